# Optimizing an MI355X kernel written in HIP

```python
import jax, jax.numpy as jnp
from jax import lax
import numpy as np

D_MODEL = 2048
BATCH = 16
SEQ = 2048
DEPTH = 2

GRID_W = 64
Q_BLOCK = 128
ROPE_THETA = 10000.0
EPS = 1e-6

GQA_HEADS = 6
GQA_KV_HEADS = 2
GQA_HEAD_DIM = 128
GQA_WIDTH = GQA_HEADS * GQA_HEAD_DIM
GQA_KV_WIDTH = GQA_KV_HEADS * GQA_HEAD_DIM

MLA_HEADS = 4
MLA_Q_LORA = 512
MLA_KV_LORA = 256
MLA_NOPE_DIM = 128
MLA_ROPE_DIM = 64
MLA_V_DIM = 128
MLA_WIDTH = MLA_HEADS * MLA_V_DIM

SSD_HEADS = 12
SSD_HEAD_DIM = 64
SSD_GROUPS = 2
SSD_STATE = 128
SSD_CONV = 5
SSD_CHUNK = 128
SSD_INNER = SSD_HEADS * SSD_HEAD_DIM
SSD_CONV_DIM = SSD_INNER + 2 * SSD_GROUPS * SSD_STATE

MIX_WIDTH = GQA_WIDTH + MLA_WIDTH + SSD_INNER
IN_SPLITS = (GQA_WIDTH, GQA_KV_WIDTH, GQA_KV_WIDTH, MLA_Q_LORA, MLA_KV_LORA, MLA_ROPE_DIM, SSD_INNER, SSD_CONV_DIM, 2 * SSD_HEADS)
IN_COLS = GQA_WIDTH + 2 * GQA_KV_WIDTH + MLA_Q_LORA + MLA_KV_LORA + MLA_ROPE_DIM + SSD_INNER + SSD_CONV_DIM + 2 * SSD_HEADS

FFN_HIDDEN = -(-8 * D_MODEL // (3 * 256)) * 256

kernel_name = 'hybrid_gqa_mla_ssd_encoder_block'


def rms_norm(x, g):
    xf = x.astype(jnp.float32)
    y = xf * lax.rsqrt(jnp.mean(xf * xf, axis=-1, keepdims=True) + EPS)
    return (y * g).astype(x.dtype)


def axial_rope_tables(seq_len, rot_dim, dtype):
    rows = seq_len // GRID_W
    row_idx = jnp.repeat(jnp.arange(rows), GRID_W).astype(jnp.float32)
    col_idx = jnp.tile(jnp.arange(GRID_W), rows).astype(jnp.float32)
    axis_dim = rot_dim // 2
    inv_freq = jnp.power(ROPE_THETA, -jnp.arange(0, axis_dim, 2, dtype=jnp.float32) / axis_dim)
    ang_r = row_idx[:, None] * inv_freq[None, :]
    ang_c = col_idx[:, None] * inv_freq[None, :]
    return (jnp.cos(ang_r).astype(dtype), jnp.sin(ang_r).astype(dtype),
            jnp.cos(ang_c).astype(dtype), jnp.sin(ang_c).astype(dtype))


def rotate(x, cos, sin):
    x1, x2 = jnp.split(x, 2, axis=-1)
    cos = cos[:, None, :]
    sin = sin[:, None, :]
    return jnp.concatenate([x1 * cos - x2 * sin, x1 * sin + x2 * cos], axis=-1)


def apply_axial_rope(x, tables):
    cos_r, sin_r, cos_c, sin_c = tables
    x_row, x_col = jnp.split(x, 2, axis=-1)
    return jnp.concatenate([rotate(x_row, cos_r, sin_r), rotate(x_col, cos_c, sin_c)], axis=-1)


def blocked_attention(q, k, v, scale):
    b, s, h, dk = q.shape
    hkv, dv = k.shape[2], v.shape[-1]
    rep = h // hkv
    nb = s // Q_BLOCK
    qb = q.reshape(b, nb, Q_BLOCK, hkv, rep, dk).transpose(1, 0, 2, 3, 4, 5)

    def attend(q_blk):
        logits = jnp.einsum('bqgrd,bsgd->bgrqs', q_blk, k).astype(jnp.float32) * scale
        probs = jax.nn.softmax(logits, axis=-1).astype(v.dtype)
        return jnp.einsum('bgrqs,bsgd->bqgrd', probs, v)

    out = lax.map(attend, qb)
    return out.transpose(1, 0, 2, 3, 4, 5).reshape(b, s, h * dv)


def segsum(a):
    t = a.shape[-1]
    a_rep = jnp.broadcast_to(a[..., :, None], a.shape + (t,))
    strict_lower = jnp.tril(jnp.ones((t, t), dtype=bool), k=-1)
    seg = jnp.cumsum(jnp.where(strict_lower, a_rep, 0.0), axis=-2)
    lower = jnp.tril(jnp.ones((t, t), dtype=bool))
    return jnp.where(lower, seg, -jnp.inf)


def ssd_chunked(x, dt, a_neg, bm, cm):
    b, s, h, p = x.shape
    g, n = bm.shape[2], bm.shape[3]
    e = h // g
    nc = s // SSD_CHUNK
    f32 = jnp.float32
    xd = (x.astype(f32) * dt[..., None]).reshape(b, nc, SSD_CHUNK, g, e, p)
    a = (dt * a_neg).reshape(b, nc, SSD_CHUNK, g, e).transpose(0, 3, 4, 1, 2)
    bc = bm.astype(f32).reshape(b, nc, SSD_CHUNK, g, n)
    cc = cm.astype(f32).reshape(b, nc, SSD_CHUNK, g, n)
    a_cs = jnp.cumsum(a, axis=-1)
    cb = jnp.einsum('bclgn,bcsgn->bgcls', cc, bc)
    w_diag = cb[:, :, None] * jnp.exp(segsum(a))
    y_diag = jnp.einsum('bgecls,bcsgep->bclgep', w_diag, xd)
    to_end = jnp.exp(a_cs[..., -1:] - a_cs).transpose(0, 3, 4, 1, 2)
    states = jnp.einsum('bclgn,bclgep->bcgepn', bc, xd * to_end[..., None])
    states = jnp.concatenate([jnp.zeros_like(states[:, :1]), states], axis=1)
    chunk_a = jnp.pad(a_cs[..., -1], ((0, 0), (0, 0), (0, 0), (1, 0)))
    chunk_decay = jnp.exp(segsum(chunk_a))
    states = jnp.einsum('bgezc,bcgepn->bzgepn', chunk_decay, states)[:, :-1]
    from_start = jnp.exp(a_cs).transpose(0, 3, 4, 1, 2)
    y_off = jnp.einsum('bclgn,bcgepn->bclgep', cc, states) * from_start[..., None]
    return (y_diag + y_off).reshape(b, s, h, p)


def depthwise_centred_conv(x, w):
    pad = SSD_CONV // 2
    return lax.conv_general_dilated(x, w[:, None, :], window_strides=(1,), padding=[(pad, pad)],
                                    dimension_numbers=('NWC', 'WIO', 'NWC'), feature_group_count=x.shape[-1])


def gqa_group(q, k, v, q_norm_g, k_norm_g, rope):
    b, s = q.shape[:2]
    q = q.reshape(b, s, GQA_HEADS, GQA_HEAD_DIM)
    k = k.reshape(b, s, GQA_KV_HEADS, GQA_HEAD_DIM)
    v = v.reshape(b, s, GQA_KV_HEADS, GQA_HEAD_DIM)
    q = apply_axial_rope(rms_norm(q, q_norm_g), rope)
    k = apply_axial_rope(rms_norm(k, k_norm_g), rope)
    return blocked_attention(q, k, v, GQA_HEAD_DIM ** -0.5)


def mla_group(c_q, c_kv, k_pe, q_norm_g, w_uq, kv_norm_g, w_ukv, rope):
    b, s = c_q.shape[:2]
    q = (rms_norm(c_q, q_norm_g) @ w_uq).reshape(b, s, MLA_HEADS, MLA_NOPE_DIM + MLA_ROPE_DIM)
    q_nope, q_pe = q[..., :MLA_NOPE_DIM], q[..., MLA_NOPE_DIM:]
    kv = (rms_norm(c_kv, kv_norm_g) @ w_ukv).reshape(b, s, MLA_HEADS, MLA_NOPE_DIM + MLA_V_DIM)
    k_nope, v = kv[..., :MLA_NOPE_DIM], kv[..., MLA_NOPE_DIM:]
    q_pe = apply_axial_rope(q_pe, rope)
    k_pe = apply_axial_rope(k_pe[:, :, None, :], rope)
    q = jnp.concatenate([q_nope, q_pe], axis=-1)
    k = jnp.concatenate([k_nope, jnp.broadcast_to(k_pe, (b, s, MLA_HEADS, MLA_ROPE_DIM))], axis=-1)
    return blocked_attention(q, k, v, (MLA_NOPE_DIM + MLA_ROPE_DIM) ** -0.5)


def ssd_group(z, xbc, dt_raw, conv_w, conv_b, dt_bias, a_log, d_skip, norm_g):
    b, s = z.shape[:2]
    xbc = jax.nn.silu(depthwise_centred_conv(xbc, conv_w) + conv_b)
    xs, bm, cm = jnp.split(xbc, [SSD_INNER, SSD_INNER + SSD_GROUPS * SSD_STATE], axis=-1)
    xs = xs.reshape(b, s, SSD_HEADS, SSD_HEAD_DIM)
    bm = bm.reshape(b, s, SSD_GROUPS, SSD_STATE)
    cm = cm.reshape(b, s, SSD_GROUPS, SSD_STATE)
    dt = jax.nn.softplus(dt_raw.reshape(b, s, 2, SSD_HEADS).astype(jnp.float32) + dt_bias)
    a_neg = -jnp.exp(a_log.astype(jnp.float32))
    y_fwd = ssd_chunked(xs, dt[:, :, 0], a_neg[0], bm, cm)
    flip = lambda t: jnp.flip(t, axis=1)
    y_bwd = flip(ssd_chunked(flip(xs), flip(dt[:, :, 1]), a_neg[1], flip(bm), flip(cm)))
    y = y_fwd + y_bwd + xs * d_skip[:, None]
    y = y.reshape(b, s, SSD_INNER) * jax.nn.silu(z)
    y = rms_norm(y.reshape(b, s, SSD_GROUPS, SSD_INNER // SSD_GROUPS), norm_g.reshape(SSD_GROUPS, -1))
    return y.reshape(b, s, SSD_INNER)


def hybrid_mixer(h, w_in, q_norm_g, k_norm_g, mla_q_norm_g, w_uq, mla_kv_norm_g, w_ukv,
                 conv_w, conv_b, dt_bias, a_log, d_skip, ssd_norm_g, w_out, rope_a, rope_b):
    proj = h @ w_in
    idx = np.cumsum(IN_SPLITS)[:-1].tolist()
    q_a, k_a, v_a, cq_b, ckv_b, kpe_b, z_c, xbc_c, dt_c = jnp.split(proj, idx, axis=-1)
    o_a = gqa_group(q_a, k_a, v_a, q_norm_g, k_norm_g, rope_a)
    o_b = mla_group(cq_b, ckv_b, kpe_b, mla_q_norm_g, w_uq, mla_kv_norm_g, w_ukv, rope_b)
    o_c = ssd_group(z_c, xbc_c, dt_c, conv_w, conv_b, dt_bias, a_log, d_skip, ssd_norm_g)
    o = jnp.concatenate([o_a.astype(h.dtype), o_b.astype(h.dtype), o_c.astype(h.dtype)], axis=-1)
    return o @ w_out


def swiglu_ffn(h, w_gate_up, w_down):
    gate, up = jnp.split(h @ w_gate_up, 2, axis=-1)
    return (jax.nn.silu(gate) * up) @ w_down


def setup_inputs(seed: int = 0) -> dict:
    key = jax.random.key(seed)
    ks = iter(jax.random.split(key, 32))
    f32 = jnp.float32
    D, L = D_MODEL, DEPTH

    def nrm(shape, std):
        return std * jax.random.normal(next(ks), shape, f32)

    def gain(shape):
        return 1.0 + nrm(shape, 0.02)

    dt_init = jnp.exp(jax.random.uniform(next(ks), (L, 2, SSD_HEADS), f32, np.log(1e-3), np.log(1e-1)))
    dt_bias = dt_init + jnp.log(-jnp.expm1(-dt_init))
    a_log = jnp.log(jax.random.uniform(next(ks), (L, 2, SSD_HEADS), f32, 1.0, 16.0))
    return {
        'x': nrm((BATCH, SEQ, D), 1.0),
        'c': nrm((BATCH, D), 1.0),
        'w_ada': nrm((L, D, 6 * D), 0.5 * D ** -0.5),
        'b_ada': nrm((L, 6 * D), 0.01),
        'norm1_g': gain((L, D)),
        'norm2_g': gain((L, D)),
        'w_in': nrm((L, D, IN_COLS), D ** -0.5),
        'q_norm_g': gain((L, GQA_HEAD_DIM)),
        'k_norm_g': gain((L, GQA_HEAD_DIM)),
        'mla_q_norm_g': gain((L, MLA_Q_LORA)),
        'w_uq': nrm((L, MLA_Q_LORA, MLA_HEADS * (MLA_NOPE_DIM + MLA_ROPE_DIM)), MLA_Q_LORA ** -0.5),
        'mla_kv_norm_g': gain((L, MLA_KV_LORA)),
        'w_ukv': nrm((L, MLA_KV_LORA, MLA_HEADS * (MLA_NOPE_DIM + MLA_V_DIM)), MLA_KV_LORA ** -0.5),
        'conv_w': nrm((L, SSD_CONV, SSD_CONV_DIM), SSD_CONV ** -0.5),
        'conv_b': nrm((L, SSD_CONV_DIM), 0.01),
        'dt_bias': dt_bias,
        'a_log': a_log,
        'd_skip': gain((L, SSD_HEADS)),
        'ssd_norm_g': gain((L, SSD_INNER)),
        'w_out': nrm((L, MIX_WIDTH, D), MIX_WIDTH ** -0.5),
        'w_gate_up': nrm((L, D, 2 * FFN_HIDDEN), D ** -0.5),
        'w_down': nrm((L, FFN_HIDDEN, D), FFN_HIDDEN ** -0.5),
        'final_norm_g': gain((D,)),
    }


def reference(x, c, w_ada, b_ada, norm1_g, norm2_g, w_in, q_norm_g, k_norm_g, mla_q_norm_g, w_uq,
              mla_kv_norm_g, w_ukv, conv_w, conv_b, dt_bias, a_log, d_skip, ssd_norm_g, w_out,
              w_gate_up, w_down, final_norm_g):
    seq_len = x.shape[1]
    rope_a = axial_rope_tables(seq_len, GQA_HEAD_DIM, x.dtype)
    rope_b = axial_rope_tables(seq_len, MLA_ROPE_DIM, x.dtype)
    c_act = jax.nn.silu(c)
    for l in range(DEPTH):
        mod = c_act @ w_ada[l] + b_ada[l]
        shift1, scale1, gate1, shift2, scale2, gate2 = [m[:, None, :] for m in jnp.split(mod, 6, axis=-1)]
        h = rms_norm(x, norm1_g[l]) * (1 + scale1) + shift1
        mix = hybrid_mixer(h, w_in[l], q_norm_g[l], k_norm_g[l], mla_q_norm_g[l], w_uq[l], mla_kv_norm_g[l],
                           w_ukv[l], conv_w[l], conv_b[l], dt_bias[l], a_log[l], d_skip[l], ssd_norm_g[l],
                           w_out[l], rope_a, rope_b)
        x = x + gate1 * mix
        h = rms_norm(x, norm2_g[l]) * (1 + scale2) + shift2
        x = x + gate2 * swiglu_ffn(h, w_gate_up[l], w_down[l])
    return rms_norm(x, final_norm_g)
```

```cpp
#include <hip/hip_runtime.h>
#include <hip/hip_cooperative_groups.h>
#include <cstdio>
#include <cstdint>
namespace cg = cooperative_groups;

#define LAS __attribute__((address_space(3)))
typedef unsigned short bf16_t;
typedef short bf16x8 __attribute__((ext_vector_type(8)));
typedef short s16x4 __attribute__((ext_vector_type(4)));
typedef float f32x2 __attribute__((ext_vector_type(2)));
typedef float f32x4 __attribute__((ext_vector_type(4)));
typedef float f32x16 __attribute__((ext_vector_type(16)));
typedef unsigned u32x2 __attribute__((ext_vector_type(2)));
typedef unsigned u32x4 __attribute__((ext_vector_type(4)));

constexpr int NB = 16, S = 2048, D = 2048, T = NB * S, DEPTH = 2;
constexpr int INC = 4184, INP = 4352;
constexpr int FF = 5632;
constexpr int C_QA = 0, C_KA = 768, C_VA = 1024, C_CQ = 1280, C_CKV = 1792, C_KPE = 2048, C_Z = 2112, C_XBC = 2880, C_DT = 4160;
constexpr float EPS = 1e-6f;
constexpr int MODW = 6 * D;

constexpr size_t al256(size_t x) { return (x + 255) / 256 * 256; }
constexpr size_t WS_CTL = 0;
constexpr size_t WS_MOD = 4096;
constexpr size_t WS_TAB = WS_MOD + (size_t)DEPTH * NB * MODW * 4;
constexpr size_t WS_W   = al256(WS_TAB + (64 * 32 * 2 + 64 * 16 * 2) * 4);
constexpr size_t W_IN = 0, W_UQ = W_IN + (size_t)INP * D * 2, W_UKV = W_UQ + (size_t)768 * 512 * 2, W_OUT = W_UKV + (size_t)1024 * 256 * 2,
                 W_GU = W_OUT + (size_t)D * D * 2, W_DN = W_GU + (size_t)2 * FF * D * 2, W_LAYER = W_DN + (size_t)D * FF * 2;
constexpr size_t WS_ACT = al256(WS_W + DEPTH * W_LAYER);
constexpr size_t WS_BIG = WS_ACT + (size_t)T * D * 2;
constexpr size_t WS_PROJ = WS_BIG;
constexpr size_t WS_QB = WS_PROJ + (size_t)T * INP * 2;
constexpr size_t WS_KB = WS_QB + (size_t)T * 768 * 2;
constexpr size_t WS_VB = WS_KB + (size_t)T * 768 * 2;
constexpr size_t WS_XBC = WS_VB + (size_t)T * 512 * 2;
constexpr size_t WS_DT = WS_XBC + (size_t)T * 1280 * 2;
constexpr size_t WS_YF = WS_DT + (size_t)T * 24 * 4;
constexpr size_t WS_YB = WS_YF + (size_t)T * 768 * 4;
constexpr size_t WS_END1 = WS_YB + (size_t)T * 768 * 4;
constexpr size_t WS_HID = WS_BIG;
constexpr size_t WS_END2 = WS_HID + (size_t)T * FF * 2;
constexpr size_t WS_END = WS_END1 > WS_END2 ? WS_END1 : WS_END2;

constexpr int RING_BYTES = 131072, MISC_OFF = RING_BYTES, LDS_BYTES = 147456;

struct Params { const float* in[23]; float* out; unsigned char* ws; };

__device__ __forceinline__ float bf2f(bf16_t b) { return __uint_as_float(((unsigned)b) << 16); }
__device__ __forceinline__ float bfs2f(short b) { return __uint_as_float(((unsigned)(unsigned short)b) << 16); }
__device__ __forceinline__ unsigned cvt_pk_bf16(float lo, float hi) { unsigned r; asm volatile("v_cvt_pk_bf16_f32 %0, %1, %2" : "=v"(r) : "v"(lo), "v"(hi)); return r; }
__device__ __forceinline__ bf16_t f2bf(float f) { return (bf16_t)(cvt_pk_bf16(f, 0.f) & 0xffffu); }
__device__ __forceinline__ float wave_sum(float v) {
#pragma unroll
    for (int o = 1; o < 64; o <<= 1) v += __shfl_xor(v, o);
    return v;
}
__device__ __forceinline__ float silu_f(float x) { return x * __builtin_amdgcn_rcpf(1.f + __expf(-x)); }
__device__ __forceinline__ int opaque_tid() { int t = threadIdx.x; asm volatile("" : "+v"(t)); return t; }
__device__ __forceinline__ int opaque_s(int x) { asm volatile("" : "+s"(x)); return x; }
#define LDS_WAIT() asm volatile("s_waitcnt lgkmcnt(0)" ::: "memory")

namespace pg8 {
constexpr int BM = 256, BK = 64, HALF = 128, HTB = HALF * BK * 2, STAGE_BYTES = 8 * HTB, NXCD = 8, WGM = 8;
__host__ __device__ __forceinline__ int lds_byte(int r, int c) { const int st = (r >> 4) * 2 + (c >> 5), rr = r & 15, cc = c & 31, ob = rr * 64 + cc * 2; return st * 1024 + (ob ^ (((ob >> 9) & 1) << 5)); }
__host__ __device__ __forceinline__ void stage_rc(int b, int& R, int& C) { const int st = b / 1024, sb = b % 1024, swz = sb ^ (((sb >> 9) & 1) << 5); R = (st >> 1) * 16 + swz / 64; C = (st & 1) * 32 + (swz % 64) / 2; }
__host__ __device__ __forceinline__ int perm32(int rho) { const int n = rho >> 4, i = rho & 15; return 8 * (i >> 2) + 4 * n + (i & 3); }

struct Unit { int pm, pn; };
struct Gemm { const bf16_t* A; const bf16_t* Bt; int M, N, K, lda; };

struct StaticOrder {
    int nM, nN, nwg, G, c;
    __device__ void init(int M, int N, int G_, int c_) { nM = M / BM; nN = N / BM; nwg = nM * nN; G = G_; c = c_; }
    __device__ bool next(int i, Unit& u) const {
        const long L = (long)i * G + c; if (L >= nwg) return false;
        int wgid = (int)L; { const int q = nwg / NXCD, r = nwg % NXCD, xcd = wgid % NXCD, off = wgid / NXCD; wgid = (xcd < r ? xcd * (q + 1) : r * (q + 1) + (xcd - r) * q) + off; }
        const int nig = WGM * nN, gid = wgid / nig, fm = gid * WGM, gsz = (nM - fm) < WGM ? (nM - fm) : WGM;
        u.pm = fm + ((wgid % nig) % gsz); u.pn = (wgid % nig) / gsz; return true;
    }
};

template <class Epi>
__device__ __forceinline__ void gemm_phase(LAS unsigned char* lds, const Gemm g, const StaticOrder& S, const Epi& E) {
    const int tid = opaque_tid(), wid = __builtin_amdgcn_readfirstlane(tid >> 6), lane = tid & 63, wr = wid >> 2, wc = wid & 3, fr = lane & 15, fq = lane >> 4;
    const int K = g.K, nt = K / BK;
    unsigned voffA[2], voffB[2];
#pragma unroll
    for (int i = 0; i < 2; ++i) { int R, C; stage_rc(tid * 16 + i * 8192, R, C); const int Rb = Epi::PERM ? ((R & ~31) + perm32(R & 31)) : R;
        voffA[i] = (unsigned)(R * g.lda + C) * 2u; voffB[i] = (unsigned)(Rb * K + C) * 2u; }
    const size_t kstep = (size_t)(BK * 2);
    const size_t hstepA = (size_t)HALF * g.lda * 2, hstepB = (size_t)HALF * K * 2;
    const size_t tstepA = 2 * hstepA, tstepB = 2 * hstepB;
    const unsigned ldsw = (unsigned)wid * 1024u;
    const int aoff = lds_byte(wr * 64 + fr, fq * 8), boff = lds_byte(wc * 32 + fr, fq * 8);
#define PG8_SA(b, h) (((b) * 2 + (h)) * HTB)
#define PG8_SB(b, h) ((4 + (b) * 2 + (h)) * HTB)
#define PG8_STAGE(bufoff, gbase, voff) do { _Pragma("unroll") for (int _i = 0; _i < 2; ++_i) \
        __builtin_amdgcn_global_load_lds((const unsigned*)((const char*)(gbase) + (voff)[_i]), (LAS unsigned*)(lds + (bufoff) + ldsw + _i * 8192), 16, 0, 0); } while (0)
#define PG8_LDA(dst, b, h) do { _Pragma("unroll") for (int m = 0; m < 4; ++m) _Pragma("unroll") for (int k = 0; k < 2; ++k) dst[m][k] = *(const LAS bf16x8*)(lds + PG8_SA(b, h) + aoff + m * 2048 + k * 1024); } while (0)
#define PG8_LDB(dst, b, h) do { _Pragma("unroll") for (int n = 0; n < 2; ++n) _Pragma("unroll") for (int k = 0; k < 2; ++k) dst[n][k] = *(const LAS bf16x8*)(lds + PG8_SB(b, h) + boff + n * 2048 + k * 1024); } while (0)
#define PG8_MMA(ai, bj, At, Bt) do { __builtin_amdgcn_s_setprio(1); _Pragma("unroll") for (int m = 0; m < 4; ++m) _Pragma("unroll") for (int n = 0; n < 2; ++n) _Pragma("unroll") for (int k = 0; k < 2; ++k) \
        acc[ai][bj][m][n] = __builtin_amdgcn_mfma_f32_16x16x32_bf16(Bt[n][k], At[m][k], acc[ai][bj][m][n], 0, 0, 0); __builtin_amdgcn_s_setprio(0); } while (0)
#define PG8_WAIT_V(n) asm volatile("s_waitcnt vmcnt(" #n ")" ::: "memory")
#define PG8_WAIT_L(n) asm volatile("s_waitcnt lgkmcnt(" #n ")" ::: "memory")
#define PG8_BAR __builtin_amdgcn_s_barrier()
#define PG8_SCHED __builtin_amdgcn_sched_barrier(0)
    Unit cur, nxt; int ui = 0;
    if (!S.next(0, cur)) return;
    f32x4 acc[2][2][4][2];
#pragma unroll
    for (int a = 0; a < 2; ++a)
#pragma unroll
        for (int b = 0; b < 2; ++b)
#pragma unroll
            for (int m = 0; m < 4; ++m)
#pragma unroll
                for (int n = 0; n < 2; ++n) acc[a][b][m][n] = (f32x4){0.f, 0.f, 0.f, 0.f};
    bf16x8 At[4][2], B0[2][2], B1[2][2];
    const char* cA = (const char*)g.A + (size_t)cur.pm * tstepA; const char* cB = (const char*)g.Bt + (size_t)cur.pn * tstepB;
    PG8_STAGE(PG8_SB(0, 0), cB, voffB); PG8_STAGE(PG8_SB(0, 1), cB + hstepB, voffB); PG8_STAGE(PG8_SA(0, 0), cA, voffA); PG8_STAGE(PG8_SA(0, 1), cA + hstepA, voffA);
    if (wr == 1) PG8_BAR;
    PG8_WAIT_V(2); PG8_BAR;
    PG8_STAGE(PG8_SB(1, 0), cB + kstep, voffB); PG8_STAGE(PG8_SA(1, 0), cA + kstep, voffA); PG8_STAGE(PG8_SB(1, 1), cB + hstepB + kstep, voffB);
    PG8_WAIT_V(6); PG8_BAR;
    for (;;) {
        const bool has_next = S.next(ui + 1, nxt);
        const char* nA = has_next ? (const char*)g.A + (size_t)nxt.pm * tstepA : cA; const char* nB = has_next ? (const char*)g.Bt + (size_t)nxt.pn * tstepB : cB;
#pragma nounroll
        for (int t = 0; t < nt; t += 2) {
            const bool last = (t == nt - 2);
            const char* a1 = cA + (size_t)(t + 1) * kstep;
            const char* a2 = last ? nA : cA + (size_t)(t + 2) * kstep; const char* b2 = last ? nB : cB + (size_t)(t + 2) * kstep;
            const char* a3 = a2 + kstep; const char* b3 = b2 + kstep;
            PG8_LDB(B0, 0, 0); PG8_LDB(B1, 0, 1); PG8_SCHED; PG8_LDA(At, 0, 0); PG8_STAGE(PG8_SA(1, 1), a1 + hstepA, voffA);
            PG8_WAIT_V(8); PG8_WAIT_L(0); PG8_BAR; PG8_MMA(0, 0, At, B0); PG8_MMA(0, 1, At, B1); PG8_BAR; PG8_SCHED;
            PG8_LDA(At, 0, 1); PG8_STAGE(PG8_SB(0, 0), b2, voffB); PG8_STAGE(PG8_SB(0, 1), b2 + hstepB, voffB); PG8_STAGE(PG8_SA(0, 0), a2, voffA);
            PG8_WAIT_V(8); PG8_WAIT_L(0); PG8_BAR; PG8_MMA(1, 0, At, B0); PG8_MMA(1, 1, At, B1); PG8_BAR; PG8_SCHED;
            PG8_LDB(B0, 1, 0); PG8_LDB(B1, 1, 1); PG8_SCHED; PG8_LDA(At, 1, 0); PG8_STAGE(PG8_SA(0, 1), a2 + hstepA, voffA);
            PG8_WAIT_V(8); PG8_WAIT_L(0); PG8_BAR; PG8_MMA(0, 0, At, B0); PG8_MMA(0, 1, At, B1); PG8_BAR; PG8_SCHED;
            PG8_LDA(At, 1, 1); PG8_STAGE(PG8_SB(1, 0), b3, voffB); PG8_STAGE(PG8_SB(1, 1), b3 + hstepB, voffB); PG8_STAGE(PG8_SA(1, 0), a3, voffA);
            PG8_WAIT_V(8); PG8_WAIT_L(0); PG8_BAR; PG8_MMA(1, 0, At, B0); PG8_MMA(1, 1, At, B1); PG8_BAR; PG8_SCHED;
        }
        if (wr == 0) PG8_BAR;
        E(acc, cur, wr, wc, fr, fq);
        if (!has_next) break;
#pragma unroll
        for (int a = 0; a < 2; ++a)
#pragma unroll
            for (int b = 0; b < 2; ++b)
#pragma unroll
                for (int m = 0; m < 4; ++m)
#pragma unroll
                    for (int n = 0; n < 2; ++n) acc[a][b][m][n] = (f32x4){0.f, 0.f, 0.f, 0.f};
        cur = nxt; cA = nA; cB = nB; ++ui;
        if (wr == 1) PG8_BAR;
    }
    PG8_WAIT_V(0);
    PG8_BAR;
#undef PG8_SA
#undef PG8_SB
#undef PG8_STAGE
#undef PG8_LDA
#undef PG8_LDB
#undef PG8_MMA
#undef PG8_WAIT_V
#undef PG8_WAIT_L
#undef PG8_BAR
#undef PG8_SCHED
}

struct EpiProj {
    static constexpr bool PERM = true;
    bf16_t* O;
    __device__ __forceinline__ void operator()(const f32x4 (&acc)[2][2][4][2], const Unit& u, int wr, int wc, int fr, int fq) const {
        const int row0 = u.pm * BM + wr * 64 + fr, col0 = u.pn * BM + wc * 32 + 8 * fq;
#pragma unroll
        for (int ai = 0; ai < 2; ++ai)
#pragma unroll
            for (int m = 0; m < 4; ++m) { bf16_t* rowp = O + (size_t)(row0 + ai * HALF + m * 16) * INP + col0;
#pragma unroll
                for (int bj = 0; bj < 2; ++bj) { const f32x4 v0 = acc[ai][bj][m][0], v1 = acc[ai][bj][m][1];
                    u32x4 w; w.x = cvt_pk_bf16(v0[0], v0[1]); w.y = cvt_pk_bf16(v0[2], v0[3]); w.z = cvt_pk_bf16(v1[0], v1[1]); w.w = cvt_pk_bf16(v1[2], v1[3]);
                    *(u32x4*)(rowp + bj * HALF) = w; } }
    }
};
struct EpiUq {
    static constexpr bool PERM = false;
    bf16_t* O; const float* tcos; const float* tsin;
    __device__ __forceinline__ void operator()(const f32x4 (&acc)[2][2][4][2], const Unit& u, int wr, int wc, int fr, int fq) const {
        const int row0 = u.pm * BM + wr * 64 + fr;
#pragma unroll
        for (int bj = 0; bj < 2; ++bj) {
            const int cg = u.pn * BM + bj * HALF + wc * 32, w = cg % 192;
            const int axis = (w == 128) ? 0 : ((w == 160) ? 1 : -1);
#pragma unroll
            for (int ai = 0; ai < 2; ++ai)
#pragma unroll
                for (int m = 0; m < 4; ++m) {
                    const int r = row0 + ai * HALF + m * 16, s = r & (S - 1);
                    f32x4 x1 = acc[ai][bj][m][0], x2 = acc[ai][bj][m][1];
                    if (axis >= 0) {
                        const int idx = axis ? (s & 63) : (s >> 6);
                        const f32x4 c = *(const f32x4*)(tcos + idx * 16 + 4 * fq), sn = *(const f32x4*)(tsin + idx * 16 + 4 * fq);
                        const f32x4 o1 = x1 * c - x2 * sn, o2 = x1 * sn + x2 * c; x1 = o1; x2 = o2;
                    }
                    bf16_t* rowp = O + (size_t)r * 768 + cg + 4 * fq;
                    u32x2 w0, w1; w0.x = cvt_pk_bf16(x1[0], x1[1]); w0.y = cvt_pk_bf16(x1[2], x1[3]); w1.x = cvt_pk_bf16(x2[0], x2[1]); w1.y = cvt_pk_bf16(x2[2], x2[3]);
                    *(u32x2*)(rowp) = w0; *(u32x2*)(rowp + 16) = w1;
                }
        }
    }
};
struct EpiUkv {
    static constexpr bool PERM = true;
    bf16_t* KB; bf16_t* VB;
    __device__ __forceinline__ void operator()(const f32x4 (&acc)[2][2][4][2], const Unit& u, int wr, int wc, int fr, int fq) const {
        const int row0 = u.pm * BM + wr * 64 + fr, cin = wc * 32 + 8 * fq;
#pragma unroll
        for (int ai = 0; ai < 2; ++ai)
#pragma unroll
            for (int m = 0; m < 4; ++m) { const size_t r = (size_t)(row0 + ai * HALF + m * 16);
#pragma unroll
                for (int bj = 0; bj < 2; ++bj) { const f32x4 v0 = acc[ai][bj][m][0], v1 = acc[ai][bj][m][1];
                    u32x4 w; w.x = cvt_pk_bf16(v0[0], v0[1]); w.y = cvt_pk_bf16(v0[2], v0[3]); w.z = cvt_pk_bf16(v1[0], v1[1]); w.w = cvt_pk_bf16(v1[2], v1[3]);
                    bf16_t* dst = bj == 0 ? (KB + r * 768 + u.pn * 192 + cin) : (VB + r * 512 + u.pn * 128 + cin);
                    *(u32x4*)dst = w; } }
    }
};
struct EpiResid {
    static constexpr bool PERM = false;
    const float* in; float* out; const float* gate;
    __device__ __forceinline__ void operator()(const f32x4 (&acc)[2][2][4][2], const Unit& u, int wr, int wc, int fr, int fq) const {
        const int row0 = u.pm * BM + wr * 64 + fr, col0 = u.pn * BM + wc * 32 + 4 * fq;
        const float* gb = gate + (size_t)(u.pm >> 3) * MODW + col0;
        f32x4 gv[2][2];
#pragma unroll
        for (int bj = 0; bj < 2; ++bj)
#pragma unroll
            for (int n = 0; n < 2; ++n) gv[bj][n] = *(const f32x4*)(gb + bj * HALF + n * 16);
#pragma unroll
        for (int ai = 0; ai < 2; ++ai)
#pragma unroll
            for (int m = 0; m < 4; ++m) { const size_t off = (size_t)(row0 + ai * HALF + m * 16) * D + col0;
#pragma unroll
                for (int bj = 0; bj < 2; ++bj)
#pragma unroll
                    for (int n = 0; n < 2; ++n) { const f32x4 bs = *(const f32x4*)(in + off + bj * HALF + n * 16);
                        *(f32x4*)(out + off + bj * HALF + n * 16) = bs + gv[bj][n] * acc[ai][bj][m][n]; }
                asm volatile("" ::: "memory"); }
    }
};
struct EpiSwiglu {
    static constexpr bool PERM = true;
    bf16_t* O;
    __device__ __forceinline__ void operator()(const f32x4 (&acc)[2][2][4][2], const Unit& u, int wr, int wc, int fr, int fq) const {
        const int row0 = u.pm * BM + wr * 64 + fr, col0 = u.pn * HALF + wc * 32 + 8 * fq;
#pragma unroll
        for (int ai = 0; ai < 2; ++ai)
#pragma unroll
            for (int m = 0; m < 4; ++m) { bf16_t* rowp = O + (size_t)(row0 + ai * HALF + m * 16) * FF + col0;
                f32x4 h0, h1;
#pragma unroll
                for (int j = 0; j < 4; ++j) { h0[j] = silu_f(acc[ai][0][m][0][j]) * acc[ai][1][m][0][j]; h1[j] = silu_f(acc[ai][0][m][1][j]) * acc[ai][1][m][1][j]; }
                u32x4 w; w.x = cvt_pk_bf16(h0[0], h0[1]); w.y = cvt_pk_bf16(h0[2], h0[3]); w.z = cvt_pk_bf16(h1[0], h1[1]); w.w = cvt_pk_bf16(h1[2], h1[3]);
                *(u32x4*)rowp = w; }
    }
};
}

namespace att {
constexpr int NW = 8, QBLK = 32, KVBLK = 64, DV = 128;
constexpr float THR = 8.f;
#define SBAR() __builtin_amdgcn_sched_barrier(0)
__device__ __forceinline__ int crow(int r, int hi) { return (r & 3) + 8 * (r >> 2) + 4 * hi; }
__device__ __forceinline__ unsigned cvtpk(float lo, float hi) { unsigned r; asm volatile("v_cvt_pk_bf16_f32 %0, %1, %2" : "=v"(r) : "v"(lo), "v"(hi)); return r; }

template <int DK> struct Cfg {
    static constexpr float SCALE = (DK == 128) ? 0.088388347648318440f : 0.072168783648703220f;
    static constexpr int KROWB = DK * 2;
    static constexpr int SHM_V = KVBLK * DV * 2, SHM_K = KVBLK * DK * 2;
    static constexpr int SHM = 2 * SHM_V + 2 * SHM_K + NW * 64 * 4;
    static constexpr int NKC = DK / 64;
    static constexpr int ND0 = DK / 16;
};
template <int DK> __device__ __forceinline__ int kswz(int row, int colB) { return row * (DK * 2) + (colB ^ ((row & 7) << 4)); }

template <int DK>
__device__ __forceinline__ void partialSM(f32x16& p0, f32x16& p1, float& m_reg, float& mn, float& alpha) {
    constexpr float SCALE = Cfg<DK>::SCALE;
    constexpr float C = SCALE * 1.4426950408889634f;
    float pmax = p0[0];
#pragma unroll
    for (int r = 1; r < 16; ++r) pmax = fmaxf(pmax, p0[r]);
#pragma unroll
    for (int r = 0; r < 16; ++r) pmax = fmaxf(pmax, p1[r]);
    { auto rr = __builtin_amdgcn_permlane32_swap(__float_as_uint(pmax), __float_as_uint(pmax), false, false);
      pmax = fmaxf(__uint_as_float(rr[0]), __uint_as_float(rr[1])); }
    if (__builtin_expect(__all(pmax - m_reg <= THR / SCALE), 1)) { mn = m_reg; alpha = 1.f; }
    else { mn = fmaxf(m_reg, pmax); alpha = __builtin_amdgcn_exp2f((m_reg - mn) * C); m_reg = mn; }
    float mnC = -mn * C;
#pragma unroll
    for (int r = 0; r < 16; ++r) p0[r] = fmaf(p0[r], C, mnC);
#pragma unroll
    for (int r = 0; r < 16; ++r) p1[r] = fmaf(p1[r], C, mnC);
#pragma unroll
    for (int r = 0; r < 16; ++r) p0[r] = __builtin_amdgcn_exp2f(p0[r]);
}
__device__ __forceinline__ void finishSM(f32x16& p0, f32x16& p1, float alpha, float& l_reg, bf16x8& pa0, bf16x8& pa1, bf16x8& pa2, bf16x8& pa3) {
#pragma unroll
    for (int r = 0; r < 16; ++r) p1[r] = __builtin_amdgcn_exp2f(p1[r]);
    float ps = 0;
#pragma unroll
    for (int r = 0; r < 16; ++r) ps += p0[r];
#pragma unroll
    for (int r = 0; r < 16; ++r) ps += p1[r];
    { auto rr = __builtin_amdgcn_permlane32_swap(__float_as_uint(ps), __float_as_uint(ps), false, false);
      ps = __uint_as_float(rr[0]) + __uint_as_float(rr[1]); }
    l_reg = l_reg * alpha + ps;
#define PK4(P, BASE, OUT) do { unsigned a0 = cvtpk(P[BASE + 0], P[BASE + 1]), a1 = cvtpk(P[BASE + 2], P[BASE + 3]);   \
    unsigned b0 = cvtpk(P[BASE + 4], P[BASE + 5]), b1 = cvtpk(P[BASE + 6], P[BASE + 7]);                              \
    auto r0 = __builtin_amdgcn_permlane32_swap(a0, b0, false, false); auto r1 = __builtin_amdgcn_permlane32_swap(a1, b1, false, false); \
    u32x4 w = {r0[0], r1[0], r0[1], r1[1]}; OUT = *reinterpret_cast<bf16x8*>(&w); } while (0)
    PK4(p0, 0, pa0); PK4(p0, 8, pa1); PK4(p1, 0, pa2); PK4(p1, 8, pa3);
#undef PK4
}
template <int DK>
__device__ __forceinline__ void qkt(f32x16& p0, f32x16& p1, const char* Ks, const bf16x8* qr, int r32, int hi) {
    p0 = f32x16{}; p1 = f32x16{};
#pragma unroll
    for (int d0 = 0; d0 < Cfg<DK>::ND0; ++d0) { int cb = (d0 * 16 + hi * 8) * 2;
        bf16x8 b0 = *reinterpret_cast<const bf16x8*>(Ks + kswz<DK>(r32, cb));
        bf16x8 b1 = *reinterpret_cast<const bf16x8*>(Ks + kswz<DK>(32 + r32, cb));
        p0 = __builtin_amdgcn_mfma_f32_32x32x16_bf16(b0, qr[d0], p0, 0, 0, 0);
        p1 = __builtin_amdgcn_mfma_f32_32x32x16_bf16(b1, qr[d0], p1, 0, 0, 0); }
}
__device__ __forceinline__ int v_st(int k, int c) { const int kk = (k & ~0xC) | ((k & 4) << 1) | ((k & 8) >> 1); return ((kk >> 3) * 4 + (c >> 5)) * 512 + ((kk & 7) * 32 + (c & 31)) * 2; }
__device__ __forceinline__ int v_rd_base(int lane) { return ((lane & 3) << 3) | (((lane >> 2) & 3) << 6) | (((lane >> 4) & 1) << 5) | (((lane >> 5) & 1) << 8); }
constexpr int v_rd_off(int d0, int ks, int half) { return d0 * 512 + ks * 4096 + half * 2048; }
template <int OFF> __device__ __forceinline__ s16x4 tr_read(int vb) {
    s16x4 r; asm volatile("ds_read_b64_tr_b16 %0, %1 offset:%2" : "=&v"(r) : "v"(vb), "i"(OFF) : "memory"); return r;
}
template <int D0> __device__ __forceinline__ void pv_one(f32x16& od, int vb, bf16x8 pa0, bf16x8 pa1, bf16x8 pa2, bf16x8 pa3) {
    const s16x4 l0 = tr_read<v_rd_off(D0, 0, 0)>(vb), h0 = tr_read<v_rd_off(D0, 0, 1)>(vb), l1 = tr_read<v_rd_off(D0, 1, 0)>(vb), h1 = tr_read<v_rd_off(D0, 1, 1)>(vb);
    const s16x4 l2 = tr_read<v_rd_off(D0, 2, 0)>(vb), h2 = tr_read<v_rd_off(D0, 2, 1)>(vb), l3 = tr_read<v_rd_off(D0, 3, 0)>(vb), h3 = tr_read<v_rd_off(D0, 3, 1)>(vb);
    asm volatile("s_waitcnt lgkmcnt(0)" ::: "memory"); SBAR();
#define PK(L, H) (bf16x8){L[0], L[1], L[2], L[3], H[0], H[1], H[2], H[3]}
    od = __builtin_amdgcn_mfma_f32_32x32x16_bf16(pa0, PK(l0, h0), od, 0, 0, 0);
    od = __builtin_amdgcn_mfma_f32_32x32x16_bf16(pa1, PK(l1, h1), od, 0, 0, 0);
    od = __builtin_amdgcn_mfma_f32_32x32x16_bf16(pa2, PK(l2, h2), od, 0, 0, 0);
    od = __builtin_amdgcn_mfma_f32_32x32x16_bf16(pa3, PK(l3, h3), od, 0, 0, 0);
#undef PK
}
__device__ __forceinline__ void pv_d0(f32x16* o, int vb, bf16x8 pa0, bf16x8 pa1, bf16x8 pa2, bf16x8 pa3) {
    pv_one<0>(o[0], vb, pa0, pa1, pa2, pa3); pv_one<1>(o[1], vb, pa0, pa1, pa2, pa3); pv_one<2>(o[2], vb, pa0, pa1, pa2, pa3); pv_one<3>(o[3], vb, pa0, pa1, pa2, pa3);
}

template <int DK, int LDQ, int LDK, int LDV, int LDO, int SDEPTH>
__device__ __forceinline__ void attn_dense_body(const bf16_t* __restrict__ Qb, const bf16_t* __restrict__ Kh, const bf16_t* __restrict__ Vh,
                                                bf16_t* __restrict__ Ob, int seq, char* lds) {
    using C = Cfg<DK>;
    constexpr int SHM_V = C::SHM_V, SHM_K = C::SHM_K, NKC = C::NKC, ND0 = C::ND0;
    const int tid = opaque_tid(), wid = tid >> 6, lane = tid & 63, r32 = lane & 31, hi = lane >> 5;
    char* V_lds = lds; char* K_lds = lds + 2 * SHM_V;
    float* ws = (float*)(lds + 2 * SHM_V + 2 * SHM_K) + wid * 64; float* li_l = ws; float* al_l = ws + 32;
    float m_reg = -1e30f, l_reg = 0; f32x16 o[4] = {}; bf16x8 qr[ND0];
    const bf16_t* Qw = Qb + (long)(wid * QBLK + r32) * LDQ + hi * 8;
#pragma unroll
    for (int d0 = 0; d0 < ND0; ++d0) qr[d0] = *reinterpret_cast<const bf16x8*>(Qw + d0 * 16);
    const int sr = tid >> 4, sc = (tid & 15) * 8, vst0 = v_st(sr, sc), vst1 = v_st(32 + sr, sc);
    int kgo[NKC], klo[NKC];
#pragma unroll
    for (int c = 0; c < NKC; ++c) { const int id = tid + 512 * c, kr = id / (DK / 8), kc = id % (DK / 8); kgo[c] = kr * LDK + kc * 8; klo[c] = kswz<DK>(kr, kc * 16); }
    const int vb0 = (int)(uintptr_t)V_lds + v_rd_base(lane);
    struct { bf16x8 vs0, vs1, ks[NKC]; } sr_[SDEPTH];
#define SLOAD(i, k0) do { sr_[i].vs0 = *reinterpret_cast<const bf16x8*>(&Vh[(long)((k0) + sr) * LDV + sc]); sr_[i].vs1 = *reinterpret_cast<const bf16x8*>(&Vh[(long)((k0) + 32 + sr) * LDV + sc]); \
    _Pragma("unroll") for (int c_ = 0; c_ < NKC; ++c_) sr_[i].ks[c_] = *reinterpret_cast<const bf16x8*>(&Kh[(long)(k0) * LDK + kgo[c_]]); } while (0)
#define SWRITE(b, i) do { *(bf16x8*)(V_lds + (b) * SHM_V + vst0) = sr_[i].vs0; *(bf16x8*)(V_lds + (b) * SHM_V + vst1) = sr_[i].vs1; \
    _Pragma("unroll") for (int c_ = 0; c_ < NKC; ++c_) *(bf16x8*)(K_lds + (b) * SHM_K + klo[c_]) = sr_[i].ks[c_]; } while (0)
#define SWAIT() do { if constexpr (SDEPTH == 2) { if constexpr (NKC == 2) asm volatile("s_waitcnt vmcnt(4)" ::: "memory"); else asm volatile("s_waitcnt vmcnt(5)" ::: "memory"); } \
    else asm volatile("s_waitcnt vmcnt(0)" ::: "memory"); } while (0)
#define RESC(a) do { if (__any((a) < 1.f)) { if (hi == 0) al_l[r32] = (a); asm volatile("s_waitcnt lgkmcnt(0)" ::: "memory"); \
    _Pragma("unroll") for (int d = 0; d < 4; ++d) _Pragma("unroll") for (int r = 0; r < 16; ++r) o[d][r] *= al_l[crow(r, hi)]; } } while (0)
    f32x16 pA0, pA1, pB0, pB1; float mnA, mnB, alA, alB; bf16x8 pa0, pa1, pa2, pa3; const int NT = seq / KVBLK;
    constexpr int SE = 0, SO = SDEPTH - 1;
    SLOAD(SE, 0); asm volatile("s_waitcnt vmcnt(0)" ::: "memory"); SWRITE(0, SE); __syncthreads();
    qkt<DK>(pA0, pA1, K_lds, qr, r32, hi); partialSM<DK>(pA0, pA1, m_reg, mnA, alA);
    SLOAD(SO, KVBLK); if constexpr (SDEPTH == 2) { if (2 < NT) SLOAD(SE, 2 * KVBLK); }
    SWAIT(); SWRITE(1, SO); __syncthreads();
    for (int j = 1; j + 1 < NT; j += 2) {
        SBAR(); qkt<DK>(pB0, pB1, K_lds + SHM_K, qr, r32, hi);
        finishSM(pA0, pA1, alA, l_reg, pa0, pa1, pa2, pa3); SBAR();
        SLOAD(SO, (j + SDEPTH) * KVBLK); SBAR();
        pv_d0(o, vb0, pa0, pa1, pa2, pa3); partialSM<DK>(pB0, pB1, m_reg, mnB, alB);
        __syncthreads(); SWAIT(); SWRITE(0, SE);
        RESC(alB); __syncthreads();
        SBAR(); qkt<DK>(pA0, pA1, K_lds, qr, r32, hi);
        finishSM(pB0, pB1, alB, l_reg, pa0, pa1, pa2, pa3); SBAR();
        if (SDEPTH == 1 || j + 3 < NT) SLOAD(SE, (j + 1 + SDEPTH) * KVBLK); SBAR();
        pv_d0(o, vb0 + (int)SHM_V, pa0, pa1, pa2, pa3); partialSM<DK>(pA0, pA1, m_reg, mnA, alA);
        __syncthreads(); SWAIT(); SWRITE(1, SO);
        RESC(alA); __syncthreads();
    }
    SBAR(); qkt<DK>(pB0, pB1, K_lds + SHM_K, qr, r32, hi);
    finishSM(pA0, pA1, alA, l_reg, pa0, pa1, pa2, pa3); SBAR();
    pv_d0(o, vb0, pa0, pa1, pa2, pa3); partialSM<DK>(pB0, pB1, m_reg, mnB, alB);
    __syncthreads(); RESC(alB);
    finishSM(pB0, pB1, alB, l_reg, pa0, pa1, pa2, pa3); SBAR();
    pv_d0(o, vb0 + (int)SHM_V, pa0, pa1, pa2, pa3);
    if (hi == 0) li_l[r32] = l_reg; asm volatile("s_waitcnt lgkmcnt(0)" ::: "memory");
    float rli[16];
#pragma unroll
    for (int r = 0; r < 16; ++r) rli[r] = __builtin_amdgcn_rcpf(li_l[crow(r, hi)]);
    bf16_t* Ow = Ob + (long)(wid * QBLK) * LDO;
#pragma unroll
    for (int r = 0; r < 16; ++r) { int orow = crow(r, hi);
#pragma unroll
        for (int d0 = 0; d0 < 4; ++d0) Ow[(long)orow * LDO + d0 * 32 + r32] = f2bf(o[d0][r] * rli[r]); }
#undef SLOAD
#undef SWRITE
#undef SWAIT
#undef RESC
}

template <int DK, int LDQ, int LDK, int LDV, int LDO>
__device__ __forceinline__ void attn_simple_body(const bf16_t* __restrict__ Qb, const bf16_t* __restrict__ Kh, const bf16_t* __restrict__ Vh,
                                                 bf16_t* __restrict__ Ob, int seq, char* lds) {
    using C = Cfg<DK>;
    constexpr int SHM_V = C::SHM_V, SHM_K = C::SHM_K, NKC = C::NKC, ND0 = C::ND0;
    const int tid = opaque_tid(), wid = tid >> 6, lane = tid & 63, r32 = lane & 31, hi = lane >> 5;
    char* V_lds = lds; char* K_lds = lds + 2 * SHM_V;
    float* ws = (float*)(lds + 2 * SHM_V + 2 * SHM_K) + wid * 64; float* li_l = ws; float* al_l = ws + 32;
    float m_reg = -1e30f, l_reg = 0; f32x16 o[4] = {}; bf16x8 qr[ND0];
    const bf16_t* Qw = Qb + (long)(wid * QBLK + r32) * LDQ + hi * 8;
#pragma unroll
    for (int d0 = 0; d0 < ND0; ++d0) qr[d0] = *reinterpret_cast<const bf16x8*>(Qw + d0 * 16);
    const int sr = tid >> 4, sc = (tid & 15) * 8, vst0 = v_st(sr, sc), vst1 = v_st(32 + sr, sc);
    const int vb0 = (int)(uintptr_t)V_lds + v_rd_base(lane);
    bf16x8 vs0, vs1, ks[NKC];
#define SLOAD1(k0) do { vs0 = *reinterpret_cast<const bf16x8*>(&Vh[(long)((k0) + sr) * LDV + sc]); vs1 = *reinterpret_cast<const bf16x8*>(&Vh[(long)((k0) + 32 + sr) * LDV + sc]); \
    _Pragma("unroll") for (int c_ = 0; c_ < NKC; ++c_) { const int id_ = tid + 512 * c_, kr_ = id_ / (DK / 8), kc_ = id_ % (DK / 8); ks[c_] = *reinterpret_cast<const bf16x8*>(&Kh[(long)((k0) + kr_) * LDK + kc_ * 8]); } } while (0)
#define SWRITE1(b) do { *(bf16x8*)(V_lds + (b) * SHM_V + vst0) = vs0; *(bf16x8*)(V_lds + (b) * SHM_V + vst1) = vs1; \
    _Pragma("unroll") for (int c_ = 0; c_ < NKC; ++c_) { const int id_ = tid + 512 * c_, kr_ = id_ / (DK / 8), kc_ = id_ % (DK / 8); *(bf16x8*)(K_lds + (b) * SHM_K + kswz<DK>(kr_, kc_ * 16)) = ks[c_]; } } while (0)
    f32x16 pA0, pA1; float mnA, alA; bf16x8 pa0, pa1, pa2, pa3; const int NT = seq / KVBLK;
    SLOAD1(0); asm volatile("s_waitcnt vmcnt(0)" ::: "memory"); SWRITE1(0); __syncthreads();
    for (int j = 0; j < NT; ++j) {
        const int cb = j & 1;
        if (j + 1 < NT) SLOAD1((j + 1) * KVBLK);
        SBAR(); qkt<DK>(pA0, pA1, K_lds + cb * SHM_K, qr, r32, hi);
        partialSM<DK>(pA0, pA1, m_reg, mnA, alA);
        if (__any(alA < 1.f)) { if (hi == 0) al_l[r32] = alA; asm volatile("s_waitcnt lgkmcnt(0)" ::: "memory");
#pragma unroll
            for (int d = 0; d < 4; ++d)
#pragma unroll
                for (int r = 0; r < 16; ++r) o[d][r] *= al_l[crow(r, hi)]; }
        finishSM(pA0, pA1, alA, l_reg, pa0, pa1, pa2, pa3); SBAR();
        pv_d0(o, vb0 + cb * SHM_V, pa0, pa1, pa2, pa3);
        if (j + 1 < NT) { SWRITE1(cb ^ 1); }
        __syncthreads();
    }
    if (hi == 0) li_l[r32] = l_reg; asm volatile("s_waitcnt lgkmcnt(0)" ::: "memory");
    float rli[16];
#pragma unroll
    for (int r = 0; r < 16; ++r) rli[r] = __builtin_amdgcn_rcpf(li_l[crow(r, hi)]);
    bf16_t* Ow = Ob + (long)(wid * QBLK) * LDO;
#pragma unroll
    for (int r = 0; r < 16; ++r) { int orow = crow(r, hi);
#pragma unroll
        for (int d0 = 0; d0 < 4; ++d0) Ow[(long)orow * LDO + d0 * 32 + r32] = f2bf(o[d0][r] * rli[r]); }
#undef SLOAD1
#undef SWRITE1
}
}

__device__ __forceinline__ void transpose_item(const float* W, int K, int N, int NPAD, bf16_t* WT, int mode, LAS float* scr, int item, int) {
    const int lane = opaque_tid() & 63;
    const int nblk = NPAD / 32, kb = item / nblk, nb = item % nblk, k0 = 64 * kb, n0 = 32 * nb;
    const int ncol = n0 + (lane & 31); const bool okc = ncol < N;
#pragma unroll 8
    for (int i = 0; i < 32; ++i) { const int kk = 2 * i + (lane >> 5); scr[kk * 33 + (lane & 31)] = okc ? W[(size_t)(k0 + kk) * N + ncol] : 0.f; }
    LDS_WAIT(); asm volatile("" ::: "memory");
    const int c = lane & 7;
#pragma unroll
    for (int j = 0; j < 4; ++j) { const int n = (lane >> 3) + 8 * j; const LAS float* s = scr + (8 * c) * 33 + n;
        u32x4 o; o.x = cvt_pk_bf16(s[0 * 33], s[1 * 33]); o.y = cvt_pk_bf16(s[2 * 33], s[3 * 33]); o.z = cvt_pk_bf16(s[4 * 33], s[5 * 33]); o.w = cvt_pk_bf16(s[6 * 33], s[7 * 33]);
        int nn = n0 + n, drow = nn;
        if (mode == 1) { drow = (nn < FF) ? ((nn >> 7) * 256 + (nn & 127)) : (((nn - FF) >> 7) * 256 + 128 + ((nn - FF) & 127)); }
        *(u32x4*)(WT + (size_t)drow * K + k0 + 8 * c) = o; }
    LDS_WAIT(); asm volatile("" ::: "memory");
}

__device__ __forceinline__ void mod_item(const Params& p, int item, LAS float* ldsf, int) {
    const int tid = opaque_tid();
    const int l = item / 192, col0 = (item % 192) * 64, wave = tid >> 6, lane = tid & 63;
    const float* cin = p.in[1]; const float* wada = p.in[2] + (size_t)l * D * MODW; const float* bada = p.in[3] + (size_t)l * MODW;
    float* mod = (float*)(p.ws + WS_MOD) + (size_t)l * NB * MODW;
    __syncthreads();
    for (int i = 0; i < 64; ++i) { const int idx = tid + 512 * i, b = idx >> 11, k = idx & 2047; ldsf[k * 16 + b] = silu_f(cin[idx]); }
    __syncthreads();
    float acc[16];
#pragma unroll
    for (int b = 0; b < 16; ++b) acc[b] = 0.f;
    const float* wp = wada + (size_t)(wave * 256) * MODW + col0 + lane;
    for (int k = 0; k < 256; ++k) {
        const float wv = wp[(size_t)k * MODW];
        const LAS f32x4* sp = (const LAS f32x4*)(ldsf + (wave * 256 + k) * 16);
#pragma unroll
        for (int q = 0; q < 4; ++q) { const f32x4 s4 = sp[q];
#pragma unroll
            for (int j = 0; j < 4; ++j) acc[q * 4 + j] = fmaf(s4[j], wv, acc[q * 4 + j]); }
    }
    __syncthreads();
#pragma unroll
    for (int b = 0; b < 16; ++b) ldsf[(wave * 16 + b) * 64 + lane] = acc[b];
    __syncthreads();
#pragma unroll
    for (int q = 0; q < 2; ++q) { const int o = tid + 512 * q, b = o >> 6, cl = o & 63; float s = 0.f;
#pragma unroll
        for (int w = 0; w < 8; ++w) s += ldsf[(w * 16 + b) * 64 + cl];
        mod[(size_t)b * MODW + col0 + cl] = s + bada[col0 + cl]; }
    __syncthreads();
}

__device__ __forceinline__ void norm_mod_phase(const float* x, const float* g, const float* modl, int shift_off, int scale_off, bf16_t* outp, int gw, int NGW, int) {
    const int lane = opaque_tid() & 63; gw = opaque_s(gw);
    for (int row = gw; row < T; row += NGW) {
        const int b = row >> 11;
        const f32x4* xr = (const f32x4*)(x + (size_t)row * D) + lane;
        f32x4 v[8]; float ss = 0.f;
#pragma unroll
        for (int j = 0; j < 8; ++j) { v[j] = xr[64 * j]; ss += (v[j][0] * v[j][0] + v[j][1] * v[j][1]) + (v[j][2] * v[j][2] + v[j][3] * v[j][3]); }
        ss = wave_sum(ss);
        const float rstd = rsqrtf(ss * (1.f / D) + EPS);
        const float* mb = modl + (size_t)b * MODW;
#pragma unroll
        for (int j = 0; j < 8; ++j) { const int c = (lane + 64 * j) * 4;
            const f32x4 g4 = *(const f32x4*)(g + c), sc4 = *(const f32x4*)(mb + scale_off + c), sh4 = *(const f32x4*)(mb + shift_off + c);
            const f32x4 y = (v[j] * rstd) * g4 * (sc4 + 1.f) + sh4;
            u32x2 w; w.x = cvt_pk_bf16(y[0], y[1]); w.y = cvt_pk_bf16(y[2], y[3]);
            *(u32x2*)(outp + (size_t)row * D + c) = w; }
    }
}

__device__ __forceinline__ void prep_phase(const Params& p, int layer, int gw, int NGW, int) {
    const int lane = opaque_tid() & 63; gw = opaque_s(gw);
    bf16_t* proj = (bf16_t*)(p.ws + WS_PROJ);
    bf16_t* KB = (bf16_t*)(p.ws + WS_KB); bf16_t* XBC = (bf16_t*)(p.ws + WS_XBC); float* DT = (float*)(p.ws + WS_DT);
    const float* tab = (const float*)(p.ws + WS_TAB);
    const float* tAc = tab, *tAs = tab + 2048, *tBc = tab + 4096, *tBs = tab + 4096 + 1024;
    const float* qg = p.in[7] + layer * 128; const float* kg = p.in[8] + layer * 128;
    const float* cqg = p.in[9] + layer * 512; const float* ckvg = p.in[11] + layer * 256;
    const float* convw = p.in[13] + (size_t)layer * 5 * 1280; const float* convb = p.in[14] + layer * 1280;
    const float* dtbias = p.in[15] + layer * 24;
    for (int row = gw; row < T; row += NGW) {
        const int s = row & (S - 1), ri = s >> 6, ci = s & 63;
        bf16_t* pr = proj + (size_t)row * INP;
        {
            const int e = lane + (lane & 32), axis = lane >> 5, fi = lane & 31, idx = axis ? ci : ri;
            const float cs = tAc[idx * 32 + fi], sn = tAs[idx * 32 + fi];
#pragma unroll
            for (int hh = 0; hh < 8; ++hh) {
                bf16_t* base = pr + 128 * hh;
                float x1 = bf2f(base[e]), x2 = bf2f(base[e + 32]);
                const float ss = wave_sum(x1 * x1 + x2 * x2);
                const float r = rsqrtf(ss * (1.f / 128.f) + EPS);
                const float* gg = hh < 6 ? qg : kg;
                x1 = x1 * r * gg[e]; x2 = x2 * r * gg[e + 32];
                base[e] = f2bf(x1 * cs - x2 * sn); base[e + 32] = f2bf(x1 * sn + x2 * cs);
            }
        }
        {
            bf16_t* base = pr + C_CQ + lane * 8;
            const bf16x8 v = *(const bf16x8*)base; float f[8]; float ss = 0.f;
#pragma unroll
            for (int j = 0; j < 8; ++j) { f[j] = bfs2f(v[j]); ss += f[j] * f[j]; }
            ss = wave_sum(ss); const float r = rsqrtf(ss * (1.f / 512.f) + EPS);
            const f32x4 g0 = *(const f32x4*)(cqg + lane * 8), g1 = *(const f32x4*)(cqg + lane * 8 + 4);
            u32x4 w; w.x = cvt_pk_bf16(f[0] * r * g0[0], f[1] * r * g0[1]); w.y = cvt_pk_bf16(f[2] * r * g0[2], f[3] * r * g0[3]);
            w.z = cvt_pk_bf16(f[4] * r * g1[0], f[5] * r * g1[1]); w.w = cvt_pk_bf16(f[6] * r * g1[2], f[7] * r * g1[3]);
            *(u32x4*)base = w;
        }
        {
            bf16_t* base = pr + C_CKV + lane * 4;
            const s16x4 v = *(const s16x4*)base; float f[4]; float ss = 0.f;
#pragma unroll
            for (int j = 0; j < 4; ++j) { f[j] = bfs2f(v[j]); ss += f[j] * f[j]; }
            ss = wave_sum(ss); const float r = rsqrtf(ss * (1.f / 256.f) + EPS);
            const f32x4 g0 = *(const f32x4*)(ckvg + lane * 4);
            u32x2 w; w.x = cvt_pk_bf16(f[0] * r * g0[0], f[1] * r * g0[1]); w.y = cvt_pk_bf16(f[2] * r * g0[2], f[3] * r * g0[3]);
            *(u32x2*)base = w;
        }
        if (lane < 32) {
            const int axis = lane >> 4, fi = lane & 15, e = fi + 32 * axis, idx = axis ? ci : ri;
            const float cs = tBc[idx * 16 + fi], sn = tBs[idx * 16 + fi];
            const float x1 = bf2f(pr[C_KPE + e]), x2 = bf2f(pr[C_KPE + e + 16]);
            const bf16_t o1 = f2bf(x1 * cs - x2 * sn), o2 = f2bf(x1 * sn + x2 * cs);
            bf16_t* kb = KB + (size_t)row * 768 + 128 + e;
#pragma unroll
            for (int hd = 0; hd < 4; ++hd) { kb[hd * 192] = o1; kb[hd * 192 + 16] = o2; }
        }
        {
#pragma unroll
            for (int j = 0; j < 5; ++j) {
                const int c = (j * 64 + lane) * 4;
                f32x4 a = *(const f32x4*)(convb + c);
#pragma unroll
                for (int k = 0; k < 5; ++k) {
                    const int s2 = s + k - 2;
                    if (s2 >= 0 && s2 < S) {
                        const s16x4 v = *(const s16x4*)(proj + (size_t)(row + k - 2) * INP + C_XBC + c);
                        const f32x4 w = *(const f32x4*)(convw + k * 1280 + c);
#pragma unroll
                        for (int q = 0; q < 4; ++q) a[q] = fmaf(w[q], bfs2f(v[q]), a[q]);
                    }
                }
                u32x2 o; o.x = cvt_pk_bf16(silu_f(a[0]), silu_f(a[1])); o.y = cvt_pk_bf16(silu_f(a[2]), silu_f(a[3]));
                *(u32x2*)(XBC + (size_t)row * 1280 + c) = o;
            }
        }
        if (lane < 24) {
            const float v = bf2f(pr[C_DT + lane]) + dtbias[lane];
            DT[(size_t)row * 24 + lane] = v > 20.f ? v : log1pf(expf(v));
        }
    }
}

__device__ __forceinline__ void ssd_item(const bf16_t* XBC, const float* DT, float* Y, float a_neg, int b, int dir, int h, LAS unsigned char* lds, int) {
    const int tid = opaque_tid();
    LAS float* Bs = (LAS float*)lds;
    LAS float* Cs = Bs + 4096;
    LAS float* Xs = Cs + 4096;
    LAS float* Ys = Xs + 2048;
    LAS float* dAs = Ys + 2048;
    LAS float* dts = dAs + 32;
    const int g = h / 6, pp = tid >> 3, nq = tid & 7, srow = tid >> 4, sc = tid & 15;
    const size_t rowbase = (size_t)b * S;
    float hst[16];
#pragma unroll
    for (int j = 0; j < 16; ++j) hst[j] = 0.f;
    bf16x8 rB, rC; s16x4 rX; float rdt = 0.f;
#define SSD_LOAD(blk) do { const int i_ = (blk) * 32 + srow, t_ = dir ? (S - 1 - i_) : i_; const bf16_t* rp_ = XBC + (rowbase + t_) * 1280; \
        rB = *(const bf16x8*)(rp_ + 768 + g * 128 + sc * 8); rC = *(const bf16x8*)(rp_ + 1024 + g * 128 + sc * 8); rX = *(const s16x4*)(rp_ + h * 64 + sc * 4); \
        if (tid < 32) { const int i2_ = (blk) * 32 + tid, t2_ = dir ? (S - 1 - i2_) : i2_; rdt = DT[(rowbase + t2_) * 24 + dir * 12 + h]; } } while (0)
#define SSD_STORE() do { f32x4 b0_, b1_, c0_, c1_, x_; \
        _Pragma("unroll") for (int k_ = 0; k_ < 4; ++k_) { b0_[k_] = bfs2f(rB[k_]); b1_[k_] = bfs2f(rB[4 + k_]); c0_[k_] = bfs2f(rC[k_]); c1_[k_] = bfs2f(rC[4 + k_]); x_[k_] = bfs2f(rX[k_]); } \
        *(LAS f32x4*)(Bs + srow * 128 + sc * 8) = b0_; *(LAS f32x4*)(Bs + srow * 128 + sc * 8 + 4) = b1_; \
        *(LAS f32x4*)(Cs + srow * 128 + sc * 8) = c0_; *(LAS f32x4*)(Cs + srow * 128 + sc * 8 + 4) = c1_; \
        *(LAS f32x4*)(Xs + srow * 64 + sc * 4) = x_; \
        if (tid < 32) { dts[tid] = rdt; dAs[tid] = expf(rdt * a_neg); } } while (0)
    SSD_LOAD(0); SSD_STORE(); __syncthreads();
    for (int blk = 0; blk < S / 32; ++blk) {
        if (blk + 1 < S / 32) SSD_LOAD(blk + 1);
        for (int i = 0; i < 32; ++i) {
            const float dAt = dAs[i], xdt = Xs[i * 64 + pp] * dts[i];
            float acc = 0.f;
#pragma unroll
            for (int j = 0; j < 4; ++j) {
                const f32x4 bv = *(const LAS f32x4*)(Bs + i * 128 + 32 * j + 4 * nq), cv = *(const LAS f32x4*)(Cs + i * 128 + 32 * j + 4 * nq);
#pragma unroll
                for (int k = 0; k < 4; ++k) { hst[4 * j + k] = fmaf(hst[4 * j + k], dAt, xdt * bv[k]); acc = fmaf(cv[k], hst[4 * j + k], acc); }
            }
            acc += __shfl_xor(acc, 1); acc += __shfl_xor(acc, 2); acc += __shfl_xor(acc, 4);
            if (nq == 0) Ys[i * 64 + pp] = acc;
        }
        __syncthreads();
        { const int i_ = blk * 32 + srow, t_ = dir ? (S - 1 - i_) : i_;
          *(f32x4*)(Y + (rowbase + t_) * 768 + h * 64 + sc * 4) = *(const LAS f32x4*)(Ys + srow * 64 + sc * 4); }
        if (blk + 1 < S / 32) SSD_STORE();
        __syncthreads();
    }
#undef SSD_LOAD
#undef SSD_STORE
}

__device__ __forceinline__ void combine_phase(const Params& p, int layer, int gw, int NGW, int) {
    const int lane = opaque_tid() & 63; gw = opaque_s(gw);
    const bf16_t* proj = (const bf16_t*)(p.ws + WS_PROJ); const bf16_t* XBC = (const bf16_t*)(p.ws + WS_XBC);
    const float* YF = (const float*)(p.ws + WS_YF); const float* YB = (const float*)(p.ws + WS_YB);
    bf16_t* ACT = (bf16_t*)(p.ws + WS_ACT);
    const float* dskip = p.in[17] + layer * 12; const float* ng = p.in[18] + layer * 768;
    for (int row = gw; row < T; row += NGW) {
        f32x4 y[3]; float ss0 = 0.f, ss1 = 0.f;
#pragma unroll
        for (int j = 0; j < 3; ++j) {
            const int c = j * 256 + lane * 4;
            const f32x4 a = *(const f32x4*)(YF + (size_t)row * 768 + c), bq = *(const f32x4*)(YB + (size_t)row * 768 + c);
            const s16x4 xv = *(const s16x4*)(XBC + (size_t)row * 1280 + c), zv = *(const s16x4*)(proj + (size_t)row * INP + C_Z + c);
            const float dsk = dskip[c >> 6];
            float q = 0.f;
#pragma unroll
            for (int k = 0; k < 4; ++k) { const float v = (a[k] + bq[k] + bfs2f(xv[k]) * dsk) * silu_f(bfs2f(zv[k])); y[j][k] = v; q += v * v; }
            if (c < 384) ss0 += q; else ss1 += q;
        }
        ss0 = wave_sum(ss0); ss1 = wave_sum(ss1);
        const float r0 = rsqrtf(ss0 * (1.f / 384.f) + EPS), r1 = rsqrtf(ss1 * (1.f / 384.f) + EPS);
#pragma unroll
        for (int j = 0; j < 3; ++j) {
            const int c = j * 256 + lane * 4; const float r = c < 384 ? r0 : r1;
            const f32x4 g4 = *(const f32x4*)(ng + c);
            u32x2 w; w.x = cvt_pk_bf16(y[j][0] * r * g4[0], y[j][1] * r * g4[1]); w.y = cvt_pk_bf16(y[j][2] * r * g4[2], y[j][3] * r * g4[3]);
            *(u32x2*)(ACT + (size_t)row * D + 1280 + c) = w;
        }
    }
}

#ifndef PH_MASK
#define PH_MASK 0xffff
#endif
#ifndef MLA_SD
#define MLA_SD 1
#endif
constexpr int N_SSD = NB * 2 * 12, N_MLA = NB * 4 * 8, N_GQA = NB * 6 * 8, N_MIX = N_SSD + N_MLA + N_GQA;

__global__ void __launch_bounds__(512, 2) fwd_megakernel(Params p) {
    extern __shared__ __attribute__((aligned(16))) unsigned char smem[];
    cg::grid_group grid = cg::this_grid();
    LAS unsigned char* lds = (LAS unsigned char*)smem;
    volatile LAS unsigned* MISC = (volatile LAS unsigned*)(lds + MISC_OFF);
    const int wave = __builtin_amdgcn_readfirstlane(threadIdx.x >> 6);
    const int G = gridDim.x, bx = blockIdx.x;
    const int gw = bx * 8 + wave, NGW = G * 8;
    unsigned char* ws = p.ws;
    unsigned* ctl = (unsigned*)(ws + WS_CTL);
    float* modall = (float*)(ws + WS_MOD);
    float* tab = (float*)(ws + WS_TAB);
    bf16_t* ACT = (bf16_t*)(ws + WS_ACT); bf16_t* PROJ = (bf16_t*)(ws + WS_PROJ);
    bf16_t* QB = (bf16_t*)(ws + WS_QB); bf16_t* KB = (bf16_t*)(ws + WS_KB); bf16_t* VB = (bf16_t*)(ws + WS_VB);
    bf16_t* XBC = (bf16_t*)(ws + WS_XBC); float* DT = (float*)(ws + WS_DT); float* YF = (float*)(ws + WS_YF); float* YB = (float*)(ws + WS_YB);
    bf16_t* HID = (bf16_t*)(ws + WS_HID);

    {
        for (int it = bx; it < DEPTH * 192; it += G) mod_item(p, it, (LAS float*)lds, 0);
        __syncthreads();
        { const int gt = bx * 512 + opaque_tid();
          if (gt < 2048) { const int idx = gt >> 5, i = gt & 31; const float inv = powf(10000.f, -(float)(2 * i) / 64.f); const float ang = (float)idx * inv; tab[gt] = cosf(ang); tab[2048 + gt] = sinf(ang); }
          else if (gt < 3072) { const int q = gt - 2048, idx = q >> 4, i = q & 15; const float inv = powf(10000.f, -(float)(2 * i) / 32.f); const float ang = (float)idx * inv; tab[4096 + q] = cosf(ang); tab[4096 + 1024 + q] = sinf(ang); } }
        LAS float* scr = (LAS float*)(lds + wave * 16384);
        constexpr int I_IN = (D / 64) * (INP / 32), I_UQ = (512 / 64) * (768 / 32), I_UKV = (256 / 64) * (1024 / 32), I_OUT = (D / 64) * (D / 32), I_GU = (D / 64) * (2 * FF / 32), I_DN = (FF / 64) * (D / 32);
        constexpr int I_LAYER = I_IN + I_UQ + I_UKV + I_OUT + I_GU + I_DN;
        for (int it = gw; it < DEPTH * I_LAYER; it += NGW) {
            const int l = it / I_LAYER; int r = it % I_LAYER;
            unsigned char* wl = ws + WS_W + (size_t)l * W_LAYER;
            if (r < I_IN) { transpose_item(p.in[6] + (size_t)l * D * INC, D, INC, INP, (bf16_t*)(wl + W_IN), 0, scr, r, 0); continue; } r -= I_IN;
            if (r < I_UQ) { transpose_item(p.in[10] + (size_t)l * 512 * 768, 512, 768, 768, (bf16_t*)(wl + W_UQ), 0, scr, r, 0); continue; } r -= I_UQ;
            if (r < I_UKV) { transpose_item(p.in[12] + (size_t)l * 256 * 1024, 256, 1024, 1024, (bf16_t*)(wl + W_UKV), 0, scr, r, 0); continue; } r -= I_UKV;
            if (r < I_OUT) { transpose_item(p.in[19] + (size_t)l * D * D, D, D, D, (bf16_t*)(wl + W_OUT), 0, scr, r, 0); continue; } r -= I_OUT;
            if (r < I_GU) { transpose_item(p.in[20] + (size_t)l * D * 2 * FF, D, 2 * FF, 2 * FF, (bf16_t*)(wl + W_GU), 1, scr, r, 0); continue; } r -= I_GU;
            transpose_item(p.in[21] + (size_t)l * FF * D, FF, D, D, (bf16_t*)(wl + W_DN), 0, scr, r, 0);
        }
    }
    grid.sync();

    for (int layer = 0; layer < DEPTH; ++layer) {
        const unsigned char* wl = ws + WS_W + (size_t)layer * W_LAYER;
        const float* modl = modall + (size_t)layer * NB * MODW;
        const float* xin = layer == 0 ? p.in[0] : p.out;
        norm_mod_phase(xin, p.in[4] + layer * D, modl, 0, D, ACT, gw, NGW, 0);
        grid.sync();
        #if PH_MASK & (1<<2)
        { pg8::Gemm g{ACT, (const bf16_t*)(wl + W_IN), T, INP, D, D}; pg8::StaticOrder so; so.init(T, INP, G, bx);
          pg8::EpiProj E{PROJ}; pg8::gemm_phase<pg8::EpiProj>(lds, g, so, E); }

#endif
        grid.sync();
        prep_phase(p, layer, gw, NGW, 0);
        grid.sync();
        #if PH_MASK & (1<<4)
        { pg8::Gemm g{PROJ + C_CQ, (const bf16_t*)(wl + W_UQ), T, 768, 512, INP}; pg8::StaticOrder so; so.init(T, 768, G, bx);
          pg8::EpiUq E{QB, tab + 4096, tab + 4096 + 1024}; pg8::gemm_phase<pg8::EpiUq>(lds, g, so, E); }

#endif
        #if PH_MASK & (1<<5)
        { pg8::Gemm g{PROJ + C_CKV, (const bf16_t*)(wl + W_UKV), T, 1024, 256, INP}; pg8::StaticOrder so; so.init(T, 1024, G, bx);
          pg8::EpiUkv E{KB, VB}; pg8::gemm_phase<pg8::EpiUkv>(lds, g, so, E); }

#endif
        grid.sync();
        {
            const float* alog = p.in[16] + layer * 24;
            for (;;) {
                __syncthreads();
                if (opaque_tid() == 0) MISC[0] = atomicAdd(ctl + 16 + layer, 1u);
                __syncthreads();
                const int it = (int)MISC[0];
                if (it >= N_MIX) break;
                if (it < N_SSD) {
                    const int h = it % 12, dir = (it / 12) & 1, b = it / 24;
#ifndef NO_SSD
                    ssd_item(XBC, DT, dir ? YB : YF, -expf(alog[dir * 12 + h]), b, dir, h, lds, 0);
#endif
                } else if (it < N_SSD + N_MLA) {
                    const int i = it - N_SSD, qb = i & 7, h = (i >> 3) & 3, b = i >> 5;
                    const size_t r0 = (size_t)b * S;
#ifndef NO_MLA
                    att::attn_simple_body<192, 768, 768, 512, D>(QB + (r0 + qb * 256) * 768 + h * 192, KB + r0 * 768 + h * 192, VB + r0 * 512 + h * 128,
                                                                ACT + (r0 + qb * 256) * D + 768 + h * 128, S, (char*)smem);
#endif
                } else {
                    const int i = it - N_SSD - N_MLA, qb = i & 7, h = (i >> 3) % 6, b = i / 48;
                    const size_t r0 = (size_t)b * S;
#ifndef NO_GQA
                    att::attn_dense_body<128, INP, INP, INP, D, 2>(PROJ + (r0 + qb * 256) * INP + C_QA + h * 128, PROJ + r0 * INP + C_KA + (h / 3) * 128, PROJ + r0 * INP + C_VA + (h / 3) * 128,
                                                                ACT + (r0 + qb * 256) * D + h * 128, S, (char*)smem);
#endif
                }
            }
        }
        grid.sync();
        combine_phase(p, layer, gw, NGW, 0);
        grid.sync();
        #if PH_MASK & (1<<7)
        { pg8::Gemm g{ACT, (const bf16_t*)(wl + W_OUT), T, D, D, D}; pg8::StaticOrder so; so.init(T, D, G, bx);
          pg8::EpiResid E{xin, p.out, modl + 2 * D}; pg8::gemm_phase<pg8::EpiResid>(lds, g, so, E); }

#endif
        grid.sync();
        norm_mod_phase(p.out, p.in[5] + layer * D, modl, 3 * D, 4 * D, ACT, gw, NGW, 0);
        grid.sync();
        #if PH_MASK & (1<<9)
        { pg8::Gemm g{ACT, (const bf16_t*)(wl + W_GU), T, 2 * FF, D, D}; pg8::StaticOrder so; so.init(T, 2 * FF, G, bx);
          pg8::EpiSwiglu E{HID}; pg8::gemm_phase<pg8::EpiSwiglu>(lds, g, so, E); }

#endif
        grid.sync();
        #if PH_MASK & (1<<10)
        { pg8::Gemm g{HID, (const bf16_t*)(wl + W_DN), T, D, FF, FF}; pg8::StaticOrder so; so.init(T, D, G, bx);
          pg8::EpiResid E{p.out, p.out, modl + 5 * D}; pg8::gemm_phase<pg8::EpiResid>(lds, g, so, E); }

#endif
        grid.sync();
    }
    {
        const float* fg = p.in[22]; const int lane = opaque_tid() & 63; const int gw2 = opaque_s(gw);
        for (int row = gw2; row < T; row += NGW) {
            f32x4* xr = (f32x4*)(p.out + (size_t)row * D) + lane;
            f32x4 v[8]; float ss = 0.f;
#pragma unroll
            for (int j = 0; j < 8; ++j) { v[j] = xr[64 * j]; ss += (v[j][0] * v[j][0] + v[j][1] * v[j][1]) + (v[j][2] * v[j][2] + v[j][3] * v[j][3]); }
            ss = wave_sum(ss);
            const float rstd = rsqrtf(ss * (1.f / D) + EPS);
#pragma unroll
            for (int j = 0; j < 8; ++j) { const f32x4 g4 = *(const f32x4*)(fg + (lane + 64 * j) * 4); xr[64 * j] = (v[j] * rstd) * g4; }
        }
    }
}

extern "C" void kernel_launch(void* const* d_in, const int* in_sizes, int n_in, void* d_out, int out_size, void* d_ws, size_t ws_size, hipStream_t stream) {
    static int grid_blocks = 0;
    if (grid_blocks == 0) {
        if (n_in != 23 || in_sizes[0] != T * D || out_size != T * D || ws_size < WS_END) {
            fprintf(stderr, "kernel_launch: shape/workspace mismatch: n_in %d in0 %d out %d ws %zu (need %zu); nothing launched\n", n_in, n_in > 0 ? in_sizes[0] : -1, out_size, ws_size, (size_t)WS_END);
            grid_blocks = -1; return; }
        int dev = 0, cus = 0, per_cu = 0;
        hipGetDevice(&dev);
        hipDeviceGetAttribute(&cus, hipDeviceAttributeMultiprocessorCount, dev);
        if (hipFuncSetAttribute((const void*)fwd_megakernel, hipFuncAttributeMaxDynamicSharedMemorySize, LDS_BYTES) != hipSuccess) { fprintf(stderr, "kernel_launch: hipFuncSetAttribute failed\n"); grid_blocks = -1; return; }
        if (hipOccupancyMaxActiveBlocksPerMultiprocessor(&per_cu, (const void*)fwd_megakernel, 512, LDS_BYTES) != hipSuccess || per_cu < 1) { fprintf(stderr, "kernel_launch: occupancy query failed (%d)\n", per_cu); (void)hipGetLastError(); per_cu = 1; }
        grid_blocks = cus * per_cu;
        fprintf(stderr, "kernel_launch: grid %d (cus %d x %d), ws need %zu of %zu\n", grid_blocks, cus, per_cu, (size_t)WS_END, ws_size);
    }
    if (grid_blocks < 0) return;
    if (hipMemsetAsync((char*)d_ws + WS_CTL, 0, 4096, stream) != hipSuccess) { fprintf(stderr, "kernel_launch: memset failed\n"); return; }
    Params p{};
    for (int i = 0; i < 23; ++i) p.in[i] = (const float*)d_in[i];
    p.out = (float*)d_out; p.ws = (unsigned char*)d_ws;
    void* args[] = {&p};
    hipError_t e = hipLaunchCooperativeKernel((const void*)fwd_megakernel, dim3(grid_blocks), dim3(512), args, LDS_BYTES, stream);
    if (e != hipSuccess) fprintf(stderr, "kernel_launch: cooperative launch failed: %s (grid %d)\n", hipGetErrorString(e), grid_blocks);
}
```

```cpp
#include <hip/hip_runtime.h>
#include <hip/hip_cooperative_groups.h>
#include <cstdio>
#include <cstdint>
namespace cg = cooperative_groups;

#define LAS __attribute__((address_space(3)))
typedef unsigned short bf16_t;
typedef short bf16x8 __attribute__((ext_vector_type(8)));
typedef short s16x4 __attribute__((ext_vector_type(4)));
typedef float f32x2 __attribute__((ext_vector_type(2)));
typedef float f32x4 __attribute__((ext_vector_type(4)));
typedef float f32x16 __attribute__((ext_vector_type(16)));
typedef unsigned u32x2 __attribute__((ext_vector_type(2)));
typedef unsigned u32x4 __attribute__((ext_vector_type(4)));

constexpr int NB = 16, S = 2048, D = 2048, T = NB * S, DEPTH = 2;
constexpr int INC = 4184, INP = 4352;
constexpr int FF = 5632;
constexpr int C_QA = 0, C_KA = 768, C_VA = 1024, C_CQ = 1280, C_CKV = 1792, C_KPE = 2048, C_Z = 2112, C_XBC = 2880, C_DT = 4160;
constexpr float EPS = 1e-6f;
constexpr int MODW = 6 * D;

constexpr size_t al256(size_t x) { return (x + 255) / 256 * 256; }
constexpr size_t WS_CTL = 0;
constexpr size_t WS_MOD = 4096;
constexpr size_t WS_TAB = WS_MOD + (size_t)DEPTH * NB * MODW * 4;
constexpr size_t WS_W   = al256(WS_TAB + (64 * 32 * 2 + 64 * 16 * 2) * 4);
constexpr size_t W_IN = 0, W_UQ = W_IN + (size_t)INP * D * 2, W_UKV = W_UQ + (size_t)768 * 512 * 2, W_OUT = W_UKV + (size_t)1024 * 256 * 2,
                 W_GU = W_OUT + (size_t)D * D * 2, W_DN = W_GU + (size_t)2 * FF * D * 2, W_LAYER = W_DN + (size_t)D * FF * 2;
constexpr size_t WS_ACT = al256(WS_W + DEPTH * W_LAYER);
constexpr size_t WS_BIG = WS_ACT + (size_t)T * D * 2;
constexpr size_t WS_PROJ = WS_BIG;
constexpr size_t WS_QB = WS_PROJ + (size_t)T * INP * 2;
constexpr size_t WS_KB = WS_QB + (size_t)T * 768 * 2;
constexpr size_t WS_VB = WS_KB + (size_t)T * 768 * 2;
constexpr size_t WS_XBC = WS_VB + (size_t)T * 512 * 2;
constexpr size_t WS_DT = WS_XBC + (size_t)T * 1280 * 2;
constexpr size_t WS_YF = WS_DT + (size_t)T * 24 * 4;
constexpr size_t WS_YB = WS_YF + (size_t)T * 768 * 4;
constexpr size_t WS_END1 = WS_YB + (size_t)T * 768 * 4;
constexpr size_t WS_HID = WS_BIG;
constexpr size_t WS_END2 = WS_HID + (size_t)T * FF * 2;
constexpr size_t WS_END = WS_END1 > WS_END2 ? WS_END1 : WS_END2;

constexpr int RING_BYTES = 131072, MISC_OFF = RING_BYTES, LDS_BYTES = 147456;

struct Params { const float* in[23]; float* out; unsigned char* ws; };

__device__ __forceinline__ float bf2f(bf16_t b) { return __uint_as_float(((unsigned)b) << 16); }
__device__ __forceinline__ float bfs2f(short b) { return __uint_as_float(((unsigned)(unsigned short)b) << 16); }
__device__ __forceinline__ unsigned cvt_pk_bf16(float lo, float hi) { unsigned r; asm volatile("v_cvt_pk_bf16_f32 %0, %1, %2" : "=v"(r) : "v"(lo), "v"(hi)); return r; }
__device__ __forceinline__ bf16_t f2bf(float f) { return (bf16_t)(cvt_pk_bf16(f, 0.f) & 0xffffu); }
__device__ __forceinline__ float wave_sum(float v) {
#pragma unroll
    for (int o = 1; o < 64; o <<= 1) v += __shfl_xor(v, o);
    return v;
}
__device__ __forceinline__ float silu_f(float x) { return x * __builtin_amdgcn_rcpf(1.f + __expf(-x)); }
__device__ __forceinline__ int opaque_tid() { int t = threadIdx.x; asm volatile("" : "+v"(t)); return t; }
__device__ __forceinline__ int opaque_s(int x) { asm volatile("" : "+s"(x)); return x; }
#define LDS_WAIT() asm volatile("s_waitcnt lgkmcnt(0)" ::: "memory")

namespace pg8 {
constexpr int BM = 256, BK = 64, HALF = 128, HTB = HALF * BK * 2, STAGE_BYTES = 8 * HTB, NXCD = 8, WGM = 8;
__host__ __device__ __forceinline__ int lds_byte(int r, int c) { const int st = (r >> 4) * 2 + (c >> 5), rr = r & 15, cc = c & 31, ob = rr * 64 + cc * 2; return st * 1024 + (ob ^ (((ob >> 9) & 1) << 5)); }
__host__ __device__ __forceinline__ void stage_rc(int b, int& R, int& C) { const int st = b / 1024, sb = b % 1024, swz = sb ^ (((sb >> 9) & 1) << 5); R = (st >> 1) * 16 + swz / 64; C = (st & 1) * 32 + (swz % 64) / 2; }
__host__ __device__ __forceinline__ int perm32(int rho) { const int n = rho >> 4, i = rho & 15; return 8 * (i >> 2) + 4 * n + (i & 3); }

struct Unit { int pm, pn; };
struct Gemm { const bf16_t* A; const bf16_t* Bt; int M, N, K, lda; };

struct StaticOrder {
    int nM, nN, nwg, G, c;
    __device__ void init(int M, int N, int G_, int c_) { nM = M / BM; nN = N / BM; nwg = nM * nN; G = G_; c = c_; }
    __device__ bool next(int i, Unit& u) const {
        const long L = (long)i * G + c; if (L >= nwg) return false;
        int wgid = (int)L; { const int q = nwg / NXCD, r = nwg % NXCD, xcd = wgid % NXCD, off = wgid / NXCD; wgid = (xcd < r ? xcd * (q + 1) : r * (q + 1) + (xcd - r) * q) + off; }
        const int nig = WGM * nN, gid = wgid / nig, fm = gid * WGM, gsz = (nM - fm) < WGM ? (nM - fm) : WGM;
        u.pm = fm + ((wgid % nig) % gsz); u.pn = (wgid % nig) / gsz; return true;
    }
};

template <class Epi>
__device__ __forceinline__ void gemm_phase(LAS unsigned char* lds, const Gemm g, const StaticOrder& S, const Epi& E) {
    const int tid = opaque_tid(), wid = __builtin_amdgcn_readfirstlane(tid >> 6), lane = tid & 63, wr = wid >> 2, wc = wid & 3, fr = lane & 15, fq = lane >> 4;
    const int K = g.K, nt = K / BK;
    unsigned voffA[2], voffB[2];
#pragma unroll
    for (int i = 0; i < 2; ++i) { int R, C; stage_rc(tid * 16 + i * 8192, R, C); const int Rb = Epi::PERM ? ((R & ~31) + perm32(R & 31)) : R;
        voffA[i] = (unsigned)(R * g.lda + C) * 2u; voffB[i] = (unsigned)(Rb * K + C) * 2u; }
    const size_t kstep = (size_t)(BK * 2);
    const size_t hstepA = (size_t)HALF * g.lda * 2, hstepB = (size_t)HALF * K * 2;
    const size_t tstepA = 2 * hstepA, tstepB = 2 * hstepB;
    const unsigned ldsw = (unsigned)wid * 1024u;
    const int aoff = lds_byte(wr * 64 + fr, fq * 8), boff = lds_byte(wc * 32 + fr, fq * 8);
#define PG8_SA(b, h) (((b) * 2 + (h)) * HTB)
#define PG8_SB(b, h) ((4 + (b) * 2 + (h)) * HTB)
#define PG8_STAGE(bufoff, gbase, voff) do { _Pragma("unroll") for (int _i = 0; _i < 2; ++_i) \
        __builtin_amdgcn_global_load_lds((const unsigned*)((const char*)(gbase) + (voff)[_i]), (LAS unsigned*)(lds + (bufoff) + ldsw + _i * 8192), 16, 0, 0); } while (0)
#define PG8_LDA(dst, b, h) do { _Pragma("unroll") for (int m = 0; m < 4; ++m) _Pragma("unroll") for (int k = 0; k < 2; ++k) dst[m][k] = *(const LAS bf16x8*)(lds + PG8_SA(b, h) + aoff + m * 2048 + k * 1024); } while (0)
#define PG8_LDB(dst, b, h) do { _Pragma("unroll") for (int n = 0; n < 2; ++n) _Pragma("unroll") for (int k = 0; k < 2; ++k) dst[n][k] = *(const LAS bf16x8*)(lds + PG8_SB(b, h) + boff + n * 2048 + k * 1024); } while (0)
#define PG8_MMA(ai, bj, At, Bt) do { __builtin_amdgcn_s_setprio(1); _Pragma("unroll") for (int m = 0; m < 4; ++m) _Pragma("unroll") for (int n = 0; n < 2; ++n) _Pragma("unroll") for (int k = 0; k < 2; ++k) \
        acc[ai][bj][m][n] = __builtin_amdgcn_mfma_f32_16x16x32_bf16(Bt[n][k], At[m][k], acc[ai][bj][m][n], 0, 0, 0); __builtin_amdgcn_s_setprio(0); } while (0)
#define PG8_WAIT_V(n) asm volatile("s_waitcnt vmcnt(" #n ")" ::: "memory")
#define PG8_WAIT_L(n) asm volatile("s_waitcnt lgkmcnt(" #n ")" ::: "memory")
#define PG8_BAR __builtin_amdgcn_s_barrier()
#define PG8_SCHED __builtin_amdgcn_sched_barrier(0)
    Unit cur, nxt; int ui = 0;
    if (!S.next(0, cur)) return;
    f32x4 acc[2][2][4][2];
#pragma unroll
    for (int a = 0; a < 2; ++a)
#pragma unroll
        for (int b = 0; b < 2; ++b)
#pragma unroll
            for (int m = 0; m < 4; ++m)
#pragma unroll
                for (int n = 0; n < 2; ++n) acc[a][b][m][n] = (f32x4){0.f, 0.f, 0.f, 0.f};
    bf16x8 At[4][2], B0[2][2], B1[2][2];
    const char* cA = (const char*)g.A + (size_t)cur.pm * tstepA; const char* cB = (const char*)g.Bt + (size_t)cur.pn * tstepB;
    PG8_STAGE(PG8_SB(0, 0), cB, voffB); PG8_STAGE(PG8_SB(0, 1), cB + hstepB, voffB); PG8_STAGE(PG8_SA(0, 0), cA, voffA); PG8_STAGE(PG8_SA(0, 1), cA + hstepA, voffA);
    if (wr == 1) PG8_BAR;
    PG8_WAIT_V(2); PG8_BAR;
    PG8_STAGE(PG8_SB(1, 0), cB + kstep, voffB); PG8_STAGE(PG8_SA(1, 0), cA + kstep, voffA); PG8_STAGE(PG8_SB(1, 1), cB + hstepB + kstep, voffB);
    PG8_WAIT_V(6); PG8_BAR;
    for (;;) {
        const bool has_next = S.next(ui + 1, nxt);
        const char* nA = has_next ? (const char*)g.A + (size_t)nxt.pm * tstepA : cA; const char* nB = has_next ? (const char*)g.Bt + (size_t)nxt.pn * tstepB : cB;
#pragma nounroll
        for (int t = 0; t < nt; t += 2) {
            const bool last = (t == nt - 2);
            const char* a1 = cA + (size_t)(t + 1) * kstep;
            const char* a2 = last ? nA : cA + (size_t)(t + 2) * kstep; const char* b2 = last ? nB : cB + (size_t)(t + 2) * kstep;
            const char* a3 = a2 + kstep; const char* b3 = b2 + kstep;
            PG8_LDB(B0, 0, 0); PG8_LDB(B1, 0, 1); PG8_SCHED; PG8_LDA(At, 0, 0); PG8_STAGE(PG8_SA(1, 1), a1 + hstepA, voffA);
            PG8_WAIT_V(8); PG8_WAIT_L(0); PG8_BAR; PG8_MMA(0, 0, At, B0); PG8_MMA(0, 1, At, B1); PG8_BAR; PG8_SCHED;
            PG8_LDA(At, 0, 1); PG8_STAGE(PG8_SB(0, 0), b2, voffB); PG8_STAGE(PG8_SB(0, 1), b2 + hstepB, voffB); PG8_STAGE(PG8_SA(0, 0), a2, voffA);
            PG8_WAIT_V(8); PG8_WAIT_L(0); PG8_BAR; PG8_MMA(1, 0, At, B0); PG8_MMA(1, 1, At, B1); PG8_BAR; PG8_SCHED;
            PG8_LDB(B0, 1, 0); PG8_LDB(B1, 1, 1); PG8_SCHED; PG8_LDA(At, 1, 0); PG8_STAGE(PG8_SA(0, 1), a2 + hstepA, voffA);
            PG8_WAIT_V(8); PG8_WAIT_L(0); PG8_BAR; PG8_MMA(0, 0, At, B0); PG8_MMA(0, 1, At, B1); PG8_BAR; PG8_SCHED;
            PG8_LDA(At, 1, 1); PG8_STAGE(PG8_SB(1, 0), b3, voffB); PG8_STAGE(PG8_SB(1, 1), b3 + hstepB, voffB); PG8_STAGE(PG8_SA(1, 0), a3, voffA);
            PG8_WAIT_V(8); PG8_WAIT_L(0); PG8_BAR; PG8_MMA(1, 0, At, B0); PG8_MMA(1, 1, At, B1); PG8_BAR; PG8_SCHED;
        }
        if (wr == 0) PG8_BAR;
        E(acc, cur, wr, wc, fr, fq);
        if (!has_next) break;
#pragma unroll
        for (int a = 0; a < 2; ++a)
#pragma unroll
            for (int b = 0; b < 2; ++b)
#pragma unroll
                for (int m = 0; m < 4; ++m)
#pragma unroll
                    for (int n = 0; n < 2; ++n) acc[a][b][m][n] = (f32x4){0.f, 0.f, 0.f, 0.f};
        cur = nxt; cA = nA; cB = nB; ++ui;
        if (wr == 1) PG8_BAR;
    }
    PG8_WAIT_V(0);
    PG8_BAR;
#undef PG8_SA
#undef PG8_SB
#undef PG8_STAGE
#undef PG8_LDA
#undef PG8_LDB
#undef PG8_MMA
#undef PG8_WAIT_V
#undef PG8_WAIT_L
#undef PG8_BAR
#undef PG8_SCHED
}

struct EpiProj {
    static constexpr bool PERM = true;
    bf16_t* O;
    __device__ __forceinline__ void operator()(const f32x4 (&acc)[2][2][4][2], const Unit& u, int wr, int wc, int fr, int fq) const {
        const int row0 = u.pm * BM + wr * 64 + fr, col0 = u.pn * BM + wc * 32 + 8 * fq;
#pragma unroll
        for (int ai = 0; ai < 2; ++ai)
#pragma unroll
            for (int m = 0; m < 4; ++m) { bf16_t* rowp = O + (size_t)(row0 + ai * HALF + m * 16) * INP + col0;
#pragma unroll
                for (int bj = 0; bj < 2; ++bj) { const f32x4 v0 = acc[ai][bj][m][0], v1 = acc[ai][bj][m][1];
                    u32x4 w; w.x = cvt_pk_bf16(v0[0], v0[1]); w.y = cvt_pk_bf16(v0[2], v0[3]); w.z = cvt_pk_bf16(v1[0], v1[1]); w.w = cvt_pk_bf16(v1[2], v1[3]);
                    *(u32x4*)(rowp + bj * HALF) = w; } }
    }
};
struct EpiUq {
    static constexpr bool PERM = false;
    bf16_t* O; const float* tcos; const float* tsin;
    __device__ __forceinline__ void operator()(const f32x4 (&acc)[2][2][4][2], const Unit& u, int wr, int wc, int fr, int fq) const {
        const int row0 = u.pm * BM + wr * 64 + fr;
#pragma unroll
        for (int bj = 0; bj < 2; ++bj) {
            const int cg = u.pn * BM + bj * HALF + wc * 32, w = cg % 192;
            const int axis = (w == 128) ? 0 : ((w == 160) ? 1 : -1);
#pragma unroll
            for (int ai = 0; ai < 2; ++ai)
#pragma unroll
                for (int m = 0; m < 4; ++m) {
                    const int r = row0 + ai * HALF + m * 16, s = r & (S - 1);
                    f32x4 x1 = acc[ai][bj][m][0], x2 = acc[ai][bj][m][1];
                    if (axis >= 0) {
                        const int idx = axis ? (s & 63) : (s >> 6);
                        const f32x4 c = *(const f32x4*)(tcos + idx * 16 + 4 * fq), sn = *(const f32x4*)(tsin + idx * 16 + 4 * fq);
                        const f32x4 o1 = x1 * c - x2 * sn, o2 = x1 * sn + x2 * c; x1 = o1; x2 = o2;
                    }
                    bf16_t* rowp = O + (size_t)r * 768 + cg + 4 * fq;
                    u32x2 w0, w1; w0.x = cvt_pk_bf16(x1[0], x1[1]); w0.y = cvt_pk_bf16(x1[2], x1[3]); w1.x = cvt_pk_bf16(x2[0], x2[1]); w1.y = cvt_pk_bf16(x2[2], x2[3]);
                    *(u32x2*)(rowp) = w0; *(u32x2*)(rowp + 16) = w1;
                }
        }
    }
};
struct EpiUkv {
    static constexpr bool PERM = true;
    bf16_t* KB; bf16_t* VB;
    __device__ __forceinline__ void operator()(const f32x4 (&acc)[2][2][4][2], const Unit& u, int wr, int wc, int fr, int fq) const {
        const int row0 = u.pm * BM + wr * 64 + fr, cin = wc * 32 + 8 * fq;
#pragma unroll
        for (int ai = 0; ai < 2; ++ai)
#pragma unroll
            for (int m = 0; m < 4; ++m) { const size_t r = (size_t)(row0 + ai * HALF + m * 16);
#pragma unroll
                for (int bj = 0; bj < 2; ++bj) { const f32x4 v0 = acc[ai][bj][m][0], v1 = acc[ai][bj][m][1];
                    u32x4 w; w.x = cvt_pk_bf16(v0[0], v0[1]); w.y = cvt_pk_bf16(v0[2], v0[3]); w.z = cvt_pk_bf16(v1[0], v1[1]); w.w = cvt_pk_bf16(v1[2], v1[3]);
                    bf16_t* dst = bj == 0 ? (KB + r * 768 + u.pn * 192 + cin) : (VB + r * 512 + u.pn * 128 + cin);
                    *(u32x4*)dst = w; } }
    }
};
struct EpiResid {
    static constexpr bool PERM = false;
    const float* in; float* out; const float* gate;
    __device__ __forceinline__ void operator()(const f32x4 (&acc)[2][2][4][2], const Unit& u, int wr, int wc, int fr, int fq) const {
        const int row0 = u.pm * BM + wr * 64 + fr, col0 = u.pn * BM + wc * 32 + 4 * fq;
        const float* gb = gate + (size_t)(u.pm >> 3) * MODW + col0;
        f32x4 gv[2][2];
#pragma unroll
        for (int bj = 0; bj < 2; ++bj)
#pragma unroll
            for (int n = 0; n < 2; ++n) gv[bj][n] = *(const f32x4*)(gb + bj * HALF + n * 16);
#pragma unroll
        for (int ai = 0; ai < 2; ++ai)
#pragma unroll
            for (int m = 0; m < 4; ++m) { const size_t off = (size_t)(row0 + ai * HALF + m * 16) * D + col0;
#pragma unroll
                for (int bj = 0; bj < 2; ++bj)
#pragma unroll
                    for (int n = 0; n < 2; ++n) { const f32x4 bs = *(const f32x4*)(in + off + bj * HALF + n * 16);
                        *(f32x4*)(out + off + bj * HALF + n * 16) = bs + gv[bj][n] * acc[ai][bj][m][n]; }
                asm volatile("" ::: "memory"); }
    }
};
struct EpiSwiglu {
    static constexpr bool PERM = true;
    bf16_t* O;
    __device__ __forceinline__ void operator()(const f32x4 (&acc)[2][2][4][2], const Unit& u, int wr, int wc, int fr, int fq) const {
        const int row0 = u.pm * BM + wr * 64 + fr, col0 = u.pn * HALF + wc * 32 + 8 * fq;
#pragma unroll
        for (int ai = 0; ai < 2; ++ai)
#pragma unroll
            for (int m = 0; m < 4; ++m) { bf16_t* rowp = O + (size_t)(row0 + ai * HALF + m * 16) * FF + col0;
                f32x4 h0, h1;
#pragma unroll
                for (int j = 0; j < 4; ++j) { h0[j] = silu_f(acc[ai][0][m][0][j]) * acc[ai][1][m][0][j]; h1[j] = silu_f(acc[ai][0][m][1][j]) * acc[ai][1][m][1][j]; }
                u32x4 w; w.x = cvt_pk_bf16(h0[0], h0[1]); w.y = cvt_pk_bf16(h0[2], h0[3]); w.z = cvt_pk_bf16(h1[0], h1[1]); w.w = cvt_pk_bf16(h1[2], h1[3]);
                *(u32x4*)rowp = w; }
    }
};
}

namespace att {
constexpr int NW = 8, QBLK = 32, KVBLK = 64, DV = 128;
constexpr float THR = 8.f;
#define SBAR() __builtin_amdgcn_sched_barrier(0)
__device__ __forceinline__ int crow(int r, int hi) { return (r & 3) + 8 * (r >> 2) + 4 * hi; }
__device__ __forceinline__ unsigned cvtpk(float lo, float hi) { unsigned r; asm volatile("v_cvt_pk_bf16_f32 %0, %1, %2" : "=v"(r) : "v"(lo), "v"(hi)); return r; }

template <int DK> struct Cfg {
    static constexpr float SCALE = (DK == 128) ? 0.088388347648318440f : 0.072168783648703220f;
    static constexpr int KROWB = DK * 2;
    static constexpr int SHM_V = KVBLK * DV * 2, SHM_K = KVBLK * DK * 2;
    static constexpr int SHM = 2 * SHM_V + 2 * SHM_K + NW * 64 * 4;
    static constexpr int NKC = DK / 64;
    static constexpr int ND0 = DK / 16;
};
template <int DK> __device__ __forceinline__ int kswz(int row, int colB) { return row * (DK * 2) + (colB ^ ((row & 7) << 4)); }

template <int DK>
__device__ __forceinline__ void partialSM(f32x16& p0, f32x16& p1, float& m_reg, float& mn, float& alpha) {
    constexpr float SCALE = Cfg<DK>::SCALE;
    constexpr float C = SCALE * 1.4426950408889634f;
    float pmax = p0[0];
#pragma unroll
    for (int r = 1; r < 16; ++r) pmax = fmaxf(pmax, p0[r]);
#pragma unroll
    for (int r = 0; r < 16; ++r) pmax = fmaxf(pmax, p1[r]);
    { auto rr = __builtin_amdgcn_permlane32_swap(__float_as_uint(pmax), __float_as_uint(pmax), false, false);
      pmax = fmaxf(__uint_as_float(rr[0]), __uint_as_float(rr[1])); }
    if (__builtin_expect(__all(pmax - m_reg <= THR / SCALE), 1)) { mn = m_reg; alpha = 1.f; }
    else { mn = fmaxf(m_reg, pmax); alpha = __builtin_amdgcn_exp2f((m_reg - mn) * C); m_reg = mn; }
    float mnC = -mn * C;
#pragma unroll
    for (int r = 0; r < 16; ++r) p0[r] = fmaf(p0[r], C, mnC);
#pragma unroll
    for (int r = 0; r < 16; ++r) p1[r] = fmaf(p1[r], C, mnC);
#pragma unroll
    for (int r = 0; r < 16; ++r) p0[r] = __builtin_amdgcn_exp2f(p0[r]);
}
__device__ __forceinline__ void finishSM(f32x16& p0, f32x16& p1, float alpha, float& l_reg, bf16x8& pa0, bf16x8& pa1, bf16x8& pa2, bf16x8& pa3) {
#pragma unroll
    for (int r = 0; r < 16; ++r) p1[r] = __builtin_amdgcn_exp2f(p1[r]);
    float ps = 0;
#pragma unroll
    for (int r = 0; r < 16; ++r) ps += p0[r];
#pragma unroll
    for (int r = 0; r < 16; ++r) ps += p1[r];
    { auto rr = __builtin_amdgcn_permlane32_swap(__float_as_uint(ps), __float_as_uint(ps), false, false);
      ps = __uint_as_float(rr[0]) + __uint_as_float(rr[1]); }
    l_reg = l_reg * alpha + ps;
#define PK4(P, BASE, OUT) do { unsigned a0 = cvtpk(P[BASE + 0], P[BASE + 1]), a1 = cvtpk(P[BASE + 2], P[BASE + 3]);   \
    unsigned b0 = cvtpk(P[BASE + 4], P[BASE + 5]), b1 = cvtpk(P[BASE + 6], P[BASE + 7]);                              \
    auto r0 = __builtin_amdgcn_permlane32_swap(a0, b0, false, false); auto r1 = __builtin_amdgcn_permlane32_swap(a1, b1, false, false); \
    u32x4 w = {r0[0], r1[0], r0[1], r1[1]}; OUT = *reinterpret_cast<bf16x8*>(&w); } while (0)
    PK4(p0, 0, pa0); PK4(p0, 8, pa1); PK4(p1, 0, pa2); PK4(p1, 8, pa3);
#undef PK4
}
template <int DK>
__device__ __forceinline__ void qkt(f32x16& p0, f32x16& p1, const char* Ks, const bf16x8* qr, int r32, int hi) {
    p0 = f32x16{}; p1 = f32x16{};
#pragma unroll
    for (int d0 = 0; d0 < Cfg<DK>::ND0; ++d0) { int cb = (d0 * 16 + hi * 8) * 2;
        bf16x8 b0 = *reinterpret_cast<const bf16x8*>(Ks + kswz<DK>(r32, cb));
        bf16x8 b1 = *reinterpret_cast<const bf16x8*>(Ks + kswz<DK>(32 + r32, cb));
        p0 = __builtin_amdgcn_mfma_f32_32x32x16_bf16(b0, qr[d0], p0, 0, 0, 0);
        p1 = __builtin_amdgcn_mfma_f32_32x32x16_bf16(b1, qr[d0], p1, 0, 0, 0); }
}
__device__ __forceinline__ int v_st(int k, int c) { const int kk = (k & ~0xC) | ((k & 4) << 1) | ((k & 8) >> 1); return ((kk >> 3) * 4 + (c >> 5)) * 512 + ((kk & 7) * 32 + (c & 31)) * 2; }
__device__ __forceinline__ int v_rd_base(int lane) { return ((lane & 3) << 3) | (((lane >> 2) & 3) << 6) | (((lane >> 4) & 1) << 5) | (((lane >> 5) & 1) << 8); }
constexpr int v_rd_off(int d0, int ks, int half) { return d0 * 512 + ks * 4096 + half * 2048; }
template <int OFF> __device__ __forceinline__ s16x4 tr_read(int vb) {
    s16x4 r; asm volatile("ds_read_b64_tr_b16 %0, %1 offset:%2" : "=&v"(r) : "v"(vb), "i"(OFF) : "memory"); return r;
}
template <int D0> __device__ __forceinline__ void pv_one(f32x16& od, int vb, bf16x8 pa0, bf16x8 pa1, bf16x8 pa2, bf16x8 pa3) {
    const s16x4 l0 = tr_read<v_rd_off(D0, 0, 0)>(vb), h0 = tr_read<v_rd_off(D0, 0, 1)>(vb), l1 = tr_read<v_rd_off(D0, 1, 0)>(vb), h1 = tr_read<v_rd_off(D0, 1, 1)>(vb);
    const s16x4 l2 = tr_read<v_rd_off(D0, 2, 0)>(vb), h2 = tr_read<v_rd_off(D0, 2, 1)>(vb), l3 = tr_read<v_rd_off(D0, 3, 0)>(vb), h3 = tr_read<v_rd_off(D0, 3, 1)>(vb);
    asm volatile("s_waitcnt lgkmcnt(0)" ::: "memory"); SBAR();
#define PK(L, H) (bf16x8){L[0], L[1], L[2], L[3], H[0], H[1], H[2], H[3]}
    od = __builtin_amdgcn_mfma_f32_32x32x16_bf16(pa0, PK(l0, h0), od, 0, 0, 0);
    od = __builtin_amdgcn_mfma_f32_32x32x16_bf16(pa1, PK(l1, h1), od, 0, 0, 0);
    od = __builtin_amdgcn_mfma_f32_32x32x16_bf16(pa2, PK(l2, h2), od, 0, 0, 0);
    od = __builtin_amdgcn_mfma_f32_32x32x16_bf16(pa3, PK(l3, h3), od, 0, 0, 0);
#undef PK
}
__device__ __forceinline__ void pv_d0(f32x16* o, int vb, bf16x8 pa0, bf16x8 pa1, bf16x8 pa2, bf16x8 pa3) {
    pv_one<0>(o[0], vb, pa0, pa1, pa2, pa3); pv_one<1>(o[1], vb, pa0, pa1, pa2, pa3); pv_one<2>(o[2], vb, pa0, pa1, pa2, pa3); pv_one<3>(o[3], vb, pa0, pa1, pa2, pa3);
}

template <int DK, int LDQ, int LDK, int LDV, int LDO, int SDEPTH>
__device__ __forceinline__ void attn_dense_body(const bf16_t* __restrict__ Qb, const bf16_t* __restrict__ Kh, const bf16_t* __restrict__ Vh,
                                                bf16_t* __restrict__ Ob, int seq, char* lds) {
    using C = Cfg<DK>;
    constexpr int SHM_V = C::SHM_V, SHM_K = C::SHM_K, NKC = C::NKC, ND0 = C::ND0;
    const int tid = opaque_tid(), wid = tid >> 6, lane = tid & 63, r32 = lane & 31, hi = lane >> 5;
    char* V_lds = lds; char* K_lds = lds + 2 * SHM_V;
    float* ws = (float*)(lds + 2 * SHM_V + 2 * SHM_K) + wid * 64; float* li_l = ws; float* al_l = ws + 32;
    float m_reg = -1e30f, l_reg = 0; f32x16 o[4] = {}; bf16x8 qr[ND0];
    const bf16_t* Qw = Qb + (long)(wid * QBLK + r32) * LDQ + hi * 8;
#pragma unroll
    for (int d0 = 0; d0 < ND0; ++d0) qr[d0] = *reinterpret_cast<const bf16x8*>(Qw + d0 * 16);
    const int sr = tid >> 4, sc = (tid & 15) * 8, vst0 = v_st(sr, sc), vst1 = v_st(32 + sr, sc);
    int kgo[NKC], klo[NKC];
#pragma unroll
    for (int c = 0; c < NKC; ++c) { const int id = tid + 512 * c, kr = id / (DK / 8), kc = id % (DK / 8); kgo[c] = kr * LDK + kc * 8; klo[c] = kswz<DK>(kr, kc * 16); }
    const int vb0 = (int)(uintptr_t)V_lds + v_rd_base(lane);
    struct { bf16x8 vs0, vs1, ks[NKC]; } sr_[SDEPTH];
#define SLOAD(i, k0) do { sr_[i].vs0 = *reinterpret_cast<const bf16x8*>(&Vh[(long)((k0) + sr) * LDV + sc]); sr_[i].vs1 = *reinterpret_cast<const bf16x8*>(&Vh[(long)((k0) + 32 + sr) * LDV + sc]); \
    _Pragma("unroll") for (int c_ = 0; c_ < NKC; ++c_) sr_[i].ks[c_] = *reinterpret_cast<const bf16x8*>(&Kh[(long)(k0) * LDK + kgo[c_]]); } while (0)
#define SWRITE(b, i) do { *(bf16x8*)(V_lds + (b) * SHM_V + vst0) = sr_[i].vs0; *(bf16x8*)(V_lds + (b) * SHM_V + vst1) = sr_[i].vs1; \
    _Pragma("unroll") for (int c_ = 0; c_ < NKC; ++c_) *(bf16x8*)(K_lds + (b) * SHM_K + klo[c_]) = sr_[i].ks[c_]; } while (0)
#define SWAIT() do { if constexpr (SDEPTH == 2) { if constexpr (NKC == 2) asm volatile("s_waitcnt vmcnt(4)" ::: "memory"); else asm volatile("s_waitcnt vmcnt(5)" ::: "memory"); } \
    else asm volatile("s_waitcnt vmcnt(0)" ::: "memory"); } while (0)
#define RESC(a) do { if (__any((a) < 1.f)) { if (hi == 0) al_l[r32] = (a); asm volatile("s_waitcnt lgkmcnt(0)" ::: "memory"); \
    _Pragma("unroll") for (int d = 0; d < 4; ++d) _Pragma("unroll") for (int r = 0; r < 16; ++r) o[d][r] *= al_l[crow(r, hi)]; } } while (0)
    f32x16 pA0, pA1, pB0, pB1; float mnA, mnB, alA, alB; bf16x8 pa0, pa1, pa2, pa3; const int NT = seq / KVBLK;
    constexpr int SE = 0, SO = SDEPTH - 1;
    SLOAD(SE, 0); asm volatile("s_waitcnt vmcnt(0)" ::: "memory"); SWRITE(0, SE); __syncthreads();
    qkt<DK>(pA0, pA1, K_lds, qr, r32, hi); partialSM<DK>(pA0, pA1, m_reg, mnA, alA);
    SLOAD(SO, KVBLK); if constexpr (SDEPTH == 2) { if (2 < NT) SLOAD(SE, 2 * KVBLK); }
    SWAIT(); SWRITE(1, SO); __syncthreads();
    for (int j = 1; j + 1 < NT; j += 2) {
        SBAR(); qkt<DK>(pB0, pB1, K_lds + SHM_K, qr, r32, hi);
        finishSM(pA0, pA1, alA, l_reg, pa0, pa1, pa2, pa3); SBAR();
        SLOAD(SO, (j + SDEPTH) * KVBLK); SBAR();
        pv_d0(o, vb0, pa0, pa1, pa2, pa3); partialSM<DK>(pB0, pB1, m_reg, mnB, alB);
        __syncthreads(); SWAIT(); SWRITE(0, SE);
        RESC(alB); __syncthreads();
        SBAR(); qkt<DK>(pA0, pA1, K_lds, qr, r32, hi);
        finishSM(pB0, pB1, alB, l_reg, pa0, pa1, pa2, pa3); SBAR();
        if (SDEPTH == 1 || j + 3 < NT) SLOAD(SE, (j + 1 + SDEPTH) * KVBLK); SBAR();
        pv_d0(o, vb0 + (int)SHM_V, pa0, pa1, pa2, pa3); partialSM<DK>(pA0, pA1, m_reg, mnA, alA);
        __syncthreads(); SWAIT(); SWRITE(1, SO);
        RESC(alA); __syncthreads();
    }
    SBAR(); qkt<DK>(pB0, pB1, K_lds + SHM_K, qr, r32, hi);
    finishSM(pA0, pA1, alA, l_reg, pa0, pa1, pa2, pa3); SBAR();
    pv_d0(o, vb0, pa0, pa1, pa2, pa3); partialSM<DK>(pB0, pB1, m_reg, mnB, alB);
    __syncthreads(); RESC(alB);
    finishSM(pB0, pB1, alB, l_reg, pa0, pa1, pa2, pa3); SBAR();
    pv_d0(o, vb0 + (int)SHM_V, pa0, pa1, pa2, pa3);
    if (hi == 0) li_l[r32] = l_reg; asm volatile("s_waitcnt lgkmcnt(0)" ::: "memory");
    float rli[16];
#pragma unroll
    for (int r = 0; r < 16; ++r) rli[r] = __builtin_amdgcn_rcpf(li_l[crow(r, hi)]);
    bf16_t* Ow = Ob + (long)(wid * QBLK) * LDO;
#pragma unroll
    for (int r = 0; r < 16; ++r) { int orow = crow(r, hi);
#pragma unroll
        for (int d0 = 0; d0 < 4; ++d0) Ow[(long)orow * LDO + d0 * 32 + r32] = f2bf(o[d0][r] * rli[r]); }
#undef SLOAD
#undef SWRITE
#undef SWAIT
#undef RESC
}

template <int DK, int LDQ, int LDK, int LDV, int LDO>
__device__ __forceinline__ void attn_simple_body(const bf16_t* __restrict__ Qb, const bf16_t* __restrict__ Kh, const bf16_t* __restrict__ Vh,
                                                 bf16_t* __restrict__ Ob, int seq, char* lds) {
    using C = Cfg<DK>;
    constexpr int SHM_V = C::SHM_V, SHM_K = C::SHM_K, NKC = C::NKC, ND0 = C::ND0;
    const int tid = opaque_tid(), wid = tid >> 6, lane = tid & 63, r32 = lane & 31, hi = lane >> 5;
    char* V_lds = lds; char* K_lds = lds + 2 * SHM_V;
    float* ws = (float*)(lds + 2 * SHM_V + 2 * SHM_K) + wid * 64; float* li_l = ws; float* al_l = ws + 32;
    float m_reg = -1e30f, l_reg = 0; f32x16 o[4] = {}; bf16x8 qr[ND0];
    const bf16_t* Qw = Qb + (long)(wid * QBLK + r32) * LDQ + hi * 8;
#pragma unroll
    for (int d0 = 0; d0 < ND0; ++d0) qr[d0] = *reinterpret_cast<const bf16x8*>(Qw + d0 * 16);
    const int sr = tid >> 4, sc = (tid & 15) * 8, vst0 = v_st(sr, sc), vst1 = v_st(32 + sr, sc);
    const int vb0 = (int)(uintptr_t)V_lds + v_rd_base(lane);
    bf16x8 vs0, vs1, ks[NKC];
#define SLOAD1(k0) do { vs0 = *reinterpret_cast<const bf16x8*>(&Vh[(long)((k0) + sr) * LDV + sc]); vs1 = *reinterpret_cast<const bf16x8*>(&Vh[(long)((k0) + 32 + sr) * LDV + sc]); \
    _Pragma("unroll") for (int c_ = 0; c_ < NKC; ++c_) { const int id_ = tid + 512 * c_, kr_ = id_ / (DK / 8), kc_ = id_ % (DK / 8); ks[c_] = *reinterpret_cast<const bf16x8*>(&Kh[(long)((k0) + kr_) * LDK + kc_ * 8]); } } while (0)
#define SWRITE1(b) do { *(bf16x8*)(V_lds + (b) * SHM_V + vst0) = vs0; *(bf16x8*)(V_lds + (b) * SHM_V + vst1) = vs1; \
    _Pragma("unroll") for (int c_ = 0; c_ < NKC; ++c_) { const int id_ = tid + 512 * c_, kr_ = id_ / (DK / 8), kc_ = id_ % (DK / 8); *(bf16x8*)(K_lds + (b) * SHM_K + kswz<DK>(kr_, kc_ * 16)) = ks[c_]; } } while (0)
    f32x16 pA0, pA1; float mnA, alA; bf16x8 pa0, pa1, pa2, pa3; const int NT = seq / KVBLK;
    SLOAD1(0); asm volatile("s_waitcnt vmcnt(0)" ::: "memory"); SWRITE1(0); __syncthreads();
    for (int j = 0; j < NT; ++j) {
        const int cb = j & 1;
        if (j + 1 < NT) SLOAD1((j + 1) * KVBLK);
        SBAR(); qkt<DK>(pA0, pA1, K_lds + cb * SHM_K, qr, r32, hi);
        partialSM<DK>(pA0, pA1, m_reg, mnA, alA);
        if (__any(alA < 1.f)) { if (hi == 0) al_l[r32] = alA; asm volatile("s_waitcnt lgkmcnt(0)" ::: "memory");
#pragma unroll
            for (int d = 0; d < 4; ++d)
#pragma unroll
                for (int r = 0; r < 16; ++r) o[d][r] *= al_l[crow(r, hi)]; }
        finishSM(pA0, pA1, alA, l_reg, pa0, pa1, pa2, pa3); SBAR();
        pv_d0(o, vb0 + cb * SHM_V, pa0, pa1, pa2, pa3);
        if (j + 1 < NT) { SWRITE1(cb ^ 1); }
        __syncthreads();
    }
    if (hi == 0) li_l[r32] = l_reg; asm volatile("s_waitcnt lgkmcnt(0)" ::: "memory");
    float rli[16];
#pragma unroll
    for (int r = 0; r < 16; ++r) rli[r] = __builtin_amdgcn_rcpf(li_l[crow(r, hi)]);
    bf16_t* Ow = Ob + (long)(wid * QBLK) * LDO;
#pragma unroll
    for (int r = 0; r < 16; ++r) { int orow = crow(r, hi);
#pragma unroll
        for (int d0 = 0; d0 < 4; ++d0) Ow[(long)orow * LDO + d0 * 32 + r32] = f2bf(o[d0][r] * rli[r]); }
#undef SLOAD1
#undef SWRITE1
}
}

__device__ __forceinline__ void transpose_item(const float* W, int K, int N, int NPAD, bf16_t* WT, int mode, LAS float* scr, int item, int) {
    const int lane = opaque_tid() & 63;
    const int nblk = NPAD / 32, kb = item / nblk, nb = item % nblk, k0 = 64 * kb, n0 = 32 * nb;
    const int ncol = n0 + (lane & 31); const bool okc = ncol < N;
#pragma unroll
    for (int i = 0; i < 32; ++i) { const int kk = 2 * i + (lane >> 5); scr[kk * 33 + (lane & 31)] = okc ? W[(size_t)(k0 + kk) * N + ncol] : 0.f; }
    LDS_WAIT(); asm volatile("" ::: "memory");
    const int c = lane & 7;
#pragma unroll
    for (int j = 0; j < 4; ++j) { const int n = (lane >> 3) + 8 * j; const LAS float* s = scr + (8 * c) * 33 + n;
        u32x4 o; o.x = cvt_pk_bf16(s[0 * 33], s[1 * 33]); o.y = cvt_pk_bf16(s[2 * 33], s[3 * 33]); o.z = cvt_pk_bf16(s[4 * 33], s[5 * 33]); o.w = cvt_pk_bf16(s[6 * 33], s[7 * 33]);
        int nn = n0 + n, drow = nn;
        if (mode == 1) { drow = (nn < FF) ? ((nn >> 7) * 256 + (nn & 127)) : (((nn - FF) >> 7) * 256 + 128 + ((nn - FF) & 127)); }
        *(u32x4*)(WT + (size_t)drow * K + k0 + 8 * c) = o; }
    LDS_WAIT(); asm volatile("" ::: "memory");
}

__device__ __forceinline__ void mod_item(const Params& p, int item, LAS float* ldsf, int) {
    const int tid = opaque_tid();
    const int l = item / 192, col0 = (item % 192) * 64, wave = tid >> 6, lane = tid & 63;
    const float* cin = p.in[1]; const float* wada = p.in[2] + (size_t)l * D * MODW; const float* bada = p.in[3] + (size_t)l * MODW;
    float* mod = (float*)(p.ws + WS_MOD) + (size_t)l * NB * MODW;
    __syncthreads();
    for (int i = 0; i < 64; ++i) { const int idx = tid + 512 * i, b = idx >> 11, k = idx & 2047; ldsf[k * 16 + b] = silu_f(cin[idx]); }
    __syncthreads();
    float acc[16];
#pragma unroll
    for (int b = 0; b < 16; ++b) acc[b] = 0.f;
    const float* wp = wada + (size_t)(wave * 256) * MODW + col0 + lane;
    for (int k0 = 0; k0 < 256; k0 += 16) {
        float wv[16];
#pragma unroll
        for (int u = 0; u < 16; ++u) wv[u] = __builtin_nontemporal_load(wp + (size_t)(k0 + u) * MODW);
#pragma unroll
        for (int u = 0; u < 16; ++u) {
            const LAS f32x4* sp = (const LAS f32x4*)(ldsf + (wave * 256 + k0 + u) * 16);
#pragma unroll
            for (int q = 0; q < 4; ++q) { const f32x4 s4 = sp[q];
#pragma unroll
                for (int j = 0; j < 4; ++j) acc[q * 4 + j] = fmaf(s4[j], wv[u], acc[q * 4 + j]); }
        }
    }
    __syncthreads();
#pragma unroll
    for (int b = 0; b < 16; ++b) ldsf[(wave * 16 + b) * 64 + lane] = acc[b];
    __syncthreads();
#pragma unroll
    for (int q = 0; q < 2; ++q) { const int o = tid + 512 * q, b = o >> 6, cl = o & 63; float s = 0.f;
#pragma unroll
        for (int w = 0; w < 8; ++w) s += ldsf[(w * 16 + b) * 64 + cl];
        mod[(size_t)b * MODW + col0 + cl] = s + bada[col0 + cl]; }
    __syncthreads();
}

__device__ __forceinline__ void norm_mod_phase(const float* x, const float* g, const float* modl, int shift_off, int scale_off, bf16_t* outp, int gw, int NGW, int) {
    const int lane = opaque_tid() & 63; gw = opaque_s(gw);
    for (int row = gw; row < T; row += NGW) {
        const int b = row >> 11;
        const f32x4* xr = (const f32x4*)(x + (size_t)row * D) + lane;
        f32x4 v[8]; float ss = 0.f;
#pragma unroll
        for (int j = 0; j < 8; ++j) { v[j] = xr[64 * j]; ss += (v[j][0] * v[j][0] + v[j][1] * v[j][1]) + (v[j][2] * v[j][2] + v[j][3] * v[j][3]); }
        ss = wave_sum(ss);
        const float rstd = rsqrtf(ss * (1.f / D) + EPS);
        const float* mb = modl + (size_t)b * MODW;
#pragma unroll
        for (int j = 0; j < 8; ++j) { const int c = (lane + 64 * j) * 4;
            const f32x4 g4 = *(const f32x4*)(g + c), sc4 = *(const f32x4*)(mb + scale_off + c), sh4 = *(const f32x4*)(mb + shift_off + c);
            const f32x4 y = (v[j] * rstd) * g4 * (sc4 + 1.f) + sh4;
            u32x2 w; w.x = cvt_pk_bf16(y[0], y[1]); w.y = cvt_pk_bf16(y[2], y[3]);
            *(u32x2*)(outp + (size_t)row * D + c) = w; }
    }
}

__device__ __forceinline__ void prep_phase(const Params& p, int layer, int gw, int NGW, int) {
    const int lane = opaque_tid() & 63; gw = opaque_s(gw);
    bf16_t* proj = (bf16_t*)(p.ws + WS_PROJ);
    bf16_t* KB = (bf16_t*)(p.ws + WS_KB); bf16_t* XBC = (bf16_t*)(p.ws + WS_XBC); float* DT = (float*)(p.ws + WS_DT);
    const float* tab = (const float*)(p.ws + WS_TAB);
    const float* tAc = tab, *tAs = tab + 2048, *tBc = tab + 4096, *tBs = tab + 4096 + 1024;
    const float* qg = p.in[7] + layer * 128; const float* kg = p.in[8] + layer * 128;
    const float* cqg = p.in[9] + layer * 512; const float* ckvg = p.in[11] + layer * 256;
    const float* convw = p.in[13] + (size_t)layer * 5 * 1280; const float* convb = p.in[14] + layer * 1280;
    const float* dtbias = p.in[15] + layer * 24;
    for (int row = gw; row < T; row += NGW) {
        const int s = row & (S - 1), ri = s >> 6, ci = s & 63;
        bf16_t* pr = proj + (size_t)row * INP;
        {
            const int e = lane + (lane & 32), axis = lane >> 5, fi = lane & 31, idx = axis ? ci : ri;
            const float cs = tAc[idx * 32 + fi], sn = tAs[idx * 32 + fi];
#pragma unroll
            for (int hh = 0; hh < 8; ++hh) {
                bf16_t* base = pr + 128 * hh;
                float x1 = bf2f(base[e]), x2 = bf2f(base[e + 32]);
                const float ss = wave_sum(x1 * x1 + x2 * x2);
                const float r = rsqrtf(ss * (1.f / 128.f) + EPS);
                const float* gg = hh < 6 ? qg : kg;
                x1 = x1 * r * gg[e]; x2 = x2 * r * gg[e + 32];
                base[e] = f2bf(x1 * cs - x2 * sn); base[e + 32] = f2bf(x1 * sn + x2 * cs);
            }
        }
        {
            bf16_t* base = pr + C_CQ + lane * 8;
            const bf16x8 v = *(const bf16x8*)base; float f[8]; float ss = 0.f;
#pragma unroll
            for (int j = 0; j < 8; ++j) { f[j] = bfs2f(v[j]); ss += f[j] * f[j]; }
            ss = wave_sum(ss); const float r = rsqrtf(ss * (1.f / 512.f) + EPS);
            const f32x4 g0 = *(const f32x4*)(cqg + lane * 8), g1 = *(const f32x4*)(cqg + lane * 8 + 4);
            u32x4 w; w.x = cvt_pk_bf16(f[0] * r * g0[0], f[1] * r * g0[1]); w.y = cvt_pk_bf16(f[2] * r * g0[2], f[3] * r * g0[3]);
            w.z = cvt_pk_bf16(f[4] * r * g1[0], f[5] * r * g1[1]); w.w = cvt_pk_bf16(f[6] * r * g1[2], f[7] * r * g1[3]);
            *(u32x4*)base = w;
        }
        {
            bf16_t* base = pr + C_CKV + lane * 4;
            const s16x4 v = *(const s16x4*)base; float f[4]; float ss = 0.f;
#pragma unroll
            for (int j = 0; j < 4; ++j) { f[j] = bfs2f(v[j]); ss += f[j] * f[j]; }
            ss = wave_sum(ss); const float r = rsqrtf(ss * (1.f / 256.f) + EPS);
            const f32x4 g0 = *(const f32x4*)(ckvg + lane * 4);
            u32x2 w; w.x = cvt_pk_bf16(f[0] * r * g0[0], f[1] * r * g0[1]); w.y = cvt_pk_bf16(f[2] * r * g0[2], f[3] * r * g0[3]);
            *(u32x2*)base = w;
        }
        if (lane < 32) {
            const int axis = lane >> 4, fi = lane & 15, e = fi + 32 * axis, idx = axis ? ci : ri;
            const float cs = tBc[idx * 16 + fi], sn = tBs[idx * 16 + fi];
            const float x1 = bf2f(pr[C_KPE + e]), x2 = bf2f(pr[C_KPE + e + 16]);
            const bf16_t o1 = f2bf(x1 * cs - x2 * sn), o2 = f2bf(x1 * sn + x2 * cs);
            bf16_t* kb = KB + (size_t)row * 768 + 128 + e;
#pragma unroll
            for (int hd = 0; hd < 4; ++hd) { kb[hd * 192] = o1; kb[hd * 192 + 16] = o2; }
        }
        {
#pragma unroll
            for (int j = 0; j < 5; ++j) {
                const int c = (j * 64 + lane) * 4;
                f32x4 a = *(const f32x4*)(convb + c);
#pragma unroll
                for (int k = 0; k < 5; ++k) {
                    const int s2 = s + k - 2;
                    if (s2 >= 0 && s2 < S) {
                        const s16x4 v = *(const s16x4*)(proj + (size_t)(row + k - 2) * INP + C_XBC + c);
                        const f32x4 w = *(const f32x4*)(convw + k * 1280 + c);
#pragma unroll
                        for (int q = 0; q < 4; ++q) a[q] = fmaf(w[q], bfs2f(v[q]), a[q]);
                    }
                }
                u32x2 o; o.x = cvt_pk_bf16(silu_f(a[0]), silu_f(a[1])); o.y = cvt_pk_bf16(silu_f(a[2]), silu_f(a[3]));
                *(u32x2*)(XBC + (size_t)row * 1280 + c) = o;
            }
        }
        if (lane < 24) {
            const float v = bf2f(pr[C_DT + lane]) + dtbias[lane];
            DT[(size_t)row * 24 + lane] = v > 20.f ? v : log1pf(expf(v));
        }
    }
}

__device__ __forceinline__ void ssd_item(const bf16_t* XBC, const float* DT, float* Y, float a_neg, int b, int dir, int h, LAS unsigned char* lds, int) {
    const int tid = opaque_tid();
    LAS float* Bs = (LAS float*)lds;
    LAS float* Cs = Bs + 4096;
    LAS float* Xs = Cs + 4096;
    LAS float* Ys = Xs + 2048;
    LAS float* dAs = Ys + 2048;
    LAS float* dts = dAs + 32;
    const int g = h / 6, pp = tid >> 3, nq = tid & 7, srow = tid >> 4, sc = tid & 15;
    const size_t rowbase = (size_t)b * S;
    float hst[16];
#pragma unroll
    for (int j = 0; j < 16; ++j) hst[j] = 0.f;
    bf16x8 rB, rC; s16x4 rX; float rdt = 0.f;
#define SSD_LOAD(blk) do { const int i_ = (blk) * 32 + srow, t_ = dir ? (S - 1 - i_) : i_; const bf16_t* rp_ = XBC + (rowbase + t_) * 1280; \
        rB = *(const bf16x8*)(rp_ + 768 + g * 128 + sc * 8); rC = *(const bf16x8*)(rp_ + 1024 + g * 128 + sc * 8); rX = *(const s16x4*)(rp_ + h * 64 + sc * 4); \
        if (tid < 32) { const int i2_ = (blk) * 32 + tid, t2_ = dir ? (S - 1 - i2_) : i2_; rdt = DT[(rowbase + t2_) * 24 + dir * 12 + h]; } } while (0)
#define SSD_STORE() do { f32x4 b0_, b1_, c0_, c1_, x_; \
        _Pragma("unroll") for (int k_ = 0; k_ < 4; ++k_) { b0_[k_] = bfs2f(rB[k_]); b1_[k_] = bfs2f(rB[4 + k_]); c0_[k_] = bfs2f(rC[k_]); c1_[k_] = bfs2f(rC[4 + k_]); x_[k_] = bfs2f(rX[k_]); } \
        *(LAS f32x4*)(Bs + srow * 128 + sc * 8) = b0_; *(LAS f32x4*)(Bs + srow * 128 + sc * 8 + 4) = b1_; \
        *(LAS f32x4*)(Cs + srow * 128 + sc * 8) = c0_; *(LAS f32x4*)(Cs + srow * 128 + sc * 8 + 4) = c1_; \
        *(LAS f32x4*)(Xs + srow * 64 + sc * 4) = x_; \
        if (tid < 32) { dts[tid] = rdt; dAs[tid] = expf(rdt * a_neg); } } while (0)
    SSD_LOAD(0); SSD_STORE(); __syncthreads();
    for (int blk = 0; blk < S / 32; ++blk) {
        if (blk + 1 < S / 32) SSD_LOAD(blk + 1);
        for (int i = 0; i < 32; ++i) {
            const float dAt = dAs[i], xdt = Xs[i * 64 + pp] * dts[i];
            float acc = 0.f;
#pragma unroll
            for (int j = 0; j < 4; ++j) {
                const f32x4 bv = *(const LAS f32x4*)(Bs + i * 128 + 32 * j + 4 * nq), cv = *(const LAS f32x4*)(Cs + i * 128 + 32 * j + 4 * nq);
#pragma unroll
                for (int k = 0; k < 4; ++k) { hst[4 * j + k] = fmaf(hst[4 * j + k], dAt, xdt * bv[k]); acc = fmaf(cv[k], hst[4 * j + k], acc); }
            }
            acc += __shfl_xor(acc, 1); acc += __shfl_xor(acc, 2); acc += __shfl_xor(acc, 4);
            if (nq == 0) Ys[i * 64 + pp] = acc;
        }
        __syncthreads();
        { const int i_ = blk * 32 + srow, t_ = dir ? (S - 1 - i_) : i_;
          *(f32x4*)(Y + (rowbase + t_) * 768 + h * 64 + sc * 4) = *(const LAS f32x4*)(Ys + srow * 64 + sc * 4); }
        if (blk + 1 < S / 32) SSD_STORE();
        __syncthreads();
    }
#undef SSD_LOAD
#undef SSD_STORE
}


namespace ssdm {
using namespace att;
__device__ __forceinline__ int v_st_e(int k, int c) { const int kk = (k & ~0xC) | ((k & 4) << 1) | ((k & 8) >> 1); return ((kk >> 3) * 4 + (c >> 5)) * 512 + ((kk & 7) * 32 + (c & 31)) * 2; }
__device__ __forceinline__ void upd_one(f32x16& acc, int vbA, int vbB) {
    const s16x4 al0 = tr_read<v_rd_off(0, 0, 0)>(vbA), ah0 = tr_read<v_rd_off(0, 0, 1)>(vbA), al1 = tr_read<v_rd_off(0, 1, 0)>(vbA), ah1 = tr_read<v_rd_off(0, 1, 1)>(vbA);
    const s16x4 al2 = tr_read<v_rd_off(0, 2, 0)>(vbA), ah2 = tr_read<v_rd_off(0, 2, 1)>(vbA), al3 = tr_read<v_rd_off(0, 3, 0)>(vbA), ah3 = tr_read<v_rd_off(0, 3, 1)>(vbA);
    const s16x4 bl0 = tr_read<v_rd_off(0, 0, 0)>(vbB), bh0 = tr_read<v_rd_off(0, 0, 1)>(vbB), bl1 = tr_read<v_rd_off(0, 1, 0)>(vbB), bh1 = tr_read<v_rd_off(0, 1, 1)>(vbB);
    const s16x4 bl2 = tr_read<v_rd_off(0, 2, 0)>(vbB), bh2 = tr_read<v_rd_off(0, 2, 1)>(vbB), bl3 = tr_read<v_rd_off(0, 3, 0)>(vbB), bh3 = tr_read<v_rd_off(0, 3, 1)>(vbB);
    asm volatile("s_waitcnt lgkmcnt(0)" ::: "memory"); SBAR();
#define PK(L, H) (bf16x8){L[0], L[1], L[2], L[3], H[0], H[1], H[2], H[3]}
    acc = __builtin_amdgcn_mfma_f32_32x32x16_bf16(PK(al0, ah0), PK(bl0, bh0), acc, 0, 0, 0);
    acc = __builtin_amdgcn_mfma_f32_32x32x16_bf16(PK(al1, ah1), PK(bl1, bh1), acc, 0, 0, 0);
    acc = __builtin_amdgcn_mfma_f32_32x32x16_bf16(PK(al2, ah2), PK(bl2, bh2), acc, 0, 0, 0);
    acc = __builtin_amdgcn_mfma_f32_32x32x16_bf16(PK(al3, ah3), PK(bl3, bh3), acc, 0, 0, 0);
#undef PK
}
__device__ __forceinline__ void ssd_item(const bf16_t* XBC, const float* DT, float* Y, float a_neg, int b, int dir, int h, char* shm) {
    const int tid = opaque_tid(), wid = tid >> 6, lane = tid & 63, r32 = lane & 31, hi = lane >> 5;
    const int rb = wid & 3, ph = wid >> 2, g = h / 6;
    char* Kimg = shm; char* BV = shm + 32768; char* XI = shm + 65536; char* SI = shm + 98304;
    float* acs_l = (float*)(shm + MISC_OFF + 256); float* dts_l = acs_l + 128;
    const int vbB = (int)(uintptr_t)BV + v_rd_base(lane), vbX = (int)(uintptr_t)XI + v_rd_base(lane), vbS = (int)(uintptr_t)SI + v_rd_base(lane);
    const size_t rowbase = (size_t)b * S;
#define TOK(i) (dir ? (S - 1 - (i)) : (i))
#pragma unroll
    for (int i = 0; i < 4; ++i) *(u32x4*)(SI + (tid + 512 * i) * 16) = (u32x4){0u, 0u, 0u, 0u};
    f32x16 Sacc = {};
    bf16x8 rB[4], rX[2]; float rdt = 0.f;
    const int srow = tid >> 2, scq = tid & 3;
#define SSDM_LOAD(c) do { \
        _Pragma("unroll") for (int i_ = 0; i_ < 4; ++i_) { const int id_ = tid + 512 * i_, row_ = id_ >> 4, c8_ = id_ & 15; \
            rB[i_] = *(const bf16x8*)(XBC + (rowbase + TOK((c) * 128 + row_)) * 1280 + 768 + g * 128 + c8_ * 8); } \
        { const bf16_t* xp_ = XBC + (rowbase + TOK((c) * 128 + srow)) * 1280 + h * 64 + scq * 16; rX[0] = *(const bf16x8*)xp_; rX[1] = *(const bf16x8*)(xp_ + 8); } \
        if (tid < 128) rdt = DT[(rowbase + TOK((c) * 128 + tid)) * 24 + dir * 12 + h]; } while (0)
    SSDM_LOAD(0);
    for (int c = 0; c < S / 128; ++c) {
        bf16x8 qr[8];
        { const bf16_t* cp = XBC + (rowbase + TOK(c * 128 + 32 * rb + r32)) * 1280 + 1024 + g * 128 + hi * 8;
#pragma unroll
          for (int d0 = 0; d0 < 8; ++d0) qr[d0] = *(const bf16x8*)(cp + d0 * 16); }
#pragma unroll
        for (int i = 0; i < 4; ++i) { const int id = tid + 512 * i, row = id >> 4, c8 = id & 15, tt = row >> 6, k = row & 63;
            *(bf16x8*)(Kimg + tt * 16384 + kswz<128>(k, c8 * 16)) = rB[i]; *(bf16x8*)(BV + tt * 16384 + v_st(k, c8 * 8)) = rB[i]; }
        if (tid < 128) dts_l[tid] = rdt;
        __syncthreads();
        int ln = lane; asm volatile("" : "+v"(ln));
        float x_lo = dts_l[ln] * a_neg, x_hi = dts_l[64 + ln] * a_neg;
#pragma unroll
        for (int o = 1; o < 64; o <<= 1) { const int ad = (ln - o) << 2;
            const float v0 = __int_as_float(__builtin_amdgcn_ds_bpermute(ad, __float_as_int(x_lo))), v1 = __int_as_float(__builtin_amdgcn_ds_bpermute(ad, __float_as_int(x_hi)));
            if (ln >= o) { x_lo += v0; x_hi += v1; } }
        x_hi += __int_as_float(__builtin_amdgcn_readlane(__float_as_int(x_lo), 63));
        const float acs_last = __int_as_float(__builtin_amdgcn_readlane(__float_as_int(x_hi), 63));
        if (wid == 0) { acs_l[ln] = x_lo; acs_l[64 + ln] = x_hi; }
        { const int sl = ((ln >> 2) + 16 * wid) & 63;
          const float as_lo = __int_as_float(__builtin_amdgcn_ds_bpermute(sl << 2, __float_as_int(x_lo))), as_hi = __int_as_float(__builtin_amdgcn_ds_bpermute(sl << 2, __float_as_int(x_hi)));
          const float acs_s = (srow < 64) ? as_lo : as_hi;
          const float dt_s = dts_l[srow], e_s = dt_s * __expf(acs_last - acs_s);
          const int tt = srow >> 6, k = srow & 63;
#pragma unroll
          for (int hf = 0; hf < 2; ++hf) { float f[8];
#pragma unroll
              for (int j = 0; j < 8; ++j) f[j] = bfs2f(rX[hf][j]);
              u32x4 wd, we;
              wd.x = cvt_pk_bf16(f[0] * dt_s, f[1] * dt_s); wd.y = cvt_pk_bf16(f[2] * dt_s, f[3] * dt_s); wd.z = cvt_pk_bf16(f[4] * dt_s, f[5] * dt_s); wd.w = cvt_pk_bf16(f[6] * dt_s, f[7] * dt_s);
              we.x = cvt_pk_bf16(f[0] * e_s, f[1] * e_s); we.y = cvt_pk_bf16(f[2] * e_s, f[3] * e_s); we.z = cvt_pk_bf16(f[4] * e_s, f[5] * e_s); we.w = cvt_pk_bf16(f[6] * e_s, f[7] * e_s);
              const int cc = scq * 16 + hf * 8;
              *(u32x4*)(XI + tt * 16384 + v_st(k, cc)) = wd; *(u32x4*)(XI + tt * 16384 + v_st(k, cc + 64)) = we; } }
        if (c + 1 < S / 128) SSDM_LOAD(c + 1);
        __syncthreads();
        f32x16 o_off = {}, o_diag = {};
        pv_one<0>(o_off, vbS + ph * 512, qr[0], qr[1], qr[2], qr[3]);
        pv_one<0>(o_off, vbS + ph * 512 + 16384, qr[4], qr[5], qr[6], qr[7]);
        const float acs_row = acs_l[32 * rb + r32];
        for (int jt = 0; jt <= (rb >> 1); ++jt) {
            f32x16 p0, p1;
            qkt<128>(p0, p1, Kimg + jt * 16384, qr, r32, hi);
            const int lrow = 32 * rb + r32;
#pragma unroll
            for (int r = 0; r < 16; ++r) {
                const int s0 = 64 * jt + crow(r, hi), s1 = s0 + 32;
                const float m0 = __expf(acs_row - acs_l[s0]), m1 = __expf(acs_row - acs_l[s1]);
                p0[r] = (s0 <= lrow) ? p0[r] * m0 : 0.f; p1[r] = (s1 <= lrow) ? p1[r] * m1 : 0.f;
            }
            bf16x8 pa0, pa1, pa2, pa3;
#define PK4(P, BASE, OUT) do { unsigned a0 = cvtpk(P[BASE + 0], P[BASE + 1]), a1 = cvtpk(P[BASE + 2], P[BASE + 3]);   \
    unsigned b0 = cvtpk(P[BASE + 4], P[BASE + 5]), b1 = cvtpk(P[BASE + 6], P[BASE + 7]);                              \
    auto r0 = __builtin_amdgcn_permlane32_swap(a0, b0, false, false); auto r1 = __builtin_amdgcn_permlane32_swap(a1, b1, false, false); \
    u32x4 w = {r0[0], r1[0], r0[1], r1[1]}; OUT = *reinterpret_cast<bf16x8*>(&w); } while (0)
            PK4(p0, 0, pa0); PK4(p0, 8, pa1); PK4(p1, 0, pa2); PK4(p1, 8, pa3);
#undef PK4
            pv_one<0>(o_diag, vbX + ph * 512 + jt * 16384, pa0, pa1, pa2, pa3);
        }
#pragma unroll
        for (int r = 0; r < 16; ++r) { const int row = 32 * rb + crow(r, hi);
            Y[(rowbase + TOK(c * 128 + row)) * 768 + h * 64 + 32 * ph + r32] = o_diag[r] + o_off[r] * __expf(acs_l[row]); }
        { const float eA = __expf(acs_last);
#pragma unroll
          for (int r = 0; r < 16; ++r) Sacc[r] *= eA;
          upd_one(Sacc, vbB + rb * 512, vbX + (2 + ph) * 512);
          upd_one(Sacc, vbB + rb * 512 + 16384, vbX + (2 + ph) * 512 + 16384); }
        __syncthreads();
        if (c + 1 < S / 128) {
#pragma unroll
            for (int r = 0; r < 16; ++r) { const int n = 32 * rb + crow(r, hi);
                *(bf16_t*)(SI + (n >> 6) * 16384 + v_st_e(n & 63, 32 * ph + r32)) = f2bf(Sacc[r]); }
        }
    }
#undef SSDM_LOAD
#undef TOK
}
}

__device__ __forceinline__ void combine_phase(const Params& p, int layer, int gw, int NGW, int) {
    const int lane = opaque_tid() & 63; gw = opaque_s(gw);
    const bf16_t* proj = (const bf16_t*)(p.ws + WS_PROJ); const bf16_t* XBC = (const bf16_t*)(p.ws + WS_XBC);
    const float* YF = (const float*)(p.ws + WS_YF); const float* YB = (const float*)(p.ws + WS_YB);
    bf16_t* ACT = (bf16_t*)(p.ws + WS_ACT);
    const float* dskip = p.in[17] + layer * 12; const float* ng = p.in[18] + layer * 768;
    for (int row = gw; row < T; row += NGW) {
        f32x4 y[3]; float ss0 = 0.f, ss1 = 0.f;
#pragma unroll
        for (int j = 0; j < 3; ++j) {
            const int c = j * 256 + lane * 4;
            const f32x4 a = *(const f32x4*)(YF + (size_t)row * 768 + c), bq = *(const f32x4*)(YB + (size_t)row * 768 + c);
            const s16x4 xv = *(const s16x4*)(XBC + (size_t)row * 1280 + c), zv = *(const s16x4*)(proj + (size_t)row * INP + C_Z + c);
            const float dsk = dskip[c >> 6];
            float q = 0.f;
#pragma unroll
            for (int k = 0; k < 4; ++k) { const float v = (a[k] + bq[k] + bfs2f(xv[k]) * dsk) * silu_f(bfs2f(zv[k])); y[j][k] = v; q += v * v; }
            if (c < 384) ss0 += q; else ss1 += q;
        }
        ss0 = wave_sum(ss0); ss1 = wave_sum(ss1);
        const float r0 = rsqrtf(ss0 * (1.f / 384.f) + EPS), r1 = rsqrtf(ss1 * (1.f / 384.f) + EPS);
#pragma unroll
        for (int j = 0; j < 3; ++j) {
            const int c = j * 256 + lane * 4; const float r = c < 384 ? r0 : r1;
            const f32x4 g4 = *(const f32x4*)(ng + c);
            u32x2 w; w.x = cvt_pk_bf16(y[j][0] * r * g4[0], y[j][1] * r * g4[1]); w.y = cvt_pk_bf16(y[j][2] * r * g4[2], y[j][3] * r * g4[3]);
            *(u32x2*)(ACT + (size_t)row * D + 1280 + c) = w;
        }
    }
}

#ifndef EXP_SSD2
#define EXP_SSD2 0
#endif
#ifndef EXP_ELT2
#define EXP_ELT2 0
#endif
#ifndef EXP_GU2
#define EXP_GU2 0
#endif
#ifndef PH_MASK
#define PH_MASK 0xffff
#endif
#ifndef MLA_SD
#define MLA_SD 1
#endif
constexpr int N_SSD = NB * 2 * 12, N_MLA = NB * 4 * 8, N_GQA = NB * 6 * 8, N_MIX = N_SSD + N_MLA + N_GQA;

__global__ void __launch_bounds__(512, 2) fwd_megakernel(Params p) {
    extern __shared__ __attribute__((aligned(16))) unsigned char smem[];
    cg::grid_group grid = cg::this_grid();
    LAS unsigned char* lds = (LAS unsigned char*)smem;
    volatile LAS unsigned* MISC = (volatile LAS unsigned*)(lds + MISC_OFF);
    const int wave = __builtin_amdgcn_readfirstlane(threadIdx.x >> 6);
    const int G = gridDim.x, bx = blockIdx.x;
    const int gw = bx * 8 + wave, NGW = G * 8;
    unsigned char* ws = p.ws;
    unsigned* ctl = (unsigned*)(ws + WS_CTL);
    float* modall = (float*)(ws + WS_MOD);
    float* tab = (float*)(ws + WS_TAB);
    bf16_t* ACT = (bf16_t*)(ws + WS_ACT); bf16_t* PROJ = (bf16_t*)(ws + WS_PROJ);
    bf16_t* QB = (bf16_t*)(ws + WS_QB); bf16_t* KB = (bf16_t*)(ws + WS_KB); bf16_t* VB = (bf16_t*)(ws + WS_VB);
    bf16_t* XBC = (bf16_t*)(ws + WS_XBC); float* DT = (float*)(ws + WS_DT); float* YF = (float*)(ws + WS_YF); float* YB = (float*)(ws + WS_YB);
    bf16_t* HID = (bf16_t*)(ws + WS_HID);

    {
        for (int it = bx; it < DEPTH * 192; it += G) mod_item(p, it, (LAS float*)lds, 0);
        __syncthreads();
        { const int gt = bx * 512 + opaque_tid();
          if (gt < 2048) { const int idx = gt >> 5, i = gt & 31; const float inv = powf(10000.f, -(float)(2 * i) / 64.f); const float ang = (float)idx * inv; tab[gt] = cosf(ang); tab[2048 + gt] = sinf(ang); }
          else if (gt < 3072) { const int q = gt - 2048, idx = q >> 4, i = q & 15; const float inv = powf(10000.f, -(float)(2 * i) / 32.f); const float ang = (float)idx * inv; tab[4096 + q] = cosf(ang); tab[4096 + 1024 + q] = sinf(ang); } }
        LAS float* scr = (LAS float*)(lds + wave * 16384);
        constexpr int I_IN = (D / 64) * (INP / 32), I_UQ = (512 / 64) * (768 / 32), I_UKV = (256 / 64) * (1024 / 32), I_OUT = (D / 64) * (D / 32), I_GU = (D / 64) * (2 * FF / 32), I_DN = (FF / 64) * (D / 32);
        constexpr int I_LAYER = I_IN + I_UQ + I_UKV + I_OUT + I_GU + I_DN;
        for (int it = gw; it < DEPTH * I_LAYER; it += NGW) {
            const int l = it / I_LAYER; int r = it % I_LAYER;
            unsigned char* wl = ws + WS_W + (size_t)l * W_LAYER;
            if (r < I_IN) { transpose_item(p.in[6] + (size_t)l * D * INC, D, INC, INP, (bf16_t*)(wl + W_IN), 0, scr, r, 0); continue; } r -= I_IN;
            if (r < I_UQ) { transpose_item(p.in[10] + (size_t)l * 512 * 768, 512, 768, 768, (bf16_t*)(wl + W_UQ), 0, scr, r, 0); continue; } r -= I_UQ;
            if (r < I_UKV) { transpose_item(p.in[12] + (size_t)l * 256 * 1024, 256, 1024, 1024, (bf16_t*)(wl + W_UKV), 0, scr, r, 0); continue; } r -= I_UKV;
            if (r < I_OUT) { transpose_item(p.in[19] + (size_t)l * D * D, D, D, D, (bf16_t*)(wl + W_OUT), 0, scr, r, 0); continue; } r -= I_OUT;
            if (r < I_GU) { transpose_item(p.in[20] + (size_t)l * D * 2 * FF, D, 2 * FF, 2 * FF, (bf16_t*)(wl + W_GU), 1, scr, r, 0); continue; } r -= I_GU;
            transpose_item(p.in[21] + (size_t)l * FF * D, FF, D, D, (bf16_t*)(wl + W_DN), 0, scr, r, 0);
        }
    }
    grid.sync();

    for (int layer = 0; layer < DEPTH; ++layer) {
        const unsigned char* wl = ws + WS_W + (size_t)layer * W_LAYER;
        const float* modl = modall + (size_t)layer * NB * MODW;
        const float* xin = layer == 0 ? p.in[0] : p.out;
        norm_mod_phase(xin, p.in[4] + layer * D, modl, 0, D, ACT, gw, NGW, 0);
        if (EXP_ELT2) norm_mod_phase(xin, p.in[4] + layer * D, modl, 0, D, ACT, gw, NGW, 0);
        grid.sync();
        #if PH_MASK & (1<<2)
        { pg8::Gemm g{ACT, (const bf16_t*)(wl + W_IN), T, INP, D, D}; pg8::StaticOrder so; so.init(T, INP, G, bx);
          pg8::EpiProj E{PROJ}; pg8::gemm_phase<pg8::EpiProj>(lds, g, so, E); }

#endif
        grid.sync();
        prep_phase(p, layer, gw, NGW, 0);
        grid.sync();
        #if PH_MASK & (1<<4)
        { pg8::Gemm g{PROJ + C_CQ, (const bf16_t*)(wl + W_UQ), T, 768, 512, INP}; pg8::StaticOrder so; so.init(T, 768, G, bx);
          pg8::EpiUq E{QB, tab + 4096, tab + 4096 + 1024}; pg8::gemm_phase<pg8::EpiUq>(lds, g, so, E); }

#endif
        #if PH_MASK & (1<<5)
        { pg8::Gemm g{PROJ + C_CKV, (const bf16_t*)(wl + W_UKV), T, 1024, 256, INP}; pg8::StaticOrder so; so.init(T, 1024, G, bx);
          pg8::EpiUkv E{KB, VB}; pg8::gemm_phase<pg8::EpiUkv>(lds, g, so, E); }

#endif
        grid.sync();
        {
            const float* alog = p.in[16] + layer * 24;
            for (;;) {
                __syncthreads();
                if (opaque_tid() == 0) MISC[0] = atomicAdd(ctl + 16 + layer, 1u);
                __syncthreads();
                int it = (int)MISC[0];
                if (it >= N_MIX + (EXP_SSD2 ? N_SSD : 0)) break;
                if (EXP_SSD2 && it >= N_MIX) it -= N_MIX;
                if (it < N_SSD) {
                    const int h = it % 12, dir = (it / 12) & 1, b = it / 24;
#ifndef NO_SSD
                    ssdm::ssd_item(XBC, DT, dir ? YB : YF, -expf(alog[dir * 12 + h]), b, dir, h, (char*)smem);
#endif
                } else if (it < N_SSD + N_MLA) {
                    const int i = it - N_SSD, qb = i & 7, h = (i >> 3) & 3, b = i >> 5;
                    const size_t r0 = (size_t)b * S;
#ifndef NO_MLA
                    att::attn_simple_body<192, 768, 768, 512, D>(QB + (r0 + qb * 256) * 768 + h * 192, KB + r0 * 768 + h * 192, VB + r0 * 512 + h * 128,
                                                                ACT + (r0 + qb * 256) * D + 768 + h * 128, S, (char*)smem);
#endif
                } else {
                    const int i = it - N_SSD - N_MLA, qb = i & 7, h = (i >> 3) % 6, b = i / 48;
                    const size_t r0 = (size_t)b * S;
#ifndef NO_GQA
                    att::attn_dense_body<128, INP, INP, INP, D, 2>(PROJ + (r0 + qb * 256) * INP + C_QA + h * 128, PROJ + r0 * INP + C_KA + (h / 3) * 128, PROJ + r0 * INP + C_VA + (h / 3) * 128,
                                                                ACT + (r0 + qb * 256) * D + h * 128, S, (char*)smem);
#endif
                }
            }
        }
        grid.sync();
        combine_phase(p, layer, gw, NGW, 0);
        if (EXP_ELT2) combine_phase(p, layer, gw, NGW, 0);
        grid.sync();
        #if PH_MASK & (1<<7)
        { pg8::Gemm g{ACT, (const bf16_t*)(wl + W_OUT), T, D, D, D}; pg8::StaticOrder so; so.init(T, D, G, bx);
          pg8::EpiResid E{xin, p.out, modl + 2 * D}; pg8::gemm_phase<pg8::EpiResid>(lds, g, so, E); }

#endif
        grid.sync();
        norm_mod_phase(p.out, p.in[5] + layer * D, modl, 3 * D, 4 * D, ACT, gw, NGW, 0);
        if (EXP_ELT2) norm_mod_phase(p.out, p.in[5] + layer * D, modl, 3 * D, 4 * D, ACT, gw, NGW, 0);
        grid.sync();
        #if PH_MASK & (1<<9)
        { pg8::Gemm g{ACT, (const bf16_t*)(wl + W_GU), T, 2 * FF, D, D}; pg8::StaticOrder so; so.init(T, 2 * FF, G, bx);
          pg8::EpiSwiglu E{HID}; pg8::gemm_phase<pg8::EpiSwiglu>(lds, g, so, E);
          if (EXP_GU2) pg8::gemm_phase<pg8::EpiSwiglu>(lds, g, so, E); }

#endif
        grid.sync();
        #if PH_MASK & (1<<10)
        { pg8::Gemm g{HID, (const bf16_t*)(wl + W_DN), T, D, FF, FF}; pg8::StaticOrder so; so.init(T, D, G, bx);
          pg8::EpiResid E{p.out, p.out, modl + 5 * D}; pg8::gemm_phase<pg8::EpiResid>(lds, g, so, E); }

#endif
        grid.sync();
    }
    {
        const float* fg = p.in[22]; const int lane = opaque_tid() & 63; const int gw2 = opaque_s(gw);
        for (int row = gw2; row < T; row += NGW) {
            f32x4* xr = (f32x4*)(p.out + (size_t)row * D) + lane;
            f32x4 v[8]; float ss = 0.f;
#pragma unroll
            for (int j = 0; j < 8; ++j) { v[j] = xr[64 * j]; ss += (v[j][0] * v[j][0] + v[j][1] * v[j][1]) + (v[j][2] * v[j][2] + v[j][3] * v[j][3]); }
            ss = wave_sum(ss);
            const float rstd = rsqrtf(ss * (1.f / D) + EPS);
#pragma unroll
            for (int j = 0; j < 8; ++j) { const f32x4 g4 = *(const f32x4*)(fg + (lane + 64 * j) * 4); xr[64 * j] = (v[j] * rstd) * g4; }
        }
    }
}

extern "C" void kernel_launch(void* const* d_in, const int* in_sizes, int n_in, void* d_out, int out_size, void* d_ws, size_t ws_size, hipStream_t stream) {
    static int grid_blocks = 0;
    if (grid_blocks == 0) {
        if (n_in != 23 || in_sizes[0] != T * D || out_size != T * D || ws_size < WS_END) {
            fprintf(stderr, "kernel_launch: shape/workspace mismatch: n_in %d in0 %d out %d ws %zu (need %zu); nothing launched\n", n_in, n_in > 0 ? in_sizes[0] : -1, out_size, ws_size, (size_t)WS_END);
            grid_blocks = -1; return; }
        int dev = 0, cus = 0, per_cu = 0;
        hipGetDevice(&dev);
        hipDeviceGetAttribute(&cus, hipDeviceAttributeMultiprocessorCount, dev);
        if (hipFuncSetAttribute((const void*)fwd_megakernel, hipFuncAttributeMaxDynamicSharedMemorySize, LDS_BYTES) != hipSuccess) { fprintf(stderr, "kernel_launch: hipFuncSetAttribute failed\n"); grid_blocks = -1; return; }
        if (hipOccupancyMaxActiveBlocksPerMultiprocessor(&per_cu, (const void*)fwd_megakernel, 512, LDS_BYTES) != hipSuccess || per_cu < 1) { fprintf(stderr, "kernel_launch: occupancy query failed (%d)\n", per_cu); (void)hipGetLastError(); per_cu = 1; }
        grid_blocks = cus * per_cu;
        fprintf(stderr, "kernel_launch: grid %d (cus %d x %d), ws need %zu of %zu\n", grid_blocks, cus, per_cu, (size_t)WS_END, ws_size);
    }
    if (grid_blocks < 0) return;
    if (hipMemsetAsync((char*)d_ws + WS_CTL, 0, 4096, stream) != hipSuccess) { fprintf(stderr, "kernel_launch: memset failed\n"); return; }
    Params p{};
    for (int i = 0; i < 23; ++i) p.in[i] = (const float*)d_in[i];
    p.out = (float*)d_out; p.ws = (unsigned char*)d_ws;
    void* args[] = {&p};
    hipError_t e = hipLaunchCooperativeKernel((const void*)fwd_megakernel, dim3(grid_blocks), dim3(512), args, LDS_BYTES, stream);
    if (e != hipSuccess) fprintf(stderr, "kernel_launch: cooperative launch failed: %s (grid %d)\n", hipGetErrorString(e), grid_blocks);
}
```

```cpp
#include <hip/hip_runtime.h>
#include <hip/hip_cooperative_groups.h>
#include <cstdio>
#include <cstdint>
namespace cg = cooperative_groups;

#define LAS __attribute__((address_space(3)))
typedef unsigned short bf16_t;
typedef short bf16x8 __attribute__((ext_vector_type(8)));
typedef short s16x4 __attribute__((ext_vector_type(4)));
typedef float f32x2 __attribute__((ext_vector_type(2)));
typedef float f32x4 __attribute__((ext_vector_type(4)));
typedef float f32x16 __attribute__((ext_vector_type(16)));
typedef unsigned u32x2 __attribute__((ext_vector_type(2)));
typedef unsigned u32x4 __attribute__((ext_vector_type(4)));

constexpr int NB = 16, S = 2048, D = 2048, T = NB * S, DEPTH = 2;
constexpr int INC = 4184, INP = 4352;
constexpr int FF = 5632;
constexpr int C_QA = 0, C_KA = 768, C_VA = 1024, C_CQ = 1280, C_CKV = 1792, C_KPE = 2048, C_Z = 2112, C_XBC = 2880, C_DT = 4160;
constexpr float EPS = 1e-6f;
constexpr int MODW = 6 * D;

constexpr size_t al256(size_t x) { return (x + 255) / 256 * 256; }
constexpr size_t WS_CTL = 0;
constexpr size_t WS_MOD = 4096;
constexpr size_t WS_TAB = WS_MOD + (size_t)DEPTH * NB * MODW * 4;
constexpr size_t WS_BAR = al256(WS_TAB + (64 * 32 * 2 + 64 * 16 * 2) * 4);
constexpr size_t WS_W   = al256(WS_BAR + 16384);
constexpr size_t W_IN = 0, W_UQ = W_IN + (size_t)INP * D * 2, W_UKV = W_UQ + (size_t)768 * 512 * 2, W_OUT = W_UKV + (size_t)1024 * 256 * 2,
                 W_GU = W_OUT + (size_t)D * D * 2, W_DN = W_GU + (size_t)2 * FF * D * 2, W_LAYER = W_DN + (size_t)D * FF * 2;
constexpr size_t WS_ACT = al256(WS_W + DEPTH * W_LAYER);
constexpr size_t WS_BIG = WS_ACT + (size_t)T * D * 2;
constexpr size_t WS_PROJ = WS_BIG;
constexpr size_t WS_QB = WS_PROJ + (size_t)T * INP * 2;
constexpr size_t WS_KB = WS_QB + (size_t)T * 768 * 2;
constexpr size_t WS_VB = WS_KB + (size_t)T * 768 * 2;
constexpr size_t WS_XBC = WS_VB + (size_t)T * 512 * 2;
constexpr size_t WS_DT = WS_XBC + (size_t)T * 1280 * 2;
constexpr size_t WS_YF = WS_DT + (size_t)T * 24 * 4;
constexpr size_t WS_YB = WS_YF + (size_t)T * 768 * 4;
constexpr size_t WS_END1 = WS_YB + (size_t)T * 768 * 4;
constexpr size_t WS_HID = WS_BIG;
constexpr size_t WS_END2 = WS_HID + (size_t)T * FF * 2;
constexpr size_t WS_END = WS_END1 > WS_END2 ? WS_END1 : WS_END2;

constexpr int RING_BYTES = 131072, MISC_OFF = RING_BYTES, LDS_BYTES = 147456;

struct Params { const float* in[23]; float* out; unsigned char* ws; };

__device__ __forceinline__ float bf2f(bf16_t b) { return __uint_as_float(((unsigned)b) << 16); }
__device__ __forceinline__ float bfs2f(short b) { return __uint_as_float(((unsigned)(unsigned short)b) << 16); }
__device__ __forceinline__ unsigned cvt_pk_bf16(float lo, float hi) { unsigned r; asm volatile("v_cvt_pk_bf16_f32 %0, %1, %2" : "=v"(r) : "v"(lo), "v"(hi)); return r; }
__device__ __forceinline__ bf16_t f2bf_c(float f) { unsigned u = __float_as_uint(f); u += 0x7fffu + ((u >> 16) & 1u); return (bf16_t)(u >> 16); }
__device__ __forceinline__ unsigned pk2c(float lo, float hi) { return (unsigned)f2bf_c(lo) | ((unsigned)f2bf_c(hi) << 16); }
__device__ __forceinline__ bf16_t f2bf(float f) { return (bf16_t)(cvt_pk_bf16(f, 0.f) & 0xffffu); }
template <int O> __device__ __forceinline__ float shx(float x) {
    static_assert(O < 32, "within a 32-lane half");
    return __int_as_float(__builtin_amdgcn_ds_swizzle(__float_as_int(x), 0x1f | (O << 10)));
}
__device__ __forceinline__ float xsum32(float x) { auto rr = __builtin_amdgcn_permlane32_swap(__float_as_uint(x), __float_as_uint(x), false, false); return __uint_as_float(rr[0]) + __uint_as_float(rr[1]); }
#define XOR_STEPS(BODY) { BODY(1) BODY(2) BODY(4) BODY(8) BODY(16) }
__device__ __forceinline__ float wave_sum(float v) {
#define WS_STEP(O) v += shx<O>(v);
    XOR_STEPS(WS_STEP)
#undef WS_STEP
    return xsum32(v);
}
__device__ __forceinline__ void wave_sum2(float& a, float& b) {
#define WS_STEP(O) { const float ta = shx<O>(a), tb = shx<O>(b); a += ta; b += tb; }
    XOR_STEPS(WS_STEP)
#undef WS_STEP
    a = xsum32(a); b = xsum32(b);
}
__device__ __forceinline__ float silu_f(float x) { return x * __builtin_amdgcn_rcpf(1.f + __expf(-x)); }
__device__ __forceinline__ int opaque_tid() { int t = threadIdx.x; asm volatile("" : "+v"(t)); return t; }
__device__ __forceinline__ int opaque_s(int x) { asm volatile("" : "+s"(x)); return x; }
#define LDS_WAIT() asm volatile("s_waitcnt lgkmcnt(0)" ::: "memory")

namespace pg8 {
constexpr int BM = 256, BK = 64, HALF = 128, HTB = HALF * BK * 2, STAGE_BYTES = 8 * HTB, NXCD = 8, WGM = 8;
__host__ __device__ __forceinline__ int lds_byte(int r, int c) { const int st = (r >> 4) * 2 + (c >> 5), rr = r & 15, cc = c & 31, ob = rr * 64 + cc * 2; return st * 1024 + (ob ^ (((ob >> 9) & 1) << 5)); }
__host__ __device__ __forceinline__ void stage_rc(int b, int& R, int& C) { const int st = b / 1024, sb = b % 1024, swz = sb ^ (((sb >> 9) & 1) << 5); R = (st >> 1) * 16 + swz / 64; C = (st & 1) * 32 + (swz % 64) / 2; }
__host__ __device__ __forceinline__ int perm32(int rho) { const int n = rho >> 4, i = rho & 15; return 8 * (i >> 2) + 4 * n + (i & 3); }

struct Unit { int pm, pn; };
struct Gemm { const bf16_t* A; const bf16_t* Bt; int M, N, K, lda; };

struct StaticOrder {
    int nM, nN, nwg, G, c;
    __device__ void init(int M, int N, int G_, int c_) { nM = M / BM; nN = N / BM; nwg = nM * nN; G = G_; c = c_; }
    __device__ bool next(int i, Unit& u) const {
        const long L = (long)i * G + c; if (L >= nwg) return false;
        int wgid = (int)L; { const int q = nwg / NXCD, r = nwg % NXCD, xcd = wgid % NXCD, off = wgid / NXCD; wgid = (xcd < r ? xcd * (q + 1) : r * (q + 1) + (xcd - r) * q) + off; }
        const int nig = WGM * nN, gid = wgid / nig, fm = gid * WGM, gsz = (nM - fm) < WGM ? (nM - fm) : WGM;
        u.pm = fm + ((wgid % nig) % gsz); u.pn = (wgid % nig) / gsz; return true;
    }
};

template <class Epi>
__device__ __forceinline__ void gemm_phase(LAS unsigned char* lds, const Gemm g, const StaticOrder& S, const Epi& E) {
    const int tid = opaque_tid(), wid = __builtin_amdgcn_readfirstlane(tid >> 6), lane = tid & 63, wr = wid >> 2, wc = wid & 3, fr = lane & 15, fq = lane >> 4;
    const int K = g.K, nt = K / BK;
    unsigned voffA[2], voffB[2];
#pragma unroll
    for (int i = 0; i < 2; ++i) { int R, C; stage_rc(tid * 16 + i * 8192, R, C); const int Rb = Epi::PERM ? ((R & ~31) + perm32(R & 31)) : R;
        voffA[i] = (unsigned)(R * g.lda + C) * 2u; voffB[i] = (unsigned)(Rb * K + C) * 2u; }
    const size_t kstep = (size_t)(BK * 2);
    const size_t hstepA = (size_t)HALF * g.lda * 2, hstepB = (size_t)HALF * K * 2;
    const size_t tstepA = 2 * hstepA, tstepB = 2 * hstepB;
    const unsigned ldsw = (unsigned)wid * 1024u;
    const int aoff = lds_byte(wr * 64 + fr, fq * 8), boff = lds_byte(wc * 32 + fr, fq * 8);
#define PG8_SA(b, h) (((b) * 2 + (h)) * HTB)
#define PG8_SB(b, h) ((4 + (b) * 2 + (h)) * HTB)
#define PG8_STAGE(bufoff, gbase, voff) do { _Pragma("unroll") for (int _i = 0; _i < 2; ++_i) \
        __builtin_amdgcn_global_load_lds((const unsigned*)((const char*)(gbase) + (voff)[_i]), (LAS unsigned*)(lds + (bufoff) + ldsw + _i * 8192), 16, 0, 0); } while (0)
#define PG8_LDA(dst, b, h) do { _Pragma("unroll") for (int m = 0; m < 4; ++m) _Pragma("unroll") for (int k = 0; k < 2; ++k) dst[m][k] = *(const LAS bf16x8*)(lds + PG8_SA(b, h) + aoff + m * 2048 + k * 1024); } while (0)
#define PG8_LDB(dst, b, h) do { _Pragma("unroll") for (int n = 0; n < 2; ++n) _Pragma("unroll") for (int k = 0; k < 2; ++k) dst[n][k] = *(const LAS bf16x8*)(lds + PG8_SB(b, h) + boff + n * 2048 + k * 1024); } while (0)
#define PG8_MMA(ai, bj, At, Bt) do { __builtin_amdgcn_s_setprio(1); _Pragma("unroll") for (int m = 0; m < 4; ++m) _Pragma("unroll") for (int n = 0; n < 2; ++n) _Pragma("unroll") for (int k = 0; k < 2; ++k) \
        acc[ai][bj][m][n] = __builtin_amdgcn_mfma_f32_16x16x32_bf16(Bt[n][k], At[m][k], acc[ai][bj][m][n], 0, 0, 0); __builtin_amdgcn_s_setprio(0); } while (0)
#define PG8_WAIT_V(n) asm volatile("s_waitcnt vmcnt(" #n ")" ::: "memory")
#define PG8_WAIT_L(n) asm volatile("s_waitcnt lgkmcnt(" #n ")" ::: "memory")
#define PG8_BAR __builtin_amdgcn_s_barrier()
#define PG8_SCHED __builtin_amdgcn_sched_barrier(0)
    Unit cur, nxt; int ui = 0;
    if (!S.next(0, cur)) return;
    f32x4 acc[2][2][4][2];
#pragma unroll
    for (int a = 0; a < 2; ++a)
#pragma unroll
        for (int b = 0; b < 2; ++b)
#pragma unroll
            for (int m = 0; m < 4; ++m)
#pragma unroll
                for (int n = 0; n < 2; ++n) acc[a][b][m][n] = (f32x4){0.f, 0.f, 0.f, 0.f};
    bf16x8 At[4][2], B0[2][2], B1[2][2];
    const char* cA = (const char*)g.A + (size_t)cur.pm * tstepA; const char* cB = (const char*)g.Bt + (size_t)cur.pn * tstepB;
    PG8_STAGE(PG8_SB(0, 0), cB, voffB); PG8_STAGE(PG8_SB(0, 1), cB + hstepB, voffB); PG8_STAGE(PG8_SA(0, 0), cA, voffA); PG8_STAGE(PG8_SA(0, 1), cA + hstepA, voffA);
    if (wr == 1) PG8_BAR;
    PG8_WAIT_V(2); PG8_BAR;
    PG8_STAGE(PG8_SB(1, 0), cB + kstep, voffB); PG8_STAGE(PG8_SA(1, 0), cA + kstep, voffA); PG8_STAGE(PG8_SB(1, 1), cB + hstepB + kstep, voffB);
    PG8_WAIT_V(6); PG8_BAR;
    for (;;) {
        const bool has_next = S.next(ui + 1, nxt);
        const char* nA = has_next ? (const char*)g.A + (size_t)nxt.pm * tstepA : cA; const char* nB = has_next ? (const char*)g.Bt + (size_t)nxt.pn * tstepB : cB;
#pragma nounroll
        for (int t = 0; t < nt; t += 2) {
            const bool last = (t == nt - 2);
            const char* a1 = cA + (size_t)(t + 1) * kstep;
            const char* a2 = last ? nA : cA + (size_t)(t + 2) * kstep; const char* b2 = last ? nB : cB + (size_t)(t + 2) * kstep;
            const char* a3 = a2 + kstep; const char* b3 = b2 + kstep;
            PG8_LDB(B0, 0, 0); PG8_LDB(B1, 0, 1); PG8_SCHED; PG8_LDA(At, 0, 0); PG8_STAGE(PG8_SA(1, 1), a1 + hstepA, voffA);
            PG8_WAIT_V(8); PG8_WAIT_L(0); PG8_BAR; PG8_MMA(0, 0, At, B0); PG8_MMA(0, 1, At, B1); PG8_BAR; PG8_SCHED;
            PG8_LDA(At, 0, 1); PG8_STAGE(PG8_SB(0, 0), b2, voffB); PG8_STAGE(PG8_SB(0, 1), b2 + hstepB, voffB); PG8_STAGE(PG8_SA(0, 0), a2, voffA);
            PG8_WAIT_V(8); PG8_WAIT_L(0); PG8_BAR; PG8_MMA(1, 0, At, B0); PG8_MMA(1, 1, At, B1); PG8_BAR; PG8_SCHED;
            PG8_LDB(B0, 1, 0); PG8_LDB(B1, 1, 1); PG8_SCHED; PG8_LDA(At, 1, 0); PG8_STAGE(PG8_SA(0, 1), a2 + hstepA, voffA);
            PG8_WAIT_V(8); PG8_WAIT_L(0); PG8_BAR; PG8_MMA(0, 0, At, B0); PG8_MMA(0, 1, At, B1); PG8_BAR; PG8_SCHED;
            PG8_LDA(At, 1, 1); PG8_STAGE(PG8_SB(1, 0), b3, voffB); PG8_STAGE(PG8_SB(1, 1), b3 + hstepB, voffB); PG8_STAGE(PG8_SA(1, 0), a3, voffA);
            PG8_WAIT_V(8); PG8_WAIT_L(0); PG8_BAR; PG8_MMA(1, 0, At, B0); PG8_MMA(1, 1, At, B1); PG8_BAR; PG8_SCHED;
        }
        if (wr == 0) PG8_BAR;
        E(acc, cur, wr, wc, fr, fq);
        if (!has_next) break;
#pragma unroll
        for (int a = 0; a < 2; ++a)
#pragma unroll
            for (int b = 0; b < 2; ++b)
#pragma unroll
                for (int m = 0; m < 4; ++m)
#pragma unroll
                    for (int n = 0; n < 2; ++n) acc[a][b][m][n] = (f32x4){0.f, 0.f, 0.f, 0.f};
        cur = nxt; cA = nA; cB = nB; ++ui;
        if (wr == 1) PG8_BAR;
    }
    PG8_WAIT_V(0);
    PG8_BAR;
#undef PG8_SA
#undef PG8_SB
#undef PG8_STAGE
#undef PG8_LDA
#undef PG8_LDB
#undef PG8_MMA
#undef PG8_WAIT_V
#undef PG8_WAIT_L
#undef PG8_BAR
#undef PG8_SCHED
}

struct EpiProj {
    static constexpr bool PERM = true;
    bf16_t* O;
    __device__ __forceinline__ void operator()(const f32x4 (&acc)[2][2][4][2], const Unit& u, int wr, int wc, int fr, int fq) const {
        const int row0 = u.pm * BM + wr * 64 + fr, col0 = u.pn * BM + wc * 32 + 8 * fq;
#pragma unroll
        for (int ai = 0; ai < 2; ++ai)
#pragma unroll
            for (int m = 0; m < 4; ++m) { bf16_t* rowp = O + (size_t)(row0 + ai * HALF + m * 16) * INP + col0;
#pragma unroll
                for (int bj = 0; bj < 2; ++bj) { const f32x4 v0 = acc[ai][bj][m][0], v1 = acc[ai][bj][m][1];
                    u32x4 w; w.x = cvt_pk_bf16(v0[0], v0[1]); w.y = cvt_pk_bf16(v0[2], v0[3]); w.z = cvt_pk_bf16(v1[0], v1[1]); w.w = cvt_pk_bf16(v1[2], v1[3]);
                    *(u32x4*)(rowp + bj * HALF) = w; } }
    }
};
struct EpiUq {
    static constexpr bool PERM = false;
    bf16_t* O; const float* tcos; const float* tsin;
    __device__ __forceinline__ void operator()(const f32x4 (&acc)[2][2][4][2], const Unit& u, int wr, int wc, int fr, int fq) const {
        const int row0 = u.pm * BM + wr * 64 + fr;
#pragma unroll
        for (int bj = 0; bj < 2; ++bj) {
            const int cg = u.pn * BM + bj * HALF + wc * 32, w = cg % 192;
            const int axis = (w == 128) ? 0 : ((w == 160) ? 1 : -1);
#pragma unroll
            for (int ai = 0; ai < 2; ++ai)
#pragma unroll
                for (int m = 0; m < 4; ++m) {
                    const int r = row0 + ai * HALF + m * 16, s = r & (S - 1);
                    f32x4 x1 = acc[ai][bj][m][0], x2 = acc[ai][bj][m][1];
                    if (axis >= 0) {
                        const int idx = axis ? (s & 63) : (s >> 6);
                        const f32x4 c = *(const f32x4*)(tcos + idx * 16 + 4 * fq), sn = *(const f32x4*)(tsin + idx * 16 + 4 * fq);
                        const f32x4 o1 = x1 * c - x2 * sn, o2 = x1 * sn + x2 * c; x1 = o1; x2 = o2;
                    }
                    bf16_t* rowp = O + (size_t)r * 768 + cg + 4 * fq;
                    u32x2 w0, w1; w0.x = pk2c(x1[0], x1[1]); w0.y = pk2c(x1[2], x1[3]); w1.x = pk2c(x2[0], x2[1]); w1.y = pk2c(x2[2], x2[3]);
                    *(u32x2*)(rowp) = w0; *(u32x2*)(rowp + 16) = w1;
                }
        }
    }
};
struct EpiUkv {
    static constexpr bool PERM = true;
    bf16_t* KB; bf16_t* VB;
    __device__ __forceinline__ void operator()(const f32x4 (&acc)[2][2][4][2], const Unit& u, int wr, int wc, int fr, int fq) const {
        const int row0 = u.pm * BM + wr * 64 + fr, cin = wc * 32 + 8 * fq;
#pragma unroll
        for (int ai = 0; ai < 2; ++ai)
#pragma unroll
            for (int m = 0; m < 4; ++m) { const size_t r = (size_t)(row0 + ai * HALF + m * 16);
#pragma unroll
                for (int bj = 0; bj < 2; ++bj) { const f32x4 v0 = acc[ai][bj][m][0], v1 = acc[ai][bj][m][1];
                    u32x4 w; w.x = pk2c(v0[0], v0[1]); w.y = pk2c(v0[2], v0[3]); w.z = pk2c(v1[0], v1[1]); w.w = pk2c(v1[2], v1[3]);
                    bf16_t* dst = bj == 0 ? (KB + r * 768 + u.pn * 192 + cin) : (VB + r * 512 + u.pn * 128 + cin);
                    *(u32x4*)dst = w; } }
    }
};
struct EpiResid {
    static constexpr bool PERM = false;
    const float* in; float* out; const float* gate;
    __device__ __forceinline__ void operator()(const f32x4 (&acc)[2][2][4][2], const Unit& u, int wr, int wc, int fr, int fq) const {
        const int row0 = u.pm * BM + wr * 64 + fr, col0 = u.pn * BM + wc * 32 + 4 * fq;
        const float* gb = gate + (size_t)(u.pm >> 3) * MODW + col0;
        f32x4 gv[2][2];
#pragma unroll
        for (int bj = 0; bj < 2; ++bj)
#pragma unroll
            for (int n = 0; n < 2; ++n) gv[bj][n] = *(const f32x4*)(gb + bj * HALF + n * 16);
#pragma unroll
        for (int ai = 0; ai < 2; ++ai)
#pragma unroll
            for (int mp = 0; mp < 2; ++mp) {
                f32x4 bs[2][2][2];
#pragma unroll
                for (int mm = 0; mm < 2; ++mm) { const size_t off = (size_t)(row0 + ai * HALF + (2 * mp + mm) * 16) * D + col0;
#pragma unroll
                    for (int bj = 0; bj < 2; ++bj)
#pragma unroll
                        for (int n = 0; n < 2; ++n) bs[mm][bj][n] = *(const f32x4*)(in + off + bj * HALF + n * 16); }
#pragma unroll
                for (int mm = 0; mm < 2; ++mm) { const size_t off = (size_t)(row0 + ai * HALF + (2 * mp + mm) * 16) * D + col0;
#pragma unroll
                    for (int bj = 0; bj < 2; ++bj)
#pragma unroll
                        for (int n = 0; n < 2; ++n) *(f32x4*)(out + off + bj * HALF + n * 16) = bs[mm][bj][n] + gv[bj][n] * acc[ai][bj][2 * mp + mm][n]; }
                asm volatile("" ::: "memory"); }
    }
};
struct EpiSwiglu {
    static constexpr bool PERM = true;
    bf16_t* O;
    __device__ __forceinline__ void operator()(const f32x4 (&acc)[2][2][4][2], const Unit& u, int wr, int wc, int fr, int fq) const {
        const int row0 = u.pm * BM + wr * 64 + fr, col0 = u.pn * HALF + wc * 32 + 8 * fq;
#pragma unroll
        for (int ai = 0; ai < 2; ++ai)
#pragma unroll
            for (int m = 0; m < 4; ++m) { bf16_t* rowp = O + (size_t)(row0 + ai * HALF + m * 16) * FF + col0;
                f32x4 h0, h1;
#pragma unroll
                for (int j = 0; j < 4; ++j) { h0[j] = silu_f(acc[ai][0][m][0][j]) * acc[ai][1][m][0][j]; h1[j] = silu_f(acc[ai][0][m][1][j]) * acc[ai][1][m][1][j]; }
                u32x4 w; w.x = cvt_pk_bf16(h0[0], h0[1]); w.y = cvt_pk_bf16(h0[2], h0[3]); w.z = cvt_pk_bf16(h1[0], h1[1]); w.w = cvt_pk_bf16(h1[2], h1[3]);
                *(u32x4*)rowp = w; }
    }
};
}

namespace att {
constexpr int NW = 8, QBLK = 32, KVBLK = 64, DV = 128;
constexpr float THR = 8.f;
#define SBAR() __builtin_amdgcn_sched_barrier(0)
__device__ __forceinline__ int crow(int r, int hi) { return (r & 3) + 8 * (r >> 2) + 4 * hi; }
__device__ __forceinline__ unsigned cvtpk(float lo, float hi) { unsigned r; asm volatile("v_cvt_pk_bf16_f32 %0, %1, %2" : "=v"(r) : "v"(lo), "v"(hi)); return r; }

template <int DK> struct Cfg {
    static constexpr float SCALE = (DK == 128) ? 0.088388347648318440f : 0.072168783648703220f;
    static constexpr int KROWB = DK * 2;
    static constexpr int SHM_V = KVBLK * DV * 2, SHM_K = KVBLK * DK * 2;
    static constexpr int SHM = 2 * SHM_V + 2 * SHM_K + NW * 64 * 4;
    static constexpr int NKC = DK / 64;
    static constexpr int ND0 = DK / 16;
};
template <int DK> __device__ __forceinline__ int kswz(int row, int colB) { return row * (DK * 2) + (colB ^ ((row & 7) << 4)); }

template <int DK>
__device__ __forceinline__ void partialSM(f32x16& p0, f32x16& p1, float& m_reg, float& mn, float& alpha) {
    constexpr float SCALE = Cfg<DK>::SCALE;
    constexpr float C = SCALE * 1.4426950408889634f;
    float pmax = p0[0];
#pragma unroll
    for (int r = 1; r < 16; ++r) pmax = fmaxf(pmax, p0[r]);
#pragma unroll
    for (int r = 0; r < 16; ++r) pmax = fmaxf(pmax, p1[r]);
    { auto rr = __builtin_amdgcn_permlane32_swap(__float_as_uint(pmax), __float_as_uint(pmax), false, false);
      pmax = fmaxf(__uint_as_float(rr[0]), __uint_as_float(rr[1])); }
    if (__builtin_expect(__all(pmax - m_reg <= THR / SCALE), 1)) { mn = m_reg; alpha = 1.f; }
    else { mn = fmaxf(m_reg, pmax); alpha = __builtin_amdgcn_exp2f((m_reg - mn) * C); m_reg = mn; }
    float mnC = -mn * C;
#pragma unroll
    for (int r = 0; r < 16; ++r) p0[r] = fmaf(p0[r], C, mnC);
#pragma unroll
    for (int r = 0; r < 16; ++r) p1[r] = fmaf(p1[r], C, mnC);
#pragma unroll
    for (int r = 0; r < 16; ++r) p0[r] = __builtin_amdgcn_exp2f(p0[r]);
}
__device__ __forceinline__ void finishSM(f32x16& p0, f32x16& p1, float alpha, float& l_reg, bf16x8& pa0, bf16x8& pa1, bf16x8& pa2, bf16x8& pa3) {
#pragma unroll
    for (int r = 0; r < 16; ++r) p1[r] = __builtin_amdgcn_exp2f(p1[r]);
    float ps = 0;
#pragma unroll
    for (int r = 0; r < 16; ++r) ps += p0[r];
#pragma unroll
    for (int r = 0; r < 16; ++r) ps += p1[r];
    { auto rr = __builtin_amdgcn_permlane32_swap(__float_as_uint(ps), __float_as_uint(ps), false, false);
      ps = __uint_as_float(rr[0]) + __uint_as_float(rr[1]); }
    l_reg = l_reg * alpha + ps;
#define PK4(P, BASE, OUT) do { unsigned a0 = cvtpk(P[BASE + 0], P[BASE + 1]), a1 = cvtpk(P[BASE + 2], P[BASE + 3]);   \
    unsigned b0 = cvtpk(P[BASE + 4], P[BASE + 5]), b1 = cvtpk(P[BASE + 6], P[BASE + 7]);                              \
    auto r0 = __builtin_amdgcn_permlane32_swap(a0, b0, false, false); auto r1 = __builtin_amdgcn_permlane32_swap(a1, b1, false, false); \
    u32x4 w = {r0[0], r1[0], r0[1], r1[1]}; OUT = *reinterpret_cast<bf16x8*>(&w); } while (0)
    PK4(p0, 0, pa0); PK4(p0, 8, pa1); PK4(p1, 0, pa2); PK4(p1, 8, pa3);
#undef PK4
}
template <int DK>
__device__ __forceinline__ void qkt(f32x16& p0, f32x16& p1, const char* Ks, const bf16x8* qr, int r32, int hi) {
    p0 = f32x16{}; p1 = f32x16{};
#pragma unroll
    for (int d0 = 0; d0 < Cfg<DK>::ND0; ++d0) { int cb = (d0 * 16 + hi * 8) * 2;
        bf16x8 b0 = *reinterpret_cast<const bf16x8*>(Ks + kswz<DK>(r32, cb));
        bf16x8 b1 = *reinterpret_cast<const bf16x8*>(Ks + kswz<DK>(32 + r32, cb));
        p0 = __builtin_amdgcn_mfma_f32_32x32x16_bf16(b0, qr[d0], p0, 0, 0, 0);
        p1 = __builtin_amdgcn_mfma_f32_32x32x16_bf16(b1, qr[d0], p1, 0, 0, 0); }
}
__device__ __forceinline__ int v_st(int k, int c) { const int kk = (k & ~0xC) | ((k & 4) << 1) | ((k & 8) >> 1); return ((kk >> 3) * 4 + (c >> 5)) * 512 + ((kk & 7) * 32 + (c & 31)) * 2; }
__device__ __forceinline__ int v_rd_base(int lane) { return ((lane & 3) << 3) | (((lane >> 2) & 3) << 6) | (((lane >> 4) & 1) << 5) | (((lane >> 5) & 1) << 8); }
constexpr int v_rd_off(int d0, int ks, int half) { return d0 * 512 + ks * 4096 + half * 2048; }
template <int OFF> __device__ __forceinline__ s16x4 tr_read(int vb) {
    s16x4 r; asm volatile("ds_read_b64_tr_b16 %0, %1 offset:%2" : "=&v"(r) : "v"(vb), "i"(OFF) : "memory"); return r;
}
template <int D0> __device__ __forceinline__ void pv_one(f32x16& od, int vb, bf16x8 pa0, bf16x8 pa1, bf16x8 pa2, bf16x8 pa3) {
    const s16x4 l0 = tr_read<v_rd_off(D0, 0, 0)>(vb), h0 = tr_read<v_rd_off(D0, 0, 1)>(vb), l1 = tr_read<v_rd_off(D0, 1, 0)>(vb), h1 = tr_read<v_rd_off(D0, 1, 1)>(vb);
    const s16x4 l2 = tr_read<v_rd_off(D0, 2, 0)>(vb), h2 = tr_read<v_rd_off(D0, 2, 1)>(vb), l3 = tr_read<v_rd_off(D0, 3, 0)>(vb), h3 = tr_read<v_rd_off(D0, 3, 1)>(vb);
    asm volatile("s_waitcnt lgkmcnt(0)" ::: "memory"); SBAR();
#define PK(L, H) (bf16x8){L[0], L[1], L[2], L[3], H[0], H[1], H[2], H[3]}
    od = __builtin_amdgcn_mfma_f32_32x32x16_bf16(pa0, PK(l0, h0), od, 0, 0, 0);
    od = __builtin_amdgcn_mfma_f32_32x32x16_bf16(pa1, PK(l1, h1), od, 0, 0, 0);
    od = __builtin_amdgcn_mfma_f32_32x32x16_bf16(pa2, PK(l2, h2), od, 0, 0, 0);
    od = __builtin_amdgcn_mfma_f32_32x32x16_bf16(pa3, PK(l3, h3), od, 0, 0, 0);
#undef PK
}
__device__ __forceinline__ void pv_d0(f32x16* o, int vb, bf16x8 pa0, bf16x8 pa1, bf16x8 pa2, bf16x8 pa3) {
    pv_one<0>(o[0], vb, pa0, pa1, pa2, pa3); pv_one<1>(o[1], vb, pa0, pa1, pa2, pa3); pv_one<2>(o[2], vb, pa0, pa1, pa2, pa3); pv_one<3>(o[3], vb, pa0, pa1, pa2, pa3);
}

template <int DK, int LDQ, int LDK, int LDV, int LDO, int SDEPTH>
__device__ __forceinline__ void attn_dense_body(const bf16_t* __restrict__ Qb, const bf16_t* __restrict__ Kh, const bf16_t* __restrict__ Vh,
                                                bf16_t* __restrict__ Ob, int seq, char* lds) {
    using C = Cfg<DK>;
    constexpr int SHM_V = C::SHM_V, SHM_K = C::SHM_K, NKC = C::NKC, ND0 = C::ND0;
    const int tid = opaque_tid(), wid = tid >> 6, lane = tid & 63, r32 = lane & 31, hi = lane >> 5;
    char* V_lds = lds; char* K_lds = lds + 2 * SHM_V;
    float* ws = (float*)(lds + 2 * SHM_V + 2 * SHM_K) + wid * 64; float* li_l = ws; float* al_l = ws + 32;
    float m_reg = -1e30f, l_reg = 0; f32x16 o[4] = {}; bf16x8 qr[ND0];
    const bf16_t* Qw = Qb + (long)(wid * QBLK + r32) * LDQ + hi * 8;
#pragma unroll
    for (int d0 = 0; d0 < ND0; ++d0) qr[d0] = *reinterpret_cast<const bf16x8*>(Qw + d0 * 16);
    const int sr = tid >> 4, sc = (tid & 15) * 8, vst0 = v_st(sr, sc), vst1 = v_st(32 + sr, sc);
    int kgo[NKC], klo[NKC];
#pragma unroll
    for (int c = 0; c < NKC; ++c) { const int id = tid + 512 * c, kr = id / (DK / 8), kc = id % (DK / 8); kgo[c] = kr * LDK + kc * 8; klo[c] = kswz<DK>(kr, kc * 16); }
    const int vb0 = (int)(uintptr_t)V_lds + v_rd_base(lane);
    struct { bf16x8 vs0, vs1, ks[NKC]; } sr_[SDEPTH];
#define SLOAD(i, k0) do { sr_[i].vs0 = *reinterpret_cast<const bf16x8*>(&Vh[(long)((k0) + sr) * LDV + sc]); sr_[i].vs1 = *reinterpret_cast<const bf16x8*>(&Vh[(long)((k0) + 32 + sr) * LDV + sc]); \
    _Pragma("unroll") for (int c_ = 0; c_ < NKC; ++c_) sr_[i].ks[c_] = *reinterpret_cast<const bf16x8*>(&Kh[(long)(k0) * LDK + kgo[c_]]); } while (0)
#define SWRITE(b, i) do { *(bf16x8*)(V_lds + (b) * SHM_V + vst0) = sr_[i].vs0; *(bf16x8*)(V_lds + (b) * SHM_V + vst1) = sr_[i].vs1; \
    _Pragma("unroll") for (int c_ = 0; c_ < NKC; ++c_) *(bf16x8*)(K_lds + (b) * SHM_K + klo[c_]) = sr_[i].ks[c_]; } while (0)
#define SWAIT() do { if constexpr (SDEPTH == 2) { if constexpr (NKC == 2) asm volatile("s_waitcnt vmcnt(4)" ::: "memory"); else asm volatile("s_waitcnt vmcnt(5)" ::: "memory"); } \
    else asm volatile("s_waitcnt vmcnt(0)" ::: "memory"); } while (0)
#define RESC(a) do { if (__any((a) < 1.f)) { if (hi == 0) al_l[r32] = (a); asm volatile("s_waitcnt lgkmcnt(0)" ::: "memory"); \
    _Pragma("unroll") for (int d = 0; d < 4; ++d) _Pragma("unroll") for (int r = 0; r < 16; ++r) o[d][r] *= al_l[crow(r, hi)]; } } while (0)
    f32x16 pA0, pA1, pB0, pB1; float mnA, mnB, alA, alB; bf16x8 pa0, pa1, pa2, pa3; const int NT = seq / KVBLK;
    constexpr int SE = 0, SO = SDEPTH - 1;
    SLOAD(SE, 0); asm volatile("s_waitcnt vmcnt(0)" ::: "memory"); SWRITE(0, SE); __syncthreads();
    qkt<DK>(pA0, pA1, K_lds, qr, r32, hi); partialSM<DK>(pA0, pA1, m_reg, mnA, alA);
    SLOAD(SO, KVBLK); if constexpr (SDEPTH == 2) { if (2 < NT) SLOAD(SE, 2 * KVBLK); }
    SWAIT(); SWRITE(1, SO); __syncthreads();
    for (int j = 1; j + 1 < NT; j += 2) {
        SBAR(); qkt<DK>(pB0, pB1, K_lds + SHM_K, qr, r32, hi);
        finishSM(pA0, pA1, alA, l_reg, pa0, pa1, pa2, pa3); SBAR();
        SLOAD(SO, (j + SDEPTH) * KVBLK); SBAR();
        pv_d0(o, vb0, pa0, pa1, pa2, pa3); partialSM<DK>(pB0, pB1, m_reg, mnB, alB);
        __syncthreads(); SWAIT(); SWRITE(0, SE);
        RESC(alB); __syncthreads();
        SBAR(); qkt<DK>(pA0, pA1, K_lds, qr, r32, hi);
        finishSM(pB0, pB1, alB, l_reg, pa0, pa1, pa2, pa3); SBAR();
        if (SDEPTH == 1 || j + 3 < NT) SLOAD(SE, (j + 1 + SDEPTH) * KVBLK); SBAR();
        pv_d0(o, vb0 + (int)SHM_V, pa0, pa1, pa2, pa3); partialSM<DK>(pA0, pA1, m_reg, mnA, alA);
        __syncthreads(); SWAIT(); SWRITE(1, SO);
        RESC(alA); __syncthreads();
    }
    SBAR(); qkt<DK>(pB0, pB1, K_lds + SHM_K, qr, r32, hi);
    finishSM(pA0, pA1, alA, l_reg, pa0, pa1, pa2, pa3); SBAR();
    pv_d0(o, vb0, pa0, pa1, pa2, pa3); partialSM<DK>(pB0, pB1, m_reg, mnB, alB);
    __syncthreads(); RESC(alB);
    finishSM(pB0, pB1, alB, l_reg, pa0, pa1, pa2, pa3); SBAR();
    pv_d0(o, vb0 + (int)SHM_V, pa0, pa1, pa2, pa3);
    if (hi == 0) li_l[r32] = l_reg; asm volatile("s_waitcnt lgkmcnt(0)" ::: "memory");
    float rli[16];
#pragma unroll
    for (int r = 0; r < 16; ++r) rli[r] = __builtin_amdgcn_rcpf(li_l[crow(r, hi)]);
    bf16_t* Ow = Ob + (long)(wid * QBLK) * LDO;
#pragma unroll
    for (int r = 0; r < 16; ++r) { int orow = crow(r, hi);
#pragma unroll
        for (int d0 = 0; d0 < 4; ++d0) Ow[(long)orow * LDO + d0 * 32 + r32] = f2bf(o[d0][r] * rli[r]); }
#undef SLOAD
#undef SWRITE
#undef SWAIT
#undef RESC
}

template <int DK, int LDQ, int LDK, int LDV, int LDO>
__device__ __forceinline__ void attn_simple_body(const bf16_t* __restrict__ Qb, const bf16_t* __restrict__ Kh, const bf16_t* __restrict__ Vh,
                                                 bf16_t* __restrict__ Ob, int seq, char* lds) {
    using C = Cfg<DK>;
    constexpr int SHM_V = C::SHM_V, SHM_K = C::SHM_K, NKC = C::NKC, ND0 = C::ND0;
    const int tid = opaque_tid(), wid = tid >> 6, lane = tid & 63, r32 = lane & 31, hi = lane >> 5;
    char* V_lds = lds; char* K_lds = lds + 2 * SHM_V;
    float* ws = (float*)(lds + 2 * SHM_V + 2 * SHM_K) + wid * 64; float* li_l = ws; float* al_l = ws + 32;
    float m_reg = -1e30f, l_reg = 0; f32x16 o[4] = {}; bf16x8 qr[ND0];
    const bf16_t* Qw = Qb + (long)(wid * QBLK + r32) * LDQ + hi * 8;
#pragma unroll
    for (int d0 = 0; d0 < ND0; ++d0) qr[d0] = *reinterpret_cast<const bf16x8*>(Qw + d0 * 16);
    const int sr = tid >> 4, sc = (tid & 15) * 8, vst0 = v_st(sr, sc), vst1 = v_st(32 + sr, sc);
    const int vb0 = (int)(uintptr_t)V_lds + v_rd_base(lane);
    bf16x8 vs0, vs1, ks[NKC];
#define SLOAD1(k0) do { vs0 = *reinterpret_cast<const bf16x8*>(&Vh[(long)((k0) + sr) * LDV + sc]); vs1 = *reinterpret_cast<const bf16x8*>(&Vh[(long)((k0) + 32 + sr) * LDV + sc]); \
    _Pragma("unroll") for (int c_ = 0; c_ < NKC; ++c_) { const int id_ = tid + 512 * c_, kr_ = id_ / (DK / 8), kc_ = id_ % (DK / 8); ks[c_] = *reinterpret_cast<const bf16x8*>(&Kh[(long)((k0) + kr_) * LDK + kc_ * 8]); } } while (0)
#define SWRITE1(b) do { *(bf16x8*)(V_lds + (b) * SHM_V + vst0) = vs0; *(bf16x8*)(V_lds + (b) * SHM_V + vst1) = vs1; \
    _Pragma("unroll") for (int c_ = 0; c_ < NKC; ++c_) { const int id_ = tid + 512 * c_, kr_ = id_ / (DK / 8), kc_ = id_ % (DK / 8); *(bf16x8*)(K_lds + (b) * SHM_K + kswz<DK>(kr_, kc_ * 16)) = ks[c_]; } } while (0)
    f32x16 pA0, pA1; float mnA, alA; bf16x8 pa0, pa1, pa2, pa3; const int NT = seq / KVBLK;
    SLOAD1(0); asm volatile("s_waitcnt vmcnt(0)" ::: "memory"); SWRITE1(0); __syncthreads();
    for (int j = 0; j < NT; ++j) {
        const int cb = j & 1;
        if (j + 1 < NT) SLOAD1((j + 1) * KVBLK);
        SBAR(); qkt<DK>(pA0, pA1, K_lds + cb * SHM_K, qr, r32, hi);
        partialSM<DK>(pA0, pA1, m_reg, mnA, alA);
        if (__any(alA < 1.f)) { if (hi == 0) al_l[r32] = alA; asm volatile("s_waitcnt lgkmcnt(0)" ::: "memory");
#pragma unroll
            for (int d = 0; d < 4; ++d)
#pragma unroll
                for (int r = 0; r < 16; ++r) o[d][r] *= al_l[crow(r, hi)]; }
        finishSM(pA0, pA1, alA, l_reg, pa0, pa1, pa2, pa3); SBAR();
        pv_d0(o, vb0 + cb * SHM_V, pa0, pa1, pa2, pa3);
        if (j + 1 < NT) { SWRITE1(cb ^ 1); }
        __syncthreads();
    }
    if (hi == 0) li_l[r32] = l_reg; asm volatile("s_waitcnt lgkmcnt(0)" ::: "memory");
    float rli[16];
#pragma unroll
    for (int r = 0; r < 16; ++r) rli[r] = __builtin_amdgcn_rcpf(li_l[crow(r, hi)]);
    bf16_t* Ow = Ob + (long)(wid * QBLK) * LDO;
#pragma unroll
    for (int r = 0; r < 16; ++r) { int orow = crow(r, hi);
#pragma unroll
        for (int d0 = 0; d0 < 4; ++d0) Ow[(long)orow * LDO + d0 * 32 + r32] = f2bf(o[d0][r] * rli[r]); }
#undef SLOAD1
#undef SWRITE1
}
}

__device__ __forceinline__ void transpose_item(const float* W, int K, int N, int NPAD, bf16_t* WT, int mode, LAS float* scr, int item, int) {
    const int lane = opaque_tid() & 63;
    const int nblk = NPAD / 32, kb = item / nblk, nb = item % nblk, k0 = 64 * kb, n0 = 32 * nb;
    const int ncol = n0 + (lane & 31); const bool okc = ncol < N;
    float v[32];
#pragma unroll
    for (int i = 0; i < 32; ++i) { const int kk = 2 * i + (lane >> 5); v[i] = okc ? W[(size_t)(k0 + kk) * N + ncol] : 0.f; }
#pragma unroll
    for (int i = 0; i < 32; ++i) { const int kk = 2 * i + (lane >> 5); scr[kk * 33 + (lane & 31)] = v[i]; }
    LDS_WAIT(); asm volatile("" ::: "memory");
    const int c = lane & 7;
#pragma unroll
    for (int j = 0; j < 4; ++j) { const int n = (lane >> 3) + 8 * j; const LAS float* s = scr + (8 * c) * 33 + n;
        u32x4 o; o.x = cvt_pk_bf16(s[0 * 33], s[1 * 33]); o.y = cvt_pk_bf16(s[2 * 33], s[3 * 33]); o.z = cvt_pk_bf16(s[4 * 33], s[5 * 33]); o.w = cvt_pk_bf16(s[6 * 33], s[7 * 33]);
        int nn = n0 + n, drow = nn;
        if (mode == 1) { drow = (nn < FF) ? ((nn >> 7) * 256 + (nn & 127)) : (((nn - FF) >> 7) * 256 + 128 + ((nn - FF) & 127)); }
        *(u32x4*)(WT + (size_t)drow * K + k0 + 8 * c) = o; }
    LDS_WAIT(); asm volatile("" ::: "memory");
}

__device__ __forceinline__ void mod_item(const Params& p, int item, LAS float* ldsf, int) {
    const int tid = opaque_tid();
    const int l = item / 192, col0 = (item % 192) * 64, wave = tid >> 6, lane = tid & 63;
    const float* cin = p.in[1]; const float* wada = p.in[2] + (size_t)l * D * MODW; const float* bada = p.in[3] + (size_t)l * MODW;
    float* mod = (float*)(p.ws + WS_MOD) + (size_t)l * NB * MODW;
    __syncthreads();
    for (int i0 = 0; i0 < 64; i0 += 16) {
        float cv[16];
#pragma unroll
        for (int u = 0; u < 16; ++u) cv[u] = cin[tid + 512 * (i0 + u)];
#pragma unroll
        for (int u = 0; u < 16; ++u) { const int idx = tid + 512 * (i0 + u), b = idx >> 11, k = idx & 2047; ldsf[k * 16 + b] = silu_f(cv[u]); }
    }
    __syncthreads();
    float acc[16];
#pragma unroll
    for (int b = 0; b < 16; ++b) acc[b] = 0.f;
    const float* wp = wada + (size_t)(wave * 256) * MODW + col0 + lane;
    for (int k0 = 0; k0 < 256; k0 += 16) {
        float wv[16];
#pragma unroll
        for (int u = 0; u < 16; ++u) wv[u] = __builtin_nontemporal_load(wp + (size_t)(k0 + u) * MODW);
#pragma unroll
        for (int u = 0; u < 16; ++u) {
            const LAS f32x4* sp = (const LAS f32x4*)(ldsf + (wave * 256 + k0 + u) * 16);
#pragma unroll
            for (int q = 0; q < 4; ++q) { const f32x4 s4 = sp[q];
#pragma unroll
                for (int j = 0; j < 4; ++j) acc[q * 4 + j] = fmaf(s4[j], wv[u], acc[q * 4 + j]); }
        }
    }
    __syncthreads();
#pragma unroll
    for (int b = 0; b < 16; ++b) ldsf[(wave * 16 + b) * 64 + lane] = acc[b];
    __syncthreads();
#pragma unroll
    for (int q = 0; q < 2; ++q) { const int o = tid + 512 * q, b = o >> 6, cl = o & 63; float s = 0.f;
#pragma unroll
        for (int w = 0; w < 8; ++w) s += ldsf[(w * 16 + b) * 64 + cl];
        mod[(size_t)b * MODW + col0 + cl] = s + bada[col0 + cl]; }
    __syncthreads();
}

__device__ __forceinline__ void norm_mod_phase(const float* __restrict__ x, const float* __restrict__ g, const float* __restrict__ modl, int shift_off, int scale_off, bf16_t* __restrict__ outp, int gw, int NGW, int) {
    constexpr int NR = 4;
    const int lane = opaque_tid() & 63; gw = opaque_s(gw);
    for (int rowa = gw; rowa < T; rowa += NR * NGW) {
        int rows[NR]; bool has[NR];
#pragma unroll
        for (int u = 0; u < NR; ++u) { has[u] = rowa + u * NGW < T; rows[u] = has[u] ? rowa + u * NGW : rowa; }
        f32x4 v[NR][8]; float ss[NR];
#pragma unroll
        for (int u = 0; u < NR; ++u) { const f32x4* xr = (const f32x4*)(x + (size_t)rows[u] * D) + lane;
#pragma unroll
            for (int j = 0; j < 8; ++j) v[u][j] = xr[64 * j]; }
#pragma unroll
        for (int u = 0; u < NR; ++u) { float q = 0.f;
#pragma unroll
            for (int j = 0; j < 8; ++j) q += (v[u][j][0] * v[u][j][0] + v[u][j][1] * v[u][j][1]) + (v[u][j][2] * v[u][j][2] + v[u][j][3] * v[u][j][3]);
            ss[u] = q; }
#define WS_STEP(O) { _Pragma("unroll") for (int u = 0; u < NR; ++u) ss[u] += shx<O>(ss[u]); }
        XOR_STEPS(WS_STEP)
#undef WS_STEP
#pragma unroll
        for (int u = 0; u < NR; ++u) ss[u] = xsum32(ss[u]);
        float rstd[NR];
#pragma unroll
        for (int u = 0; u < NR; ++u) rstd[u] = rsqrtf(ss[u] * (1.f / D) + EPS);
#pragma unroll
        for (int j = 0; j < 8; ++j) { const int c = (lane + 64 * j) * 4;
            const f32x4 g4 = *(const f32x4*)(g + c);
            f32x4 sc4[NR], sh4[NR];
#pragma unroll
            for (int u = 0; u < NR; ++u) { const float* mb = modl + (size_t)(rows[u] >> 11) * MODW; sc4[u] = *(const f32x4*)(mb + scale_off + c); sh4[u] = *(const f32x4*)(mb + shift_off + c); }
#pragma unroll
            for (int u = 0; u < NR; ++u) { if (!has[u]) continue;
                const f32x4 y = (v[u][j] * rstd[u]) * g4 * (sc4[u] + 1.f) + sh4[u];
                u32x2 w; w.x = cvt_pk_bf16(y[0], y[1]); w.y = cvt_pk_bf16(y[2], y[3]);
                *(u32x2*)(outp + (size_t)rows[u] * D + c) = w; } }
    }
}

__device__ __forceinline__ void prep_phase(const Params& p, int layer, int gw, int NGW, int) {
    const int lane = opaque_tid() & 63; gw = opaque_s(gw);
    bf16_t* proj = (bf16_t*)(p.ws + WS_PROJ);
    bf16_t* KB = (bf16_t*)(p.ws + WS_KB); bf16_t* XBC = (bf16_t*)(p.ws + WS_XBC); float* DT = (float*)(p.ws + WS_DT);
    const float* tab = (const float*)(p.ws + WS_TAB);
    const float* tAc = tab, *tAs = tab + 2048, *tBc = tab + 4096, *tBs = tab + 4096 + 1024;
    const float* qg = p.in[7] + layer * 128; const float* kg = p.in[8] + layer * 128;
    const float* cqg = p.in[9] + layer * 512; const float* ckvg = p.in[11] + layer * 256;
    const float* convw = p.in[13] + (size_t)layer * 5 * 1280; const float* convb = p.in[14] + layer * 1280;
    const float* dtbias = p.in[15] + layer * 24;
    for (int row = gw; row < T; row += NGW) {
        const int s = row & (S - 1), ri = s >> 6, ci = s & 63;
        bf16_t* pr = proj + (size_t)row * INP;
        const int e = lane + (lane & 32), axis = lane >> 5, fi = lane & 31, idx = axis ? ci : ri;
        float x1[8], x2[8], red[10];
#pragma unroll
        for (int hh = 0; hh < 8; ++hh) { x1[hh] = bf2f(pr[128 * hh + e]); x2[hh] = bf2f(pr[128 * hh + e + 32]); }
        bf16_t* cqb = pr + C_CQ + lane * 8; bf16_t* ckb = pr + C_CKV + lane * 4;
        const bf16x8 vq = *(const bf16x8*)cqb; const s16x4 vk4 = *(const s16x4*)ckb;
        const int paxis = (lane >> 4) & 1, pfi = lane & 15, pe = pfi + 32 * paxis, pidx = paxis ? ci : ri;
        const float kx1 = bf2f(pr[C_KPE + pe]), kx2 = bf2f(pr[C_KPE + pe + 16]);
        const float dtraw = bf2f(pr[C_DT + (lane < 24 ? lane : 0)]);
        float vk[5]; int rk[5];
#pragma unroll
        for (int k = 0; k < 5; ++k) { const int s2 = s + k - 2; const bool ok = (s2 >= 0) && (s2 < S); vk[k] = ok ? 1.f : 0.f; rk[k] = ok ? (row + k - 2) : row; }
        s16x4 xv[5][5];
#pragma unroll
        for (int j = 0; j < 5; ++j)
#pragma unroll
            for (int k = 0; k < 5; ++k) xv[j][k] = *(const s16x4*)(proj + (size_t)rk[k] * INP + C_XBC + (j * 64 + lane) * 4);
        const float cs = tAc[idx * 32 + fi], sn = tAs[idx * 32 + fi];
        float fq8[8], fk4[4];
#pragma unroll
        for (int hh = 0; hh < 8; ++hh) red[hh] = x1[hh] * x1[hh] + x2[hh] * x2[hh];
        red[8] = 0.f; red[9] = 0.f;
#pragma unroll
        for (int q = 0; q < 8; ++q) { fq8[q] = bfs2f(vq[q]); red[8] += fq8[q] * fq8[q]; }
#pragma unroll
        for (int q = 0; q < 4; ++q) { fk4[q] = bfs2f(vk4[q]); red[9] += fk4[q] * fk4[q]; }
#define WS_STEP(O) { _Pragma("unroll") for (int q = 0; q < 10; ++q) red[q] += shx<O>(red[q]); }
        XOR_STEPS(WS_STEP)
#undef WS_STEP
#pragma unroll
        for (int q = 0; q < 10; ++q) red[q] = xsum32(red[q]);
        bf16_t qo1[8], qo2[8];
#pragma unroll
        for (int hh = 0; hh < 8; ++hh) {
            const float r = rsqrtf(red[hh] * (1.f / 128.f) + EPS);
            const float* gg = hh < 6 ? qg : kg;
            const float a1 = x1[hh] * r * gg[e], a2 = x2[hh] * r * gg[e + 32];
            qo1[hh] = f2bf(a1 * cs - a2 * sn); qo2[hh] = f2bf(a1 * sn + a2 * cs);
        }
        u32x4 wq; u32x2 wk;
        { const float r = rsqrtf(red[8] * (1.f / 512.f) + EPS);
          const f32x4 g0 = *(const f32x4*)(cqg + lane * 8), g1 = *(const f32x4*)(cqg + lane * 8 + 4);
          wq.x = cvt_pk_bf16(fq8[0] * r * g0[0], fq8[1] * r * g0[1]); wq.y = cvt_pk_bf16(fq8[2] * r * g0[2], fq8[3] * r * g0[3]);
          wq.z = cvt_pk_bf16(fq8[4] * r * g1[0], fq8[5] * r * g1[1]); wq.w = cvt_pk_bf16(fq8[6] * r * g1[2], fq8[7] * r * g1[3]); }
        { const float r = rsqrtf(red[9] * (1.f / 256.f) + EPS);
          const f32x4 g0 = *(const f32x4*)(ckvg + lane * 4);
          wk.x = cvt_pk_bf16(fk4[0] * r * g0[0], fk4[1] * r * g0[1]); wk.y = cvt_pk_bf16(fk4[2] * r * g0[2], fk4[3] * r * g0[3]); }
        const float pcs = tBc[pidx * 16 + pfi], psn = tBs[pidx * 16 + pfi];
        const bf16_t ko1 = f2bf(kx1 * pcs - kx2 * psn), ko2 = f2bf(kx1 * psn + kx2 * pcs);
        u32x2 co[5];
#pragma unroll
        for (int j = 0; j < 5; ++j) {
            const int c = (j * 64 + lane) * 4;
            f32x4 a = *(const f32x4*)(convb + c);
#pragma unroll
            for (int k = 0; k < 5; ++k) {
                const f32x4 w = *(const f32x4*)(convw + k * 1280 + c) * vk[k];
#pragma unroll
                for (int q = 0; q < 4; ++q) a[q] = fmaf(w[q], bfs2f(xv[j][k][q]), a[q]);
            }
            co[j].x = cvt_pk_bf16(silu_f(a[0]), silu_f(a[1])); co[j].y = cvt_pk_bf16(silu_f(a[2]), silu_f(a[3]));
        }
        const float dtv = dtraw + dtbias[lane < 24 ? lane : 0];
        const float dto = dtv > 20.f ? dtv : log1pf(expf(dtv));
#pragma unroll
        for (int hh = 0; hh < 8; ++hh) { pr[128 * hh + e] = qo1[hh]; pr[128 * hh + e + 32] = qo2[hh]; }
        *(u32x4*)cqb = wq; *(u32x2*)ckb = wk;
        if (lane < 32) { bf16_t* kb = KB + (size_t)row * 768 + 128 + pe;
#pragma unroll
            for (int hd = 0; hd < 4; ++hd) { kb[hd * 192] = ko1; kb[hd * 192 + 16] = ko2; } }
#pragma unroll
        for (int j = 0; j < 5; ++j) *(u32x2*)(XBC + (size_t)row * 1280 + (j * 64 + lane) * 4) = co[j];
        if (lane < 24) DT[(size_t)row * 24 + lane] = dto;
    }
}

__device__ __forceinline__ void ssd_item(const bf16_t* XBC, const float* DT, float* Y, float a_neg, int b, int dir, int h, LAS unsigned char* lds, int) {
    const int tid = opaque_tid();
    LAS float* Bs = (LAS float*)lds;
    LAS float* Cs = Bs + 4096;
    LAS float* Xs = Cs + 4096;
    LAS float* Ys = Xs + 2048;
    LAS float* dAs = Ys + 2048;
    LAS float* dts = dAs + 32;
    const int g = h / 6, pp = tid >> 3, nq = tid & 7, srow = tid >> 4, sc = tid & 15;
    const size_t rowbase = (size_t)b * S;
    float hst[16];
#pragma unroll
    for (int j = 0; j < 16; ++j) hst[j] = 0.f;
    bf16x8 rB, rC; s16x4 rX; float rdt = 0.f;
#define SSD_LOAD(blk) do { const int i_ = (blk) * 32 + srow, t_ = dir ? (S - 1 - i_) : i_; const bf16_t* rp_ = XBC + (rowbase + t_) * 1280; \
        rB = *(const bf16x8*)(rp_ + 768 + g * 128 + sc * 8); rC = *(const bf16x8*)(rp_ + 1024 + g * 128 + sc * 8); rX = *(const s16x4*)(rp_ + h * 64 + sc * 4); \
        if (tid < 32) { const int i2_ = (blk) * 32 + tid, t2_ = dir ? (S - 1 - i2_) : i2_; rdt = DT[(rowbase + t2_) * 24 + dir * 12 + h]; } } while (0)
#define SSD_STORE() do { f32x4 b0_, b1_, c0_, c1_, x_; \
        _Pragma("unroll") for (int k_ = 0; k_ < 4; ++k_) { b0_[k_] = bfs2f(rB[k_]); b1_[k_] = bfs2f(rB[4 + k_]); c0_[k_] = bfs2f(rC[k_]); c1_[k_] = bfs2f(rC[4 + k_]); x_[k_] = bfs2f(rX[k_]); } \
        *(LAS f32x4*)(Bs + srow * 128 + sc * 8) = b0_; *(LAS f32x4*)(Bs + srow * 128 + sc * 8 + 4) = b1_; \
        *(LAS f32x4*)(Cs + srow * 128 + sc * 8) = c0_; *(LAS f32x4*)(Cs + srow * 128 + sc * 8 + 4) = c1_; \
        *(LAS f32x4*)(Xs + srow * 64 + sc * 4) = x_; \
        if (tid < 32) { dts[tid] = rdt; dAs[tid] = expf(rdt * a_neg); } } while (0)
    SSD_LOAD(0); SSD_STORE(); __syncthreads();
    for (int blk = 0; blk < S / 32; ++blk) {
        if (blk + 1 < S / 32) SSD_LOAD(blk + 1);
        for (int i = 0; i < 32; ++i) {
            const float dAt = dAs[i], xdt = Xs[i * 64 + pp] * dts[i];
            float acc = 0.f;
#pragma unroll
            for (int j = 0; j < 4; ++j) {
                const f32x4 bv = *(const LAS f32x4*)(Bs + i * 128 + 32 * j + 4 * nq), cv = *(const LAS f32x4*)(Cs + i * 128 + 32 * j + 4 * nq);
#pragma unroll
                for (int k = 0; k < 4; ++k) { hst[4 * j + k] = fmaf(hst[4 * j + k], dAt, xdt * bv[k]); acc = fmaf(cv[k], hst[4 * j + k], acc); }
            }
            acc += __shfl_xor(acc, 1); acc += __shfl_xor(acc, 2); acc += __shfl_xor(acc, 4);
            if (nq == 0) Ys[i * 64 + pp] = acc;
        }
        __syncthreads();
        { const int i_ = blk * 32 + srow, t_ = dir ? (S - 1 - i_) : i_;
          *(f32x4*)(Y + (rowbase + t_) * 768 + h * 64 + sc * 4) = *(const LAS f32x4*)(Ys + srow * 64 + sc * 4); }
        if (blk + 1 < S / 32) SSD_STORE();
        __syncthreads();
    }
#undef SSD_LOAD
#undef SSD_STORE
}


namespace ssdm {
using namespace att;
__device__ __forceinline__ int v_st_e(int k, int c) { const int kk = (k & ~0xC) | ((k & 4) << 1) | ((k & 8) >> 1); return ((kk >> 3) * 4 + (c >> 5)) * 512 + ((kk & 7) * 32 + (c & 31)) * 2; }
__device__ __forceinline__ void upd_one(f32x16& acc, int vbA, int vbB) {
    const s16x4 al0 = tr_read<v_rd_off(0, 0, 0)>(vbA), ah0 = tr_read<v_rd_off(0, 0, 1)>(vbA), al1 = tr_read<v_rd_off(0, 1, 0)>(vbA), ah1 = tr_read<v_rd_off(0, 1, 1)>(vbA);
    const s16x4 al2 = tr_read<v_rd_off(0, 2, 0)>(vbA), ah2 = tr_read<v_rd_off(0, 2, 1)>(vbA), al3 = tr_read<v_rd_off(0, 3, 0)>(vbA), ah3 = tr_read<v_rd_off(0, 3, 1)>(vbA);
    const s16x4 bl0 = tr_read<v_rd_off(0, 0, 0)>(vbB), bh0 = tr_read<v_rd_off(0, 0, 1)>(vbB), bl1 = tr_read<v_rd_off(0, 1, 0)>(vbB), bh1 = tr_read<v_rd_off(0, 1, 1)>(vbB);
    const s16x4 bl2 = tr_read<v_rd_off(0, 2, 0)>(vbB), bh2 = tr_read<v_rd_off(0, 2, 1)>(vbB), bl3 = tr_read<v_rd_off(0, 3, 0)>(vbB), bh3 = tr_read<v_rd_off(0, 3, 1)>(vbB);
    asm volatile("s_waitcnt lgkmcnt(0)" ::: "memory"); SBAR();
#define PK(L, H) (bf16x8){L[0], L[1], L[2], L[3], H[0], H[1], H[2], H[3]}
    acc = __builtin_amdgcn_mfma_f32_32x32x16_bf16(PK(al0, ah0), PK(bl0, bh0), acc, 0, 0, 0);
    acc = __builtin_amdgcn_mfma_f32_32x32x16_bf16(PK(al1, ah1), PK(bl1, bh1), acc, 0, 0, 0);
    acc = __builtin_amdgcn_mfma_f32_32x32x16_bf16(PK(al2, ah2), PK(bl2, bh2), acc, 0, 0, 0);
    acc = __builtin_amdgcn_mfma_f32_32x32x16_bf16(PK(al3, ah3), PK(bl3, bh3), acc, 0, 0, 0);
#undef PK
}
__device__ __forceinline__ void ssd_item(const bf16_t* XBC, const float* DT, float* Y, float a_neg, int b, int dir, int h, char* shm) {
    const int tid = opaque_tid(), wid = tid >> 6, lane = tid & 63, r32 = lane & 31, hi = lane >> 5;
    const int rb = wid & 3, ph = wid >> 2, g = h / 6;
    char* Kimg = shm; char* BV = shm + 32768; char* XI = shm + 65536; char* SI = shm + 98304;
    float* acs_l = (float*)(shm + MISC_OFF + 256); float* dts_l = acs_l + 128;
    const int vbB = (int)(uintptr_t)BV + v_rd_base(lane), vbX = (int)(uintptr_t)XI + v_rd_base(lane), vbS = (int)(uintptr_t)SI + v_rd_base(lane);
    const size_t rowbase = (size_t)b * S;
#define TOK(i) (dir ? (S - 1 - (i)) : (i))
#pragma unroll
    for (int i = 0; i < 4; ++i) *(u32x4*)(SI + (tid + 512 * i) * 16) = (u32x4){0u, 0u, 0u, 0u};
    f32x16 Sacc = {};
    bf16x8 rB[4], rX[2]; float rdt = 0.f;
    const int srow = tid >> 2, scq = tid & 3;
#define SSDM_LOAD(c) do { \
        _Pragma("unroll") for (int i_ = 0; i_ < 4; ++i_) { const int id_ = tid + 512 * i_, row_ = id_ >> 4, c8_ = id_ & 15; \
            rB[i_] = *(const bf16x8*)(XBC + (rowbase + TOK((c) * 128 + row_)) * 1280 + 768 + g * 128 + c8_ * 8); } \
        { const bf16_t* xp_ = XBC + (rowbase + TOK((c) * 128 + srow)) * 1280 + h * 64 + scq * 16; rX[0] = *(const bf16x8*)xp_; rX[1] = *(const bf16x8*)(xp_ + 8); } \
        if (tid < 128) rdt = DT[(rowbase + TOK((c) * 128 + tid)) * 24 + dir * 12 + h]; } while (0)
    SSDM_LOAD(0);
    for (int c = 0; c < S / 128; ++c) {
        bf16x8 qr[8];
        { const bf16_t* cp = XBC + (rowbase + TOK(c * 128 + 32 * rb + r32)) * 1280 + 1024 + g * 128 + hi * 8;
#pragma unroll
          for (int d0 = 0; d0 < 8; ++d0) qr[d0] = *(const bf16x8*)(cp + d0 * 16); }
#pragma unroll
        for (int i = 0; i < 4; ++i) { const int id = tid + 512 * i, row = id >> 4, c8 = id & 15, tt = row >> 6, k = row & 63;
            *(bf16x8*)(Kimg + tt * 16384 + kswz<128>(k, c8 * 16)) = rB[i]; *(bf16x8*)(BV + tt * 16384 + v_st(k, c8 * 8)) = rB[i]; }
        if (tid < 128) dts_l[tid] = rdt;
        __syncthreads();
        int ln = lane; asm volatile("" : "+v"(ln));
        float x_lo = dts_l[ln] * a_neg, x_hi = dts_l[64 + ln] * a_neg;
#pragma unroll
        for (int o = 1; o < 64; o <<= 1) { const int ad = (ln - o) << 2;
            const float v0 = __int_as_float(__builtin_amdgcn_ds_bpermute(ad, __float_as_int(x_lo))), v1 = __int_as_float(__builtin_amdgcn_ds_bpermute(ad, __float_as_int(x_hi)));
            if (ln >= o) { x_lo += v0; x_hi += v1; } }
        x_hi += __int_as_float(__builtin_amdgcn_readlane(__float_as_int(x_lo), 63));
        const float acs_last = __int_as_float(__builtin_amdgcn_readlane(__float_as_int(x_hi), 63));
        if (wid == 0) { acs_l[ln] = x_lo; acs_l[64 + ln] = x_hi; }
        { const int sl = ((ln >> 2) + 16 * wid) & 63;
          const float as_lo = __int_as_float(__builtin_amdgcn_ds_bpermute(sl << 2, __float_as_int(x_lo))), as_hi = __int_as_float(__builtin_amdgcn_ds_bpermute(sl << 2, __float_as_int(x_hi)));
          const float acs_s = (srow < 64) ? as_lo : as_hi;
          const float dt_s = dts_l[srow], e_s = dt_s * __expf(acs_last - acs_s);
          const int tt = srow >> 6, k = srow & 63;
#pragma unroll
          for (int hf = 0; hf < 2; ++hf) { float f[8];
#pragma unroll
              for (int j = 0; j < 8; ++j) f[j] = bfs2f(rX[hf][j]);
              u32x4 wd, we;
              wd.x = cvt_pk_bf16(f[0] * dt_s, f[1] * dt_s); wd.y = cvt_pk_bf16(f[2] * dt_s, f[3] * dt_s); wd.z = cvt_pk_bf16(f[4] * dt_s, f[5] * dt_s); wd.w = cvt_pk_bf16(f[6] * dt_s, f[7] * dt_s);
              we.x = cvt_pk_bf16(f[0] * e_s, f[1] * e_s); we.y = cvt_pk_bf16(f[2] * e_s, f[3] * e_s); we.z = cvt_pk_bf16(f[4] * e_s, f[5] * e_s); we.w = cvt_pk_bf16(f[6] * e_s, f[7] * e_s);
              const int cc = scq * 16 + hf * 8;
              *(u32x4*)(XI + tt * 16384 + v_st(k, cc)) = wd; *(u32x4*)(XI + tt * 16384 + v_st(k, cc + 64)) = we; } }
        if (c + 1 < S / 128) SSDM_LOAD(c + 1);
        __syncthreads();
        f32x16 o_off = {}, o_diag = {};
        pv_one<0>(o_off, vbS + ph * 512, qr[0], qr[1], qr[2], qr[3]);
        pv_one<0>(o_off, vbS + ph * 512 + 16384, qr[4], qr[5], qr[6], qr[7]);
        const float acs_row = acs_l[32 * rb + r32];
        for (int jt = 0; jt <= (rb >> 1); ++jt) {
            f32x16 p0, p1;
            qkt<128>(p0, p1, Kimg + jt * 16384, qr, r32, hi);
            const int lrow = 32 * rb + r32;
#pragma unroll
            for (int r = 0; r < 16; ++r) {
                const int s0 = 64 * jt + crow(r, hi), s1 = s0 + 32;
                const float m0 = __expf(acs_row - acs_l[s0]), m1 = __expf(acs_row - acs_l[s1]);
                p0[r] = (s0 <= lrow) ? p0[r] * m0 : 0.f; p1[r] = (s1 <= lrow) ? p1[r] * m1 : 0.f;
            }
            bf16x8 pa0, pa1, pa2, pa3;
#define PK4(P, BASE, OUT) do { unsigned a0 = cvtpk(P[BASE + 0], P[BASE + 1]), a1 = cvtpk(P[BASE + 2], P[BASE + 3]);   \
    unsigned b0 = cvtpk(P[BASE + 4], P[BASE + 5]), b1 = cvtpk(P[BASE + 6], P[BASE + 7]);                              \
    auto r0 = __builtin_amdgcn_permlane32_swap(a0, b0, false, false); auto r1 = __builtin_amdgcn_permlane32_swap(a1, b1, false, false); \
    u32x4 w = {r0[0], r1[0], r0[1], r1[1]}; OUT = *reinterpret_cast<bf16x8*>(&w); } while (0)
            PK4(p0, 0, pa0); PK4(p0, 8, pa1); PK4(p1, 0, pa2); PK4(p1, 8, pa3);
#undef PK4
            pv_one<0>(o_diag, vbX + ph * 512 + jt * 16384, pa0, pa1, pa2, pa3);
        }
        float ea[16];
#pragma unroll
        for (int r = 0; r < 16; ++r) ea[r] = __expf(acs_l[32 * rb + crow(r, hi)]);
#pragma unroll
        for (int r = 0; r < 16; ++r) { const int row = 32 * rb + crow(r, hi);
            Y[(rowbase + TOK(c * 128 + row)) * 768 + h * 64 + 32 * ph + r32] = o_diag[r] + o_off[r] * ea[r]; }
        { const float eA = __expf(acs_last);
#pragma unroll
          for (int r = 0; r < 16; ++r) Sacc[r] *= eA;
          upd_one(Sacc, vbB + rb * 512, vbX + (2 + ph) * 512);
          upd_one(Sacc, vbB + rb * 512 + 16384, vbX + (2 + ph) * 512 + 16384); }
        __syncthreads();
        if (c + 1 < S / 128) {
#pragma unroll
            for (int r = 0; r < 16; ++r) { const int n = 32 * rb + crow(r, hi);
                *(bf16_t*)(SI + (n >> 6) * 16384 + v_st_e(n & 63, 32 * ph + r32)) = f2bf_c(Sacc[r]); }
        }
    }
#undef SSDM_LOAD
#undef TOK
}
}

__device__ __forceinline__ void combine_phase(const Params& p, int layer, int gw, int NGW, int) {
    const int lane = opaque_tid() & 63; gw = opaque_s(gw);
    const bf16_t* proj = (const bf16_t*)(p.ws + WS_PROJ); const bf16_t* XBC = (const bf16_t*)(p.ws + WS_XBC);
    const float* YF = (const float*)(p.ws + WS_YF); const float* YB = (const float*)(p.ws + WS_YB);
    bf16_t* ACT = (bf16_t*)(p.ws + WS_ACT);
    const float* dskip = p.in[17] + layer * 12; const float* ng = p.in[18] + layer * 768;
    for (int rowa = gw; rowa < T; rowa += 2 * NGW) {
        const bool has1 = rowa + NGW < T; const int rows[2] = {rowa, has1 ? rowa + NGW : rowa};
        f32x4 a[2][3], bq[2][3]; s16x4 xv[2][3], zv[2][3];
#pragma unroll
        for (int u = 0; u < 2; ++u)
#pragma unroll
            for (int j = 0; j < 3; ++j) { const int c = j * 256 + lane * 4; const size_t row = (size_t)rows[u];
                a[u][j] = *(const f32x4*)(YF + row * 768 + c); bq[u][j] = *(const f32x4*)(YB + row * 768 + c);
                xv[u][j] = *(const s16x4*)(XBC + row * 1280 + c); zv[u][j] = *(const s16x4*)(proj + row * INP + C_Z + c); }
        f32x4 y[2][3]; float ss[4] = {0.f, 0.f, 0.f, 0.f};
#pragma unroll
        for (int u = 0; u < 2; ++u)
#pragma unroll
            for (int j = 0; j < 3; ++j) { const int c = j * 256 + lane * 4; const float dsk = dskip[c >> 6]; float q = 0.f;
#pragma unroll
                for (int k = 0; k < 4; ++k) { const float v = (a[u][j][k] + bq[u][j][k] + bfs2f(xv[u][j][k]) * dsk) * silu_f(bfs2f(zv[u][j][k])); y[u][j][k] = v; q += v * v; }
                if (c < 384) ss[2 * u] += q; else ss[2 * u + 1] += q; }
#define WS_STEP(O) { _Pragma("unroll") for (int q = 0; q < 4; ++q) ss[q] += shx<O>(ss[q]); }
        XOR_STEPS(WS_STEP)
#undef WS_STEP
#pragma unroll
        for (int q = 0; q < 4; ++q) ss[q] = xsum32(ss[q]);
        f32x4 gn4[3];
#pragma unroll
        for (int j = 0; j < 3; ++j) gn4[j] = *(const f32x4*)(ng + j * 256 + lane * 4);
#pragma unroll
        for (int u = 0; u < 2; ++u) { if (u == 1 && !has1) break;
            const float r0 = rsqrtf(ss[2 * u] * (1.f / 384.f) + EPS), r1 = rsqrtf(ss[2 * u + 1] * (1.f / 384.f) + EPS);
#pragma unroll
            for (int j = 0; j < 3; ++j) { const int c = j * 256 + lane * 4; const float r = c < 384 ? r0 : r1;
                const f32x4 g4 = gn4[j];
                u32x2 w; w.x = cvt_pk_bf16(y[u][j][0] * r * g4[0], y[u][j][1] * r * g4[1]); w.y = cvt_pk_bf16(y[u][j][2] * r * g4[2], y[u][j][3] * r * g4[3]);
                *(u32x2*)(ACT + (size_t)rows[u] * D + 1280 + c) = w; } }
    }
}

__device__ __forceinline__ void gsync(cg::grid_group& grid) {
    asm volatile("s_waitcnt vmcnt(0) lgkmcnt(0)" ::: "memory");
    grid.sync();
    if (__builtin_amdgcn_readfirstlane(threadIdx.x >> 6) == 0) { __builtin_amdgcn_fence(__ATOMIC_ACQUIRE, "agent"); asm volatile("s_waitcnt vmcnt(0)" ::: "memory"); }
    __syncthreads();
}
#define XB_TMO      128
#define XB_XCNT(j)  (256  + 64 * (j))
#define XB_XSUB(j)  (1280 + 64 * (j))
#define XB_XGEN(j)  (2304 + 64 * (j))
#define XB_TOP      3328
#define XB_TOPGEN   3392
#define XCD_BAR_WORDS 3456
#define XB_SPIN_CAP (1u << 18)
__device__ __forceinline__ unsigned xb_ld(unsigned* p)              { return __hip_atomic_load(p, __ATOMIC_RELAXED, __HIP_MEMORY_SCOPE_AGENT); }
__device__ __forceinline__ unsigned xb_add(unsigned* p, unsigned v) { return __hip_atomic_fetch_add(p, v, __ATOMIC_RELAXED, __HIP_MEMORY_SCOPE_AGENT); }
__device__ __forceinline__ unsigned xb_xcc_id() { return (unsigned)__builtin_amdgcn_s_getreg((3 << 11) | 20) & 0xFu; }
#define XB_SPIN(cond, bar) do { unsigned _sp = 0; while (cond) { __builtin_amdgcn_s_sleep(1); \
    if ((++_sp & 255u) == 0u) { if (xb_ld(&(bar)[XB_TMO])) break; if (_sp > XB_SPIN_CAP) { atomicAdd(&(bar)[XB_TMO], 1u); break; } } } } while (0)
struct XcdBarrier { unsigned* bar; unsigned x; volatile LAS unsigned* st; };
__device__ __forceinline__ XcdBarrier xcd_barrier_post(unsigned* bar, volatile LAS unsigned* st) {
    XcdBarrier b; b.bar = bar; b.x = xb_xcc_id(); b.st = st;
    if (opaque_tid() == 0) (void)xb_add(&bar[XB_XCNT(b.x)], 1u);
    return b;
}
__device__ __forceinline__ void xcd_barrier_complete(unsigned* bar, unsigned x, unsigned& nloc, unsigned& nx) {
    const unsigned G = gridDim.x * gridDim.y * gridDim.z;
    unsigned sum, cnt, mine, sp = 0u;
    for (;;) {
        sum = 0u; cnt = 0u; mine = 0u;
#pragma unroll
        for (unsigned j = 0; j < 16; ++j) { const unsigned c = xb_ld(&bar[XB_XCNT(j)]); sum += c; cnt += (c > 0u) ? 1u : 0u; mine = (j == x) ? c : mine; }
        if (sum == G) break;
        __builtin_amdgcn_s_sleep(1);
        if ((++sp & 255u) == 0u) { if (xb_ld(&bar[XB_TMO])) break; if (sp > XB_SPIN_CAP) { atomicAdd(&bar[XB_TMO], 1u); break; } }
    }
    nloc = mine > 0u ? mine : 1u; nx = cnt > 0u ? cnt : 1u;
}
__device__ __forceinline__ void xcd_barrier(const XcdBarrier& b) {
    asm volatile("s_waitcnt vmcnt(0)" ::: "memory");
    __syncthreads();
    if (opaque_tid() == 0) {
        unsigned* bar = b.bar;
        __builtin_amdgcn_s_waitcnt(0);
        unsigned nloc = b.st[0], nx = b.st[1];
        if (nloc == 0u) { xcd_barrier_complete(bar, b.x, nloc, nx); b.st[0] = nloc; b.st[1] = nx; }
        const unsigned old = xb_add(&bar[XB_XSUB(b.x)], 1u);
        const unsigned gen = old / nloc;
        if (old + 1u == (gen + 1u) * nloc) {
            __builtin_amdgcn_fence(__ATOMIC_RELEASE, "agent");
            asm volatile("s_waitcnt vmcnt(0)" ::: "memory");
            const unsigned og = xb_add(&bar[XB_TOP], 1u);
            const unsigned tg = og / nx;
            if (og + 1u == (tg + 1u) * nx) xb_add(&bar[XB_TOPGEN], 1u);
            else XB_SPIN(xb_ld(&bar[XB_TOPGEN]) == tg, bar);
            __builtin_amdgcn_fence(__ATOMIC_ACQUIRE, "agent");
            xb_add(&bar[XB_XGEN(b.x)], 1u);
            asm volatile("s_waitcnt vmcnt(0)" ::: "memory");
        } else {
            XB_SPIN(xb_ld(&bar[XB_XGEN(b.x)]) == gen, bar);
            __builtin_amdgcn_fence(__ATOMIC_ACQUIRE, "agent");
            asm volatile("s_waitcnt vmcnt(0)" ::: "memory");
        }
    }
    __syncthreads();
}
#ifndef EXP_SSD2
#define EXP_SSD2 0
#endif
#ifndef EXP_ELT2
#define EXP_ELT2 0
#endif
#ifndef EXP_GU2
#define EXP_GU2 0
#endif
#ifndef PROBE_PHASE
#define PROBE_PHASE 99
#endif
#define PROBE_T0(k) unsigned long long _t0 = 0; if (PROBE_PHASE == (k)) _t0 = __builtin_amdgcn_s_memrealtime();
#define PROBE_T1(k) if (PROBE_PHASE == (k)) { if (blockIdx.x == 0 && opaque_tid() == 0) { const unsigned long long _t1 = __builtin_amdgcn_s_memrealtime(); while (__builtin_amdgcn_s_memrealtime() - _t1 < _t1 - _t0) __builtin_amdgcn_s_sleep(8); } gsync(grid); }
#ifndef PH_MASK
#define PH_MASK 0xffff
#endif
#ifndef MLA_SD
#define MLA_SD 1
#endif
constexpr int N_SSD = NB * 2 * 12, N_MLA = NB * 4 * 8, N_GQA = NB * 6 * 8, N_MIX = N_SSD + N_MLA + N_GQA;

__global__ void __launch_bounds__(512, 2) fwd_megakernel(Params p) {
    extern __shared__ __attribute__((aligned(16))) unsigned char smem[];
    cg::grid_group grid = cg::this_grid();
    LAS unsigned char* lds = (LAS unsigned char*)smem;
    volatile LAS unsigned* MISC = (volatile LAS unsigned*)(lds + MISC_OFF);
    const int wave = __builtin_amdgcn_readfirstlane(threadIdx.x >> 6);
    const int G = gridDim.x, bx = blockIdx.x;
    if (threadIdx.x < 2) MISC[8 + threadIdx.x] = 0u;
    __syncthreads();
    (void)xcd_barrier_post((unsigned*)(p.ws + WS_BAR), MISC + 8);
#define XBAR() do { XcdBarrier xb_; xb_.bar = (unsigned*)(p.ws + WS_BAR); xb_.x = xb_xcc_id(); xb_.st = MISC + 8; xcd_barrier(xb_); } while (0)
    const int gw = bx * 8 + wave, NGW = G * 8;
    unsigned char* ws = p.ws;
    unsigned* ctl = (unsigned*)(ws + WS_CTL);
    float* modall = (float*)(ws + WS_MOD);
    float* tab = (float*)(ws + WS_TAB);
    bf16_t* ACT = (bf16_t*)(ws + WS_ACT); bf16_t* PROJ = (bf16_t*)(ws + WS_PROJ);
    bf16_t* QB = (bf16_t*)(ws + WS_QB); bf16_t* KB = (bf16_t*)(ws + WS_KB); bf16_t* VB = (bf16_t*)(ws + WS_VB);
    bf16_t* XBC = (bf16_t*)(ws + WS_XBC); float* DT = (float*)(ws + WS_DT); float* YF = (float*)(ws + WS_YF); float* YB = (float*)(ws + WS_YB);
    bf16_t* HID = (bf16_t*)(ws + WS_HID);

    {
        if (bx == 0 && opaque_tid() < DEPTH) ctl[16 + opaque_tid()] = 0u;
        for (int it = bx; it < DEPTH * 192; it += G) mod_item(p, it, (LAS float*)lds, 0);
        __syncthreads();
        { const int gt = bx * 512 + opaque_tid();
          if (gt < 2048) { const int idx = gt >> 5, i = gt & 31; const float inv = powf(10000.f, -(float)(2 * i) / 64.f); const float ang = (float)idx * inv; tab[gt] = cosf(ang); tab[2048 + gt] = sinf(ang); }
          else if (gt < 3072) { const int q = gt - 2048, idx = q >> 4, i = q & 15; const float inv = powf(10000.f, -(float)(2 * i) / 32.f); const float ang = (float)idx * inv; tab[4096 + q] = cosf(ang); tab[4096 + 1024 + q] = sinf(ang); } }
        LAS float* scr = (LAS float*)(lds + wave * 16384);
        constexpr int I_IN = (D / 64) * (INP / 32), I_UQ = (512 / 64) * (768 / 32), I_UKV = (256 / 64) * (1024 / 32), I_OUT = (D / 64) * (D / 32), I_GU = (D / 64) * (2 * FF / 32), I_DN = (FF / 64) * (D / 32);
        constexpr int I_LAYER = I_IN + I_UQ + I_UKV + I_OUT + I_GU + I_DN;
        static_assert(DEPTH * I_LAYER == 47232, "balance constants below assume this item count");
        int it_b, it_e, it_s;
        if (G == 256) { it_s = 1;
            if (bx < 128) { it_b = gw * 13; it_e = it_b + 13; }
            else { const int lw = gw - 1024; it_b = 13312 + lw * 33 + (lw < 128 ? lw : 128); it_e = it_b + 33 + (lw < 128 ? 1 : 0); } }
        else { it_b = gw; it_e = DEPTH * I_LAYER; it_s = NGW; }
        for (int it = it_b; it < it_e; it += it_s) {
            const int l = it / I_LAYER; int r = it % I_LAYER;
            unsigned char* wl = ws + WS_W + (size_t)l * W_LAYER;
            if (r < I_IN) { transpose_item(p.in[6] + (size_t)l * D * INC, D, INC, INP, (bf16_t*)(wl + W_IN), 0, scr, r, 0); continue; } r -= I_IN;
            if (r < I_UQ) { transpose_item(p.in[10] + (size_t)l * 512 * 768, 512, 768, 768, (bf16_t*)(wl + W_UQ), 0, scr, r, 0); continue; } r -= I_UQ;
            if (r < I_UKV) { transpose_item(p.in[12] + (size_t)l * 256 * 1024, 256, 1024, 1024, (bf16_t*)(wl + W_UKV), 0, scr, r, 0); continue; } r -= I_UKV;
            if (r < I_OUT) { transpose_item(p.in[19] + (size_t)l * D * D, D, D, D, (bf16_t*)(wl + W_OUT), 0, scr, r, 0); continue; } r -= I_OUT;
            if (r < I_GU) { transpose_item(p.in[20] + (size_t)l * D * 2 * FF, D, 2 * FF, 2 * FF, (bf16_t*)(wl + W_GU), 1, scr, r, 0); continue; } r -= I_GU;
            transpose_item(p.in[21] + (size_t)l * FF * D, FF, D, D, (bf16_t*)(wl + W_DN), 0, scr, r, 0);
        }
    }
    gsync(grid);

    for (int layer = 0; layer < DEPTH; ++layer) {
        const unsigned char* wl = ws + WS_W + (size_t)layer * W_LAYER;
        const float* modl = modall + (size_t)layer * NB * MODW;
        const float* xin = layer == 0 ? p.in[0] : p.out;
        norm_mod_phase(xin, p.in[4] + layer * D, modl, 0, D, ACT, gw, NGW, 0);
        if (EXP_ELT2) norm_mod_phase(xin, p.in[4] + layer * D, modl, 0, D, ACT, gw, NGW, 0);
        XBAR();
        #if PH_MASK & (1<<2)
        { pg8::Gemm g{ACT, (const bf16_t*)(wl + W_IN), T, INP, D, D}; pg8::StaticOrder so; so.init(T, INP, G, bx);
          pg8::EpiProj E{PROJ}; pg8::gemm_phase<pg8::EpiProj>(lds, g, so, E); }

#endif
        XBAR();
        prep_phase(p, layer, gw, NGW, 0);
        XBAR();
        #if PH_MASK & (1<<4)
        { pg8::Gemm g{PROJ + C_CQ, (const bf16_t*)(wl + W_UQ), T, 768, 512, INP}; pg8::StaticOrder so; so.init(T, 768, G, bx);
          pg8::EpiUq E{QB, tab + 4096, tab + 4096 + 1024}; pg8::gemm_phase<pg8::EpiUq>(lds, g, so, E); }

#endif
        #if PH_MASK & (1<<5)
        { pg8::Gemm g{PROJ + C_CKV, (const bf16_t*)(wl + W_UKV), T, 1024, 256, INP}; pg8::StaticOrder so; so.init(T, 1024, G, bx);
          pg8::EpiUkv E{KB, VB}; pg8::gemm_phase<pg8::EpiUkv>(lds, g, so, E); }

#endif
        XBAR();
        PROBE_T0(5)
        {
            const float* alog = p.in[16] + layer * 24;
            for (;;) {
                __syncthreads();
                if (opaque_tid() == 0) MISC[0] = atomicAdd(ctl + 16 + layer, 1u);
                __syncthreads();
                int it = (int)MISC[0];
                if (it >= N_MIX + (EXP_SSD2 ? N_SSD : 0)) break;
                if (EXP_SSD2 && it >= N_MIX) it -= N_MIX;
                if (it < N_SSD) {
                    const int h = it % 12, dir = (it / 12) & 1, b = it / 24;
#ifndef NO_SSD
                    ssdm::ssd_item(XBC, DT, dir ? YB : YF, -expf(alog[dir * 12 + h]), b, dir, h, (char*)smem);
#endif
                } else if (it < N_SSD + N_MLA) {
                    const int i = it - N_SSD, qb = i & 7, h = (i >> 3) & 3, b = i >> 5;
                    const size_t r0 = (size_t)b * S;
#ifndef NO_MLA
                    att::attn_simple_body<192, 768, 768, 512, D>(QB + (r0 + qb * 256) * 768 + h * 192, KB + r0 * 768 + h * 192, VB + r0 * 512 + h * 128,
                                                                ACT + (r0 + qb * 256) * D + 768 + h * 128, S, (char*)smem);
#endif
                } else {
                    const int i = it - N_SSD - N_MLA, qb = i & 7, h = (i >> 3) % 6, b = i / 48;
                    const size_t r0 = (size_t)b * S;
#ifndef NO_GQA
                    att::attn_dense_body<128, INP, INP, INP, D, 2>(PROJ + (r0 + qb * 256) * INP + C_QA + h * 128, PROJ + r0 * INP + C_KA + (h / 3) * 128, PROJ + r0 * INP + C_VA + (h / 3) * 128,
                                                                ACT + (r0 + qb * 256) * D + h * 128, S, (char*)smem);
#endif
                }
            }
        }
        XBAR();
        PROBE_T1(5)
        combine_phase(p, layer, gw, NGW, 0);
        if (EXP_ELT2) combine_phase(p, layer, gw, NGW, 0);
        XBAR();
        #if PH_MASK & (1<<7)
        { pg8::Gemm g{ACT, (const bf16_t*)(wl + W_OUT), T, D, D, D}; pg8::StaticOrder so; so.init(T, D, G, bx);
          pg8::EpiResid E{xin, p.out, modl + 2 * D}; pg8::gemm_phase<pg8::EpiResid>(lds, g, so, E); }

#endif
        XBAR();
        norm_mod_phase(p.out, p.in[5] + layer * D, modl, 3 * D, 4 * D, ACT, gw, NGW, 0);
        if (EXP_ELT2) norm_mod_phase(p.out, p.in[5] + layer * D, modl, 3 * D, 4 * D, ACT, gw, NGW, 0);
        XBAR();
        #if PH_MASK & (1<<9)
        { pg8::Gemm g{ACT, (const bf16_t*)(wl + W_GU), T, 2 * FF, D, D}; pg8::StaticOrder so; so.init(T, 2 * FF, G, bx);
          pg8::EpiSwiglu E{HID}; pg8::gemm_phase<pg8::EpiSwiglu>(lds, g, so, E);
          if (EXP_GU2) pg8::gemm_phase<pg8::EpiSwiglu>(lds, g, so, E); }

#endif
        XBAR();
        #if PH_MASK & (1<<10)
        { pg8::Gemm g{HID, (const bf16_t*)(wl + W_DN), T, D, FF, FF}; pg8::StaticOrder so; so.init(T, D, G, bx);
          pg8::EpiResid E{p.out, p.out, modl + 5 * D}; pg8::gemm_phase<pg8::EpiResid>(lds, g, so, E); }

#endif
        XBAR();
    }
    {
        const float* fg = p.in[22]; const int lane = opaque_tid() & 63; const int gw2 = opaque_s(gw);
        for (int row0 = gw2; row0 < T; row0 += 2 * NGW) {
            const int row1 = row0 + NGW; const bool has1 = row1 < T;
            f32x4* xr0 = (f32x4*)(p.out + (size_t)row0 * D) + lane; f32x4* xr1 = (f32x4*)(p.out + (size_t)(has1 ? row1 : row0) * D) + lane;
            f32x4 v0[8], v1[8]; float ss0 = 0.f, ss1 = 0.f;
#pragma unroll
            for (int j = 0; j < 8; ++j) { v0[j] = xr0[64 * j]; v1[j] = xr1[64 * j]; }
#pragma unroll
            for (int j = 0; j < 8; ++j) { ss0 += (v0[j][0] * v0[j][0] + v0[j][1] * v0[j][1]) + (v0[j][2] * v0[j][2] + v0[j][3] * v0[j][3]);
                                          ss1 += (v1[j][0] * v1[j][0] + v1[j][1] * v1[j][1]) + (v1[j][2] * v1[j][2] + v1[j][3] * v1[j][3]); }
            wave_sum2(ss0, ss1);
            const float rstd0 = rsqrtf(ss0 * (1.f / D) + EPS), rstd1 = rsqrtf(ss1 * (1.f / D) + EPS);
            f32x4 g4[8];
#pragma unroll
            for (int j = 0; j < 8; ++j) g4[j] = *(const f32x4*)(fg + (lane + 64 * j) * 4);
#pragma unroll
            for (int j = 0; j < 8; ++j) { xr0[64 * j] = (v0[j] * rstd0) * g4[j]; if (has1) xr1[64 * j] = (v1[j] * rstd1) * g4[j]; }
        }
    }
}

#undef XBAR
extern "C" void kernel_launch(void* const* d_in, const int* in_sizes, int n_in, void* d_out, int out_size, void* d_ws, size_t ws_size, hipStream_t stream) {
    static int grid_blocks = 0;
    if (grid_blocks == 0) {
        if (n_in != 23 || in_sizes[0] != T * D || out_size != T * D || ws_size < WS_END) {
            fprintf(stderr, "kernel_launch: shape/workspace mismatch: n_in %d in0 %d out %d ws %zu (need %zu); nothing launched\n", n_in, n_in > 0 ? in_sizes[0] : -1, out_size, ws_size, (size_t)WS_END);
            grid_blocks = -1; return; }
        int dev = 0, cus = 0, per_cu = 0;
        hipGetDevice(&dev);
        hipDeviceGetAttribute(&cus, hipDeviceAttributeMultiprocessorCount, dev);
        if (hipFuncSetAttribute((const void*)fwd_megakernel, hipFuncAttributeMaxDynamicSharedMemorySize, LDS_BYTES) != hipSuccess) { fprintf(stderr, "kernel_launch: hipFuncSetAttribute failed\n"); grid_blocks = -1; return; }
        if (hipOccupancyMaxActiveBlocksPerMultiprocessor(&per_cu, (const void*)fwd_megakernel, 512, LDS_BYTES) != hipSuccess || per_cu < 1) { fprintf(stderr, "kernel_launch: occupancy query failed (%d)\n", per_cu); (void)hipGetLastError(); per_cu = 1; }
        grid_blocks = cus * per_cu;
        fprintf(stderr, "kernel_launch: grid %d (cus %d x %d), ws need %zu of %zu\n", grid_blocks, cus, per_cu, (size_t)WS_END, ws_size);
    }
    if (grid_blocks < 0) return;
    if (hipMemsetAsync((char*)d_ws + WS_BAR, 0, 16384, stream) != hipSuccess) { fprintf(stderr, "kernel_launch: memset of the barrier words failed\n"); return; }
    Params p{};
    for (int i = 0; i < 23; ++i) p.in[i] = (const float*)d_in[i];
    p.out = (float*)d_out; p.ws = (unsigned char*)d_ws;
    void* args[] = {&p};
    hipError_t e = hipLaunchCooperativeKernel((const void*)fwd_megakernel, dim3(grid_blocks), dim3(512), args, LDS_BYTES, stream);
    if (e != hipSuccess) fprintf(stderr, "kernel_launch: cooperative launch failed: %s (grid %d)\n", hipGetErrorString(e), grid_blocks);
}
```

```cpp
#include <hip/hip_runtime.h>
#include <hip/hip_cooperative_groups.h>
#include <cstdio>
#include <cstdint>
namespace cg = cooperative_groups;

#define LAS __attribute__((address_space(3)))
typedef unsigned short bf16_t;
typedef short bf16x8 __attribute__((ext_vector_type(8)));
typedef short s16x4 __attribute__((ext_vector_type(4)));
typedef float f32x2 __attribute__((ext_vector_type(2)));
typedef float f32x4 __attribute__((ext_vector_type(4)));
typedef float f32x16 __attribute__((ext_vector_type(16)));
typedef unsigned u32x2 __attribute__((ext_vector_type(2)));
typedef unsigned u32x4 __attribute__((ext_vector_type(4)));

constexpr int NB = 16, S = 2048, D = 2048, T = NB * S, DEPTH = 2;
constexpr int INC = 4184, INP = 4352;
constexpr int FF = 5632;
constexpr int C_QA = 0, C_KA = 768, C_VA = 1024, C_CQ = 1280, C_CKV = 1792, C_KPE = 2048, C_Z = 2112, C_XBC = 2880, C_DT = 4160;
constexpr float EPS = 1e-6f;
constexpr int MODW = 6 * D;

constexpr size_t al256(size_t x) { return (x + 255) / 256 * 256; }
constexpr size_t WS_CTL = 0;
constexpr size_t WS_MOD = 4096;
constexpr size_t WS_TAB = WS_MOD + (size_t)DEPTH * NB * MODW * 4;
constexpr size_t WS_BAR = al256(WS_TAB + (64 * 32 * 2 + 64 * 16 * 2) * 4);
constexpr size_t WS_W   = al256(WS_BAR + 16384);
constexpr size_t W_IN = 0, W_UQ = W_IN + (size_t)INP * D * 2, W_UKV = W_UQ + (size_t)768 * 512 * 2, W_OUT = W_UKV + (size_t)1024 * 256 * 2,
                 W_GU = W_OUT + (size_t)D * D * 2, W_DN = W_GU + (size_t)2 * FF * D * 2, W_LAYER = W_DN + (size_t)D * FF * 2;
constexpr size_t WS_ACT = al256(WS_W + DEPTH * W_LAYER);
constexpr size_t WS_BIG = WS_ACT + (size_t)T * D * 2;
constexpr size_t WS_PROJ = WS_BIG;
constexpr size_t WS_QB = WS_PROJ + (size_t)T * INP * 2;
constexpr size_t WS_KB = WS_QB + (size_t)T * 768 * 2;
constexpr size_t WS_VB = WS_KB + (size_t)T * 768 * 2;
constexpr size_t WS_XBC = WS_VB + (size_t)T * 512 * 2;
constexpr size_t WS_DT = WS_XBC + (size_t)T * 1280 * 2;
constexpr size_t WS_YF = WS_DT + (size_t)T * 24 * 4;
constexpr size_t WS_YB = WS_YF + (size_t)T * 768 * 4;
constexpr size_t WS_END1 = WS_YB + (size_t)T * 768 * 4;
constexpr size_t WS_HID = WS_BIG;
constexpr size_t WS_END2 = WS_HID + (size_t)T * FF * 2;
constexpr size_t WS_END = WS_END1 > WS_END2 ? WS_END1 : WS_END2;

constexpr int RING_BYTES = 131072, MISC_OFF = RING_BYTES, LDS_BYTES = 147456;

struct Params { const float* in[23]; float* out; unsigned char* ws; };

__device__ __forceinline__ float bf2f(bf16_t b) { return __uint_as_float(((unsigned)b) << 16); }
__device__ __forceinline__ float bfs2f(short b) { return __uint_as_float(((unsigned)(unsigned short)b) << 16); }
__device__ __forceinline__ unsigned cvt_pk_bf16(float lo, float hi) { unsigned r; asm volatile("v_cvt_pk_bf16_f32 %0, %1, %2" : "=v"(r) : "v"(lo), "v"(hi)); return r; }
__device__ __forceinline__ bf16_t f2bf_c(float f) { unsigned u = __float_as_uint(f); u += 0x7fffu + ((u >> 16) & 1u); return (bf16_t)(u >> 16); }
__device__ __forceinline__ unsigned pk2c(float lo, float hi) { return (unsigned)f2bf_c(lo) | ((unsigned)f2bf_c(hi) << 16); }
__device__ __forceinline__ bf16_t f2bf(float f) { return (bf16_t)(cvt_pk_bf16(f, 0.f) & 0xffffu); }
template <int O> __device__ __forceinline__ float shx(float x) {
    static_assert(O < 32, "within a 32-lane half");
    return __int_as_float(__builtin_amdgcn_ds_swizzle(__float_as_int(x), 0x1f | (O << 10)));
}
__device__ __forceinline__ float xsum32(float x) { auto rr = __builtin_amdgcn_permlane32_swap(__float_as_uint(x), __float_as_uint(x), false, false); return __uint_as_float(rr[0]) + __uint_as_float(rr[1]); }
#define XOR_STEPS(BODY) { BODY(1) BODY(2) BODY(4) BODY(8) BODY(16) }
__device__ __forceinline__ float wave_sum(float v) {
#define WS_STEP(O) v += shx<O>(v);
    XOR_STEPS(WS_STEP)
#undef WS_STEP
    return xsum32(v);
}
__device__ __forceinline__ void wave_sum2(float& a, float& b) {
#define WS_STEP(O) { const float ta = shx<O>(a), tb = shx<O>(b); a += ta; b += tb; }
    XOR_STEPS(WS_STEP)
#undef WS_STEP
    a = xsum32(a); b = xsum32(b);
}
__device__ __forceinline__ float silu_f(float x) { return x * __builtin_amdgcn_rcpf(1.f + __expf(-x)); }
__device__ __forceinline__ int opaque_tid() { int t = threadIdx.x; asm volatile("" : "+v"(t)); return t; }
__device__ __forceinline__ int opaque_s(int x) { asm volatile("" : "+s"(x)); return x; }
#define LDS_WAIT() asm volatile("s_waitcnt lgkmcnt(0)" ::: "memory")

namespace pg8 {
constexpr int BM = 256, BK = 64, HALF = 128, HTB = HALF * BK * 2, STAGE_BYTES = 8 * HTB, NXCD = 8, WGM = 8;
__host__ __device__ __forceinline__ int lds_byte(int r, int c) { const int st = (r >> 4) * 2 + (c >> 5), rr = r & 15, cc = c & 31, ob = rr * 64 + cc * 2; return st * 1024 + (ob ^ (((ob >> 9) & 1) << 5)); }
__host__ __device__ __forceinline__ void stage_rc(int b, int& R, int& C) { const int st = b / 1024, sb = b % 1024, swz = sb ^ (((sb >> 9) & 1) << 5); R = (st >> 1) * 16 + swz / 64; C = (st & 1) * 32 + (swz % 64) / 2; }
__host__ __device__ __forceinline__ int perm32(int rho) { const int n = rho >> 4, i = rho & 15; return 8 * (i >> 2) + 4 * n + (i & 3); }

struct Unit { int pm, pn; };
struct Gemm { const bf16_t* A; const bf16_t* Bt; int M, N, K, lda; };

struct StaticOrder {
    int nM, nN, nwg, G, c;
    __device__ void init(int M, int N, int G_, int c_) { nM = M / BM; nN = N / BM; nwg = nM * nN; G = G_; c = c_; }
    __device__ bool next(int i, Unit& u) const {
        const long L = (long)i * G + c; if (L >= nwg) return false;
        int wgid = (int)L; { const int q = nwg / NXCD, r = nwg % NXCD, xcd = wgid % NXCD, off = wgid / NXCD; wgid = (xcd < r ? xcd * (q + 1) : r * (q + 1) + (xcd - r) * q) + off; }
        const int nig = WGM * nN, gid = wgid / nig, fm = gid * WGM, gsz = (nM - fm) < WGM ? (nM - fm) : WGM;
        u.pm = fm + ((wgid % nig) % gsz); u.pn = (wgid % nig) / gsz; return true;
    }
};

template <class Epi>
__device__ __forceinline__ void gemm_phase(LAS unsigned char* lds, const Gemm g, const StaticOrder& S, const Epi& E) {
    const int tid = opaque_tid(), wid = __builtin_amdgcn_readfirstlane(tid >> 6), lane = tid & 63, wr = wid >> 2, wc = wid & 3, fr = lane & 15, fq = lane >> 4;
    const int K = g.K, nt = K / BK;
    unsigned voffA[2], voffB[2];
#pragma unroll
    for (int i = 0; i < 2; ++i) { int R, C; stage_rc(tid * 16 + i * 8192, R, C); const int Rb = Epi::PERM ? ((R & ~31) + perm32(R & 31)) : R;
        voffA[i] = (unsigned)(R * g.lda + C) * 2u; voffB[i] = (unsigned)(Rb * K + C) * 2u; }
    const size_t kstep = (size_t)(BK * 2);
    const size_t hstepA = (size_t)HALF * g.lda * 2, hstepB = (size_t)HALF * K * 2;
    const size_t tstepA = 2 * hstepA, tstepB = 2 * hstepB;
    const unsigned ldsw = (unsigned)wid * 1024u;
    const int aoff = lds_byte(wr * 64 + fr, fq * 8), boff = lds_byte(wc * 32 + fr, fq * 8);
#define PG8_SA(b, h) (((b) * 2 + (h)) * HTB)
#define PG8_SB(b, h) ((4 + (b) * 2 + (h)) * HTB)
#define PG8_STAGE(bufoff, gbase, voff) do { _Pragma("unroll") for (int _i = 0; _i < 2; ++_i) \
        __builtin_amdgcn_global_load_lds((const unsigned*)((const char*)(gbase) + (voff)[_i]), (LAS unsigned*)(lds + (bufoff) + ldsw + _i * 8192), 16, 0, 0); } while (0)
#define PG8_LDA(dst, b, h) do { _Pragma("unroll") for (int m = 0; m < 4; ++m) _Pragma("unroll") for (int k = 0; k < 2; ++k) dst[m][k] = *(const LAS bf16x8*)(lds + PG8_SA(b, h) + aoff + m * 2048 + k * 1024); } while (0)
#define PG8_LDB(dst, b, h) do { _Pragma("unroll") for (int n = 0; n < 2; ++n) _Pragma("unroll") for (int k = 0; k < 2; ++k) dst[n][k] = *(const LAS bf16x8*)(lds + PG8_SB(b, h) + boff + n * 2048 + k * 1024); } while (0)
#define PG8_MMA(ai, bj, At, Bt) do { __builtin_amdgcn_s_setprio(1); _Pragma("unroll") for (int m = 0; m < 4; ++m) _Pragma("unroll") for (int n = 0; n < 2; ++n) _Pragma("unroll") for (int k = 0; k < 2; ++k) \
        acc[ai][bj][m][n] = __builtin_amdgcn_mfma_f32_16x16x32_bf16(Bt[n][k], At[m][k], acc[ai][bj][m][n], 0, 0, 0); __builtin_amdgcn_s_setprio(0); } while (0)
#define PG8_WAIT_V(n) asm volatile("s_waitcnt vmcnt(" #n ")" ::: "memory")
#define PG8_WAIT_L(n) asm volatile("s_waitcnt lgkmcnt(" #n ")" ::: "memory")
#define PG8_BAR __builtin_amdgcn_s_barrier()
#define PG8_SCHED __builtin_amdgcn_sched_barrier(0)
    Unit cur, nxt; int ui = 0;
    if (!S.next(0, cur)) return;
    f32x4 acc[2][2][4][2];
#pragma unroll
    for (int a = 0; a < 2; ++a)
#pragma unroll
        for (int b = 0; b < 2; ++b)
#pragma unroll
            for (int m = 0; m < 4; ++m)
#pragma unroll
                for (int n = 0; n < 2; ++n) acc[a][b][m][n] = (f32x4){0.f, 0.f, 0.f, 0.f};
    bf16x8 At[4][2], B0[2][2], B1[2][2];
    const char* cA = (const char*)g.A + (size_t)cur.pm * tstepA; const char* cB = (const char*)g.Bt + (size_t)cur.pn * tstepB;
    PG8_STAGE(PG8_SB(0, 0), cB, voffB); PG8_STAGE(PG8_SB(0, 1), cB + hstepB, voffB); PG8_STAGE(PG8_SA(0, 0), cA, voffA); PG8_STAGE(PG8_SA(0, 1), cA + hstepA, voffA);
    if (wr == 1) PG8_BAR;
    PG8_WAIT_V(2); PG8_BAR;
    PG8_STAGE(PG8_SB(1, 0), cB + kstep, voffB); PG8_STAGE(PG8_SA(1, 0), cA + kstep, voffA); PG8_STAGE(PG8_SB(1, 1), cB + hstepB + kstep, voffB);
    PG8_WAIT_V(6); PG8_BAR;
    for (;;) {
        const bool has_next = S.next(ui + 1, nxt);
        const char* nA = has_next ? (const char*)g.A + (size_t)nxt.pm * tstepA : cA; const char* nB = has_next ? (const char*)g.Bt + (size_t)nxt.pn * tstepB : cB;
#pragma nounroll
        for (int t = 0; t < nt; t += 2) {
            const bool last = (t == nt - 2);
            const char* a1 = cA + (size_t)(t + 1) * kstep;
            const char* a2 = last ? nA : cA + (size_t)(t + 2) * kstep; const char* b2 = last ? nB : cB + (size_t)(t + 2) * kstep;
            const char* a3 = a2 + kstep; const char* b3 = b2 + kstep;
            PG8_LDB(B0, 0, 0); PG8_LDB(B1, 0, 1); PG8_SCHED; PG8_LDA(At, 0, 0); PG8_STAGE(PG8_SA(1, 1), a1 + hstepA, voffA);
            PG8_WAIT_V(8); PG8_WAIT_L(0); PG8_BAR; PG8_MMA(0, 0, At, B0); PG8_MMA(0, 1, At, B1); PG8_BAR; PG8_SCHED;
            PG8_LDA(At, 0, 1); PG8_STAGE(PG8_SB(0, 0), b2, voffB); PG8_STAGE(PG8_SB(0, 1), b2 + hstepB, voffB); PG8_STAGE(PG8_SA(0, 0), a2, voffA);
            PG8_WAIT_V(8); PG8_WAIT_L(0); PG8_BAR; PG8_MMA(1, 0, At, B0); PG8_MMA(1, 1, At, B1); PG8_BAR; PG8_SCHED;
            PG8_LDB(B0, 1, 0); PG8_LDB(B1, 1, 1); PG8_SCHED; PG8_LDA(At, 1, 0); PG8_STAGE(PG8_SA(0, 1), a2 + hstepA, voffA);
            PG8_WAIT_V(8); PG8_WAIT_L(0); PG8_BAR; PG8_MMA(0, 0, At, B0); PG8_MMA(0, 1, At, B1); PG8_BAR; PG8_SCHED;
            PG8_LDA(At, 1, 1); PG8_STAGE(PG8_SB(1, 0), b3, voffB); PG8_STAGE(PG8_SB(1, 1), b3 + hstepB, voffB); PG8_STAGE(PG8_SA(1, 0), a3, voffA);
            PG8_WAIT_V(8); PG8_WAIT_L(0); PG8_BAR; PG8_MMA(1, 0, At, B0); PG8_MMA(1, 1, At, B1); PG8_BAR; PG8_SCHED;
        }
        if (wr == 0) PG8_BAR;
        E(acc, cur, wr, wc, fr, fq);
        if (!has_next) break;
#pragma unroll
        for (int a = 0; a < 2; ++a)
#pragma unroll
            for (int b = 0; b < 2; ++b)
#pragma unroll
                for (int m = 0; m < 4; ++m)
#pragma unroll
                    for (int n = 0; n < 2; ++n) acc[a][b][m][n] = (f32x4){0.f, 0.f, 0.f, 0.f};
        cur = nxt; cA = nA; cB = nB; ++ui;
        if (wr == 1) PG8_BAR;
    }
    PG8_WAIT_V(0);
    PG8_BAR;
#undef PG8_SA
#undef PG8_SB
#undef PG8_STAGE
#undef PG8_LDA
#undef PG8_LDB
#undef PG8_MMA
#undef PG8_WAIT_V
#undef PG8_WAIT_L
#undef PG8_BAR
#undef PG8_SCHED
}

struct EpiProj {
    static constexpr bool PERM = true;
    bf16_t* O;
    __device__ __forceinline__ void operator()(const f32x4 (&acc)[2][2][4][2], const Unit& u, int wr, int wc, int fr, int fq) const {
        const int row0 = u.pm * BM + wr * 64 + fr, col0 = u.pn * BM + wc * 32 + 8 * fq;
#pragma unroll
        for (int ai = 0; ai < 2; ++ai)
#pragma unroll
            for (int m = 0; m < 4; ++m) { bf16_t* rowp = O + (size_t)(row0 + ai * HALF + m * 16) * INP + col0;
#pragma unroll
                for (int bj = 0; bj < 2; ++bj) { const f32x4 v0 = acc[ai][bj][m][0], v1 = acc[ai][bj][m][1];
                    u32x4 w; w.x = cvt_pk_bf16(v0[0], v0[1]); w.y = cvt_pk_bf16(v0[2], v0[3]); w.z = cvt_pk_bf16(v1[0], v1[1]); w.w = cvt_pk_bf16(v1[2], v1[3]);
                    *(u32x4*)(rowp + bj * HALF) = w; } }
    }
};
struct EpiUq {
    static constexpr bool PERM = false;
    bf16_t* O; const float* tcos; const float* tsin;
    __device__ __forceinline__ void operator()(const f32x4 (&acc)[2][2][4][2], const Unit& u, int wr, int wc, int fr, int fq) const {
        const int row0 = u.pm * BM + wr * 64 + fr;
#pragma unroll
        for (int bj = 0; bj < 2; ++bj) {
            const int cg = u.pn * BM + bj * HALF + wc * 32, w = cg % 192;
            const int axis = (w == 128) ? 0 : ((w == 160) ? 1 : -1);
#pragma unroll
            for (int ai = 0; ai < 2; ++ai)
#pragma unroll
                for (int m = 0; m < 4; ++m) {
                    const int r = row0 + ai * HALF + m * 16, s = r & (S - 1);
                    f32x4 x1 = acc[ai][bj][m][0], x2 = acc[ai][bj][m][1];
                    if (axis >= 0) {
                        const int idx = axis ? (s & 63) : (s >> 6);
                        const f32x4 c = *(const f32x4*)(tcos + idx * 16 + 4 * fq), sn = *(const f32x4*)(tsin + idx * 16 + 4 * fq);
                        const f32x4 o1 = x1 * c - x2 * sn, o2 = x1 * sn + x2 * c; x1 = o1; x2 = o2;
                    }
                    bf16_t* rowp = O + (size_t)r * 768 + cg + 4 * fq;
                    u32x2 w0, w1; w0.x = pk2c(x1[0], x1[1]); w0.y = pk2c(x1[2], x1[3]); w1.x = pk2c(x2[0], x2[1]); w1.y = pk2c(x2[2], x2[3]);
                    *(u32x2*)(rowp) = w0; *(u32x2*)(rowp + 16) = w1;
                }
        }
    }
};
struct EpiUkv {
    static constexpr bool PERM = true;
    bf16_t* KB; bf16_t* VB;
    __device__ __forceinline__ void operator()(const f32x4 (&acc)[2][2][4][2], const Unit& u, int wr, int wc, int fr, int fq) const {
        const int row0 = u.pm * BM + wr * 64 + fr, cin = wc * 32 + 8 * fq;
#pragma unroll
        for (int ai = 0; ai < 2; ++ai)
#pragma unroll
            for (int m = 0; m < 4; ++m) { const size_t r = (size_t)(row0 + ai * HALF + m * 16);
#pragma unroll
                for (int bj = 0; bj < 2; ++bj) { const f32x4 v0 = acc[ai][bj][m][0], v1 = acc[ai][bj][m][1];
                    u32x4 w; w.x = pk2c(v0[0], v0[1]); w.y = pk2c(v0[2], v0[3]); w.z = pk2c(v1[0], v1[1]); w.w = pk2c(v1[2], v1[3]);
                    bf16_t* dst = bj == 0 ? (KB + r * 768 + u.pn * 192 + cin) : (VB + r * 512 + u.pn * 128 + cin);
                    *(u32x4*)dst = w; } }
    }
};
struct EpiResid {
    static constexpr bool PERM = false;
    const float* in; float* out; const float* gate;
    __device__ __forceinline__ void operator()(const f32x4 (&acc)[2][2][4][2], const Unit& u, int wr, int wc, int fr, int fq) const {
        const int row0 = u.pm * BM + wr * 64 + fr, col0 = u.pn * BM + wc * 32 + 4 * fq;
        const float* gb = gate + (size_t)(u.pm >> 3) * MODW + col0;
        f32x4 gv[2][2];
#pragma unroll
        for (int bj = 0; bj < 2; ++bj)
#pragma unroll
            for (int n = 0; n < 2; ++n) gv[bj][n] = *(const f32x4*)(gb + bj * HALF + n * 16);
#pragma unroll
        for (int ai = 0; ai < 2; ++ai)
#pragma unroll
            for (int mp = 0; mp < 2; ++mp) {
                f32x4 bs[2][2][2];
#pragma unroll
                for (int mm = 0; mm < 2; ++mm) { const size_t off = (size_t)(row0 + ai * HALF + (2 * mp + mm) * 16) * D + col0;
#pragma unroll
                    for (int bj = 0; bj < 2; ++bj)
#pragma unroll
                        for (int n = 0; n < 2; ++n) bs[mm][bj][n] = *(const f32x4*)(in + off + bj * HALF + n * 16); }
#pragma unroll
                for (int mm = 0; mm < 2; ++mm) { const size_t off = (size_t)(row0 + ai * HALF + (2 * mp + mm) * 16) * D + col0;
#pragma unroll
                    for (int bj = 0; bj < 2; ++bj)
#pragma unroll
                        for (int n = 0; n < 2; ++n) *(f32x4*)(out + off + bj * HALF + n * 16) = bs[mm][bj][n] + gv[bj][n] * acc[ai][bj][2 * mp + mm][n]; }
                asm volatile("" ::: "memory"); }
    }
};
struct EpiSwiglu {
    static constexpr bool PERM = true;
    bf16_t* O;
    __device__ __forceinline__ void operator()(const f32x4 (&acc)[2][2][4][2], const Unit& u, int wr, int wc, int fr, int fq) const {
        const int row0 = u.pm * BM + wr * 64 + fr, col0 = u.pn * HALF + wc * 32 + 8 * fq;
#pragma unroll
        for (int ai = 0; ai < 2; ++ai)
#pragma unroll
            for (int m = 0; m < 4; ++m) { bf16_t* rowp = O + (size_t)(row0 + ai * HALF + m * 16) * FF + col0;
                f32x4 h0, h1;
#pragma unroll
                for (int j = 0; j < 4; ++j) { h0[j] = silu_f(acc[ai][0][m][0][j]) * acc[ai][1][m][0][j]; h1[j] = silu_f(acc[ai][0][m][1][j]) * acc[ai][1][m][1][j]; }
                u32x4 w; w.x = cvt_pk_bf16(h0[0], h0[1]); w.y = cvt_pk_bf16(h0[2], h0[3]); w.z = cvt_pk_bf16(h1[0], h1[1]); w.w = cvt_pk_bf16(h1[2], h1[3]);
                *(u32x4*)rowp = w; }
    }
};
}

namespace att {
constexpr int NW = 8, QBLK = 32, KVBLK = 64, DV = 128;
constexpr float THR = 8.f;
#define SBAR() __builtin_amdgcn_sched_barrier(0)
__device__ __forceinline__ int crow(int r, int hi) { return (r & 3) + 8 * (r >> 2) + 4 * hi; }
__device__ __forceinline__ unsigned cvtpk(float lo, float hi) { unsigned r; asm volatile("v_cvt_pk_bf16_f32 %0, %1, %2" : "=v"(r) : "v"(lo), "v"(hi)); return r; }

template <int DK> struct Cfg {
    static constexpr float SCALE = (DK == 128) ? 0.088388347648318440f : 0.072168783648703220f;
    static constexpr int KROWB = DK * 2;
    static constexpr int SHM_V = KVBLK * DV * 2, SHM_K = KVBLK * DK * 2;
    static constexpr int SHM = 2 * SHM_V + 2 * SHM_K + NW * 64 * 4;
    static constexpr int NKC = DK / 64;
    static constexpr int ND0 = DK / 16;
};
template <int DK> __device__ __forceinline__ int kswz(int row, int colB) { return row * (DK * 2) + (colB ^ ((row & 7) << 4)); }

template <int DK>
__device__ __forceinline__ void partialSM(f32x16& p0, f32x16& p1, float& m_reg, float& mn, float& alpha) {
    constexpr float SCALE = Cfg<DK>::SCALE;
    constexpr float C = SCALE * 1.4426950408889634f;
    float pmax = p0[0];
#pragma unroll
    for (int r = 1; r < 16; ++r) pmax = fmaxf(pmax, p0[r]);
#pragma unroll
    for (int r = 0; r < 16; ++r) pmax = fmaxf(pmax, p1[r]);
    { auto rr = __builtin_amdgcn_permlane32_swap(__float_as_uint(pmax), __float_as_uint(pmax), false, false);
      pmax = fmaxf(__uint_as_float(rr[0]), __uint_as_float(rr[1])); }
    if (__builtin_expect(__all(pmax - m_reg <= THR / SCALE), 1)) { mn = m_reg; alpha = 1.f; }
    else { mn = fmaxf(m_reg, pmax); alpha = __builtin_amdgcn_exp2f((m_reg - mn) * C); m_reg = mn; }
    float mnC = -mn * C;
#pragma unroll
    for (int r = 0; r < 16; ++r) p0[r] = fmaf(p0[r], C, mnC);
#pragma unroll
    for (int r = 0; r < 16; ++r) p1[r] = fmaf(p1[r], C, mnC);
#pragma unroll
    for (int r = 0; r < 16; ++r) p0[r] = __builtin_amdgcn_exp2f(p0[r]);
}
__device__ __forceinline__ void finishSM(f32x16& p0, f32x16& p1, float alpha, float& l_reg, bf16x8& pa0, bf16x8& pa1, bf16x8& pa2, bf16x8& pa3) {
#pragma unroll
    for (int r = 0; r < 16; ++r) p1[r] = __builtin_amdgcn_exp2f(p1[r]);
    float ps = 0;
#pragma unroll
    for (int r = 0; r < 16; ++r) ps += p0[r];
#pragma unroll
    for (int r = 0; r < 16; ++r) ps += p1[r];
    { auto rr = __builtin_amdgcn_permlane32_swap(__float_as_uint(ps), __float_as_uint(ps), false, false);
      ps = __uint_as_float(rr[0]) + __uint_as_float(rr[1]); }
    l_reg = l_reg * alpha + ps;
#define PK4(P, BASE, OUT) do { unsigned a0 = cvtpk(P[BASE + 0], P[BASE + 1]), a1 = cvtpk(P[BASE + 2], P[BASE + 3]);   \
    unsigned b0 = cvtpk(P[BASE + 4], P[BASE + 5]), b1 = cvtpk(P[BASE + 6], P[BASE + 7]);                              \
    auto r0 = __builtin_amdgcn_permlane32_swap(a0, b0, false, false); auto r1 = __builtin_amdgcn_permlane32_swap(a1, b1, false, false); \
    u32x4 w = {r0[0], r1[0], r0[1], r1[1]}; OUT = *reinterpret_cast<bf16x8*>(&w); } while (0)
    PK4(p0, 0, pa0); PK4(p0, 8, pa1); PK4(p1, 0, pa2); PK4(p1, 8, pa3);
#undef PK4
}
template <int DK>
__device__ __forceinline__ void qkt(f32x16& p0, f32x16& p1, const char* Ks, const bf16x8* qr, int r32, int hi) {
    p0 = f32x16{}; p1 = f32x16{};
#pragma unroll
    for (int d0 = 0; d0 < Cfg<DK>::ND0; ++d0) { int cb = (d0 * 16 + hi * 8) * 2;
        bf16x8 b0 = *reinterpret_cast<const bf16x8*>(Ks + kswz<DK>(r32, cb));
        bf16x8 b1 = *reinterpret_cast<const bf16x8*>(Ks + kswz<DK>(32 + r32, cb));
        p0 = __builtin_amdgcn_mfma_f32_32x32x16_bf16(b0, qr[d0], p0, 0, 0, 0);
        p1 = __builtin_amdgcn_mfma_f32_32x32x16_bf16(b1, qr[d0], p1, 0, 0, 0); }
}
__device__ __forceinline__ int v_st(int k, int c) { const int kk = (k & ~0xC) | ((k & 4) << 1) | ((k & 8) >> 1); return ((kk >> 3) * 4 + (c >> 5)) * 512 + ((kk & 7) * 32 + (c & 31)) * 2; }
__device__ __forceinline__ int v_rd_base(int lane) { return ((lane & 3) << 3) | (((lane >> 2) & 3) << 6) | (((lane >> 4) & 1) << 5) | (((lane >> 5) & 1) << 8); }
constexpr int v_rd_off(int d0, int ks, int half) { return d0 * 512 + ks * 4096 + half * 2048; }
template <int OFF> __device__ __forceinline__ s16x4 tr_read(int vb) {
    s16x4 r; asm volatile("ds_read_b64_tr_b16 %0, %1 offset:%2" : "=&v"(r) : "v"(vb), "i"(OFF) : "memory"); return r;
}
template <int D0> __device__ __forceinline__ void pv_one(f32x16& od, int vb, bf16x8 pa0, bf16x8 pa1, bf16x8 pa2, bf16x8 pa3) {
    const s16x4 l0 = tr_read<v_rd_off(D0, 0, 0)>(vb), h0 = tr_read<v_rd_off(D0, 0, 1)>(vb), l1 = tr_read<v_rd_off(D0, 1, 0)>(vb), h1 = tr_read<v_rd_off(D0, 1, 1)>(vb);
    const s16x4 l2 = tr_read<v_rd_off(D0, 2, 0)>(vb), h2 = tr_read<v_rd_off(D0, 2, 1)>(vb), l3 = tr_read<v_rd_off(D0, 3, 0)>(vb), h3 = tr_read<v_rd_off(D0, 3, 1)>(vb);
    asm volatile("s_waitcnt lgkmcnt(0)" ::: "memory"); SBAR();
#define PK(L, H) (bf16x8){L[0], L[1], L[2], L[3], H[0], H[1], H[2], H[3]}
    od = __builtin_amdgcn_mfma_f32_32x32x16_bf16(pa0, PK(l0, h0), od, 0, 0, 0);
    od = __builtin_amdgcn_mfma_f32_32x32x16_bf16(pa1, PK(l1, h1), od, 0, 0, 0);
    od = __builtin_amdgcn_mfma_f32_32x32x16_bf16(pa2, PK(l2, h2), od, 0, 0, 0);
    od = __builtin_amdgcn_mfma_f32_32x32x16_bf16(pa3, PK(l3, h3), od, 0, 0, 0);
#undef PK
}
__device__ __forceinline__ void pv_d0(f32x16* o, int vb, bf16x8 pa0, bf16x8 pa1, bf16x8 pa2, bf16x8 pa3) {
    pv_one<0>(o[0], vb, pa0, pa1, pa2, pa3); pv_one<1>(o[1], vb, pa0, pa1, pa2, pa3); pv_one<2>(o[2], vb, pa0, pa1, pa2, pa3); pv_one<3>(o[3], vb, pa0, pa1, pa2, pa3);
}

template <int DK, int LDQ, int LDK, int LDV, int LDO, int SDEPTH>
__device__ __forceinline__ void attn_dense_body(const bf16_t* __restrict__ Qb, const bf16_t* __restrict__ Kh, const bf16_t* __restrict__ Vh,
                                                bf16_t* __restrict__ Ob, int seq, char* lds) {
    using C = Cfg<DK>;
    constexpr int SHM_V = C::SHM_V, SHM_K = C::SHM_K, NKC = C::NKC, ND0 = C::ND0;
    const int tid = opaque_tid(), wid = tid >> 6, lane = tid & 63, r32 = lane & 31, hi = lane >> 5;
    char* V_lds = lds; char* K_lds = lds + 2 * SHM_V;
    float* ws = (float*)(lds + 2 * SHM_V + 2 * SHM_K) + wid * 64; float* li_l = ws; float* al_l = ws + 32;
    float m_reg = -1e30f, l_reg = 0; f32x16 o[4] = {}; bf16x8 qr[ND0];
    const bf16_t* Qw = Qb + (long)(wid * QBLK + r32) * LDQ + hi * 8;
#pragma unroll
    for (int d0 = 0; d0 < ND0; ++d0) qr[d0] = *reinterpret_cast<const bf16x8*>(Qw + d0 * 16);
    const int sr = tid >> 4, sc = (tid & 15) * 8, vst0 = v_st(sr, sc), vst1 = v_st(32 + sr, sc);
    int kgo[NKC], klo[NKC];
#pragma unroll
    for (int c = 0; c < NKC; ++c) { const int id = tid + 512 * c, kr = id / (DK / 8), kc = id % (DK / 8); kgo[c] = kr * LDK + kc * 8; klo[c] = kswz<DK>(kr, kc * 16); }
    const int vb0 = (int)(uintptr_t)V_lds + v_rd_base(lane);
    struct { bf16x8 vs0, vs1, ks[NKC]; } sr_[SDEPTH];
#define SLOAD(i, k0) do { sr_[i].vs0 = *reinterpret_cast<const bf16x8*>(&Vh[(long)((k0) + sr) * LDV + sc]); sr_[i].vs1 = *reinterpret_cast<const bf16x8*>(&Vh[(long)((k0) + 32 + sr) * LDV + sc]); \
    _Pragma("unroll") for (int c_ = 0; c_ < NKC; ++c_) sr_[i].ks[c_] = *reinterpret_cast<const bf16x8*>(&Kh[(long)(k0) * LDK + kgo[c_]]); } while (0)
#define SWRITE(b, i) do { *(bf16x8*)(V_lds + (b) * SHM_V + vst0) = sr_[i].vs0; *(bf16x8*)(V_lds + (b) * SHM_V + vst1) = sr_[i].vs1; \
    _Pragma("unroll") for (int c_ = 0; c_ < NKC; ++c_) *(bf16x8*)(K_lds + (b) * SHM_K + klo[c_]) = sr_[i].ks[c_]; } while (0)
#define SWAIT() do { if constexpr (SDEPTH == 2) { if constexpr (NKC == 2) asm volatile("s_waitcnt vmcnt(4)" ::: "memory"); else asm volatile("s_waitcnt vmcnt(5)" ::: "memory"); } \
    else asm volatile("s_waitcnt vmcnt(0)" ::: "memory"); } while (0)
#define RESC(a) do { if (__any((a) < 1.f)) { if (hi == 0) al_l[r32] = (a); asm volatile("s_waitcnt lgkmcnt(0)" ::: "memory"); \
    _Pragma("unroll") for (int d = 0; d < 4; ++d) _Pragma("unroll") for (int r = 0; r < 16; ++r) o[d][r] *= al_l[crow(r, hi)]; } } while (0)
    f32x16 pA0, pA1, pB0, pB1; float mnA, mnB, alA, alB; bf16x8 pa0, pa1, pa2, pa3; const int NT = seq / KVBLK;
    constexpr int SE = 0, SO = SDEPTH - 1;
    SLOAD(SE, 0); asm volatile("s_waitcnt vmcnt(0)" ::: "memory"); SWRITE(0, SE); __syncthreads();
    qkt<DK>(pA0, pA1, K_lds, qr, r32, hi); partialSM<DK>(pA0, pA1, m_reg, mnA, alA);
    SLOAD(SO, KVBLK); if constexpr (SDEPTH == 2) { if (2 < NT) SLOAD(SE, 2 * KVBLK); }
    SWAIT(); SWRITE(1, SO); __syncthreads();
    for (int j = 1; j + 1 < NT; j += 2) {
        SBAR(); qkt<DK>(pB0, pB1, K_lds + SHM_K, qr, r32, hi);
        finishSM(pA0, pA1, alA, l_reg, pa0, pa1, pa2, pa3); SBAR();
        SLOAD(SO, (j + SDEPTH) * KVBLK); SBAR();
        pv_d0(o, vb0, pa0, pa1, pa2, pa3); partialSM<DK>(pB0, pB1, m_reg, mnB, alB);
        __syncthreads(); SWAIT(); SWRITE(0, SE);
        RESC(alB); __syncthreads();
        SBAR(); qkt<DK>(pA0, pA1, K_lds, qr, r32, hi);
        finishSM(pB0, pB1, alB, l_reg, pa0, pa1, pa2, pa3); SBAR();
        if (SDEPTH == 1 || j + 3 < NT) SLOAD(SE, (j + 1 + SDEPTH) * KVBLK); SBAR();
        pv_d0(o, vb0 + (int)SHM_V, pa0, pa1, pa2, pa3); partialSM<DK>(pA0, pA1, m_reg, mnA, alA);
        __syncthreads(); SWAIT(); SWRITE(1, SO);
        RESC(alA); __syncthreads();
    }
    SBAR(); qkt<DK>(pB0, pB1, K_lds + SHM_K, qr, r32, hi);
    finishSM(pA0, pA1, alA, l_reg, pa0, pa1, pa2, pa3); SBAR();
    pv_d0(o, vb0, pa0, pa1, pa2, pa3); partialSM<DK>(pB0, pB1, m_reg, mnB, alB);
    __syncthreads(); RESC(alB);
    finishSM(pB0, pB1, alB, l_reg, pa0, pa1, pa2, pa3); SBAR();
    pv_d0(o, vb0 + (int)SHM_V, pa0, pa1, pa2, pa3);
    if (hi == 0) li_l[r32] = l_reg; asm volatile("s_waitcnt lgkmcnt(0)" ::: "memory");
    float rli[16];
#pragma unroll
    for (int r = 0; r < 16; ++r) rli[r] = __builtin_amdgcn_rcpf(li_l[crow(r, hi)]);
    bf16_t* Ow = Ob + (long)(wid * QBLK) * LDO;
#pragma unroll
    for (int r = 0; r < 16; ++r) { int orow = crow(r, hi);
#pragma unroll
        for (int d0 = 0; d0 < 4; ++d0) Ow[(long)orow * LDO + d0 * 32 + r32] = f2bf(o[d0][r] * rli[r]); }
#undef SLOAD
#undef SWRITE
#undef SWAIT
#undef RESC
}

template <int DK, int LDQ, int LDK, int LDV, int LDO>
__device__ __forceinline__ void attn_simple_body(const bf16_t* __restrict__ Qb, const bf16_t* __restrict__ Kh, const bf16_t* __restrict__ Vh,
                                                 bf16_t* __restrict__ Ob, int seq, char* lds) {
    using C = Cfg<DK>;
    constexpr int SHM_V = C::SHM_V, SHM_K = C::SHM_K, NKC = C::NKC, ND0 = C::ND0;
    const int tid = opaque_tid(), wid = tid >> 6, lane = tid & 63, r32 = lane & 31, hi = lane >> 5;
    char* V_lds = lds; char* K_lds = lds + 2 * SHM_V;
    float* ws = (float*)(lds + 2 * SHM_V + 2 * SHM_K) + wid * 64; float* li_l = ws; float* al_l = ws + 32;
    float m_reg = -1e30f, l_reg = 0; f32x16 o[4] = {}; bf16x8 qr[ND0];
    const bf16_t* Qw = Qb + (long)(wid * QBLK + r32) * LDQ + hi * 8;
#pragma unroll
    for (int d0 = 0; d0 < ND0; ++d0) qr[d0] = *reinterpret_cast<const bf16x8*>(Qw + d0 * 16);
    const int sr = tid >> 4, sc = (tid & 15) * 8, vst0 = v_st(sr, sc), vst1 = v_st(32 + sr, sc);
    const int vb0 = (int)(uintptr_t)V_lds + v_rd_base(lane);
    bf16x8 vs0, vs1, ks[NKC];
#define SLOAD1(k0) do { vs0 = *reinterpret_cast<const bf16x8*>(&Vh[(long)((k0) + sr) * LDV + sc]); vs1 = *reinterpret_cast<const bf16x8*>(&Vh[(long)((k0) + 32 + sr) * LDV + sc]); \
    _Pragma("unroll") for (int c_ = 0; c_ < NKC; ++c_) { const int id_ = tid + 512 * c_, kr_ = id_ / (DK / 8), kc_ = id_ % (DK / 8); ks[c_] = *reinterpret_cast<const bf16x8*>(&Kh[(long)((k0) + kr_) * LDK + kc_ * 8]); } } while (0)
#define SWRITE1(b) do { *(bf16x8*)(V_lds + (b) * SHM_V + vst0) = vs0; *(bf16x8*)(V_lds + (b) * SHM_V + vst1) = vs1; \
    _Pragma("unroll") for (int c_ = 0; c_ < NKC; ++c_) { const int id_ = tid + 512 * c_, kr_ = id_ / (DK / 8), kc_ = id_ % (DK / 8); *(bf16x8*)(K_lds + (b) * SHM_K + kswz<DK>(kr_, kc_ * 16)) = ks[c_]; } } while (0)
    f32x16 pA0, pA1; float mnA, alA; bf16x8 pa0, pa1, pa2, pa3; const int NT = seq / KVBLK;
    SLOAD1(0); asm volatile("s_waitcnt vmcnt(0)" ::: "memory"); SWRITE1(0); __syncthreads();
    for (int j = 0; j < NT; ++j) {
        const int cb = j & 1;
        if (j + 1 < NT) SLOAD1((j + 1) * KVBLK);
        SBAR(); qkt<DK>(pA0, pA1, K_lds + cb * SHM_K, qr, r32, hi);
        partialSM<DK>(pA0, pA1, m_reg, mnA, alA);
        if (__any(alA < 1.f)) { if (hi == 0) al_l[r32] = alA; asm volatile("s_waitcnt lgkmcnt(0)" ::: "memory");
#pragma unroll
            for (int d = 0; d < 4; ++d)
#pragma unroll
                for (int r = 0; r < 16; ++r) o[d][r] *= al_l[crow(r, hi)]; }
        finishSM(pA0, pA1, alA, l_reg, pa0, pa1, pa2, pa3); SBAR();
        pv_d0(o, vb0 + cb * SHM_V, pa0, pa1, pa2, pa3);
        if (j + 1 < NT) { SWRITE1(cb ^ 1); }
        __syncthreads();
    }
    if (hi == 0) li_l[r32] = l_reg; asm volatile("s_waitcnt lgkmcnt(0)" ::: "memory");
    float rli[16];
#pragma unroll
    for (int r = 0; r < 16; ++r) rli[r] = __builtin_amdgcn_rcpf(li_l[crow(r, hi)]);
    bf16_t* Ow = Ob + (long)(wid * QBLK) * LDO;
#pragma unroll
    for (int r = 0; r < 16; ++r) { int orow = crow(r, hi);
#pragma unroll
        for (int d0 = 0; d0 < 4; ++d0) Ow[(long)orow * LDO + d0 * 32 + r32] = f2bf(o[d0][r] * rli[r]); }
#undef SLOAD1
#undef SWRITE1
}
}

__device__ __forceinline__ void transpose_item(const float* W, int K, int N, int NPAD, bf16_t* WT, int mode, LAS float* scr, int item, int) {
    const int lane = opaque_tid() & 63;
    const int nblk = NPAD / 32, kb = item / nblk, nb = item % nblk, k0 = 64 * kb, n0 = 32 * nb;
    const int ncol = n0 + (lane & 31); const bool okc = ncol < N;
    float v[32];
#pragma unroll
    for (int i = 0; i < 32; ++i) { const int kk = 2 * i + (lane >> 5); v[i] = okc ? W[(size_t)(k0 + kk) * N + ncol] : 0.f; }
#pragma unroll
    for (int i = 0; i < 32; ++i) { const int kk = 2 * i + (lane >> 5); scr[kk * 33 + (lane & 31)] = v[i]; }
    LDS_WAIT(); asm volatile("" ::: "memory");
    const int c = lane & 7;
#pragma unroll
    for (int j = 0; j < 4; ++j) { const int n = (lane >> 3) + 8 * j; const LAS float* s = scr + (8 * c) * 33 + n;
        u32x4 o; o.x = cvt_pk_bf16(s[0 * 33], s[1 * 33]); o.y = cvt_pk_bf16(s[2 * 33], s[3 * 33]); o.z = cvt_pk_bf16(s[4 * 33], s[5 * 33]); o.w = cvt_pk_bf16(s[6 * 33], s[7 * 33]);
        int nn = n0 + n, drow = nn;
        if (mode == 1) { drow = (nn < FF) ? ((nn >> 7) * 256 + (nn & 127)) : (((nn - FF) >> 7) * 256 + 128 + ((nn - FF) & 127)); }
        *(u32x4*)(WT + (size_t)drow * K + k0 + 8 * c) = o; }
    LDS_WAIT(); asm volatile("" ::: "memory");
}

__device__ __forceinline__ void mod_item(const Params& p, int item, LAS float* ldsf, int) {
    const int tid = opaque_tid();
    const int l = item / 192, col0 = (item % 192) * 64, wave = tid >> 6, lane = tid & 63;
    const float* cin = p.in[1]; const float* wada = p.in[2] + (size_t)l * D * MODW; const float* bada = p.in[3] + (size_t)l * MODW;
    float* mod = (float*)(p.ws + WS_MOD) + (size_t)l * NB * MODW;
    __syncthreads();
    for (int i0 = 0; i0 < 64; i0 += 16) {
        float cv[16];
#pragma unroll
        for (int u = 0; u < 16; ++u) cv[u] = cin[tid + 512 * (i0 + u)];
#pragma unroll
        for (int u = 0; u < 16; ++u) { const int idx = tid + 512 * (i0 + u), b = idx >> 11, k = idx & 2047; ldsf[k * 16 + b] = silu_f(cv[u]); }
    }
    __syncthreads();
    float acc[16];
#pragma unroll
    for (int b = 0; b < 16; ++b) acc[b] = 0.f;
    const float* wp = wada + (size_t)(wave * 256) * MODW + col0 + lane;
    for (int k0 = 0; k0 < 256; k0 += 16) {
        float wv[16];
#pragma unroll
        for (int u = 0; u < 16; ++u) wv[u] = __builtin_nontemporal_load(wp + (size_t)(k0 + u) * MODW);
#pragma unroll
        for (int u = 0; u < 16; ++u) {
            const LAS f32x4* sp = (const LAS f32x4*)(ldsf + (wave * 256 + k0 + u) * 16);
#pragma unroll
            for (int q = 0; q < 4; ++q) { const f32x4 s4 = sp[q];
#pragma unroll
                for (int j = 0; j < 4; ++j) acc[q * 4 + j] = fmaf(s4[j], wv[u], acc[q * 4 + j]); }
        }
    }
    __syncthreads();
#pragma unroll
    for (int b = 0; b < 16; ++b) ldsf[(wave * 16 + b) * 64 + lane] = acc[b];
    __syncthreads();
#pragma unroll
    for (int q = 0; q < 2; ++q) { const int o = tid + 512 * q, b = o >> 6, cl = o & 63; float s = 0.f;
#pragma unroll
        for (int w = 0; w < 8; ++w) s += ldsf[(w * 16 + b) * 64 + cl];
        mod[(size_t)b * MODW + col0 + cl] = s + bada[col0 + cl]; }
    __syncthreads();
}

__device__ __forceinline__ void norm_mod_phase(const float* __restrict__ x, const float* __restrict__ g, const float* __restrict__ modl, int shift_off, int scale_off, bf16_t* __restrict__ outp, int gw, int NGW, int) {
    constexpr int NR = 4;
    const int lane = opaque_tid() & 63; gw = opaque_s(gw);
    for (int rowa = gw; rowa < T; rowa += NR * NGW) {
        int rows[NR]; bool has[NR];
#pragma unroll
        for (int u = 0; u < NR; ++u) { has[u] = rowa + u * NGW < T; rows[u] = has[u] ? rowa + u * NGW : rowa; }
        f32x4 v[NR][8]; float ss[NR];
#pragma unroll
        for (int u = 0; u < NR; ++u) { const f32x4* xr = (const f32x4*)(x + (size_t)rows[u] * D) + lane;
#pragma unroll
            for (int j = 0; j < 8; ++j) v[u][j] = xr[64 * j]; }
#pragma unroll
        for (int u = 0; u < NR; ++u) { float q = 0.f;
#pragma unroll
            for (int j = 0; j < 8; ++j) q += (v[u][j][0] * v[u][j][0] + v[u][j][1] * v[u][j][1]) + (v[u][j][2] * v[u][j][2] + v[u][j][3] * v[u][j][3]);
            ss[u] = q; }
#define WS_STEP(O) { _Pragma("unroll") for (int u = 0; u < NR; ++u) ss[u] += shx<O>(ss[u]); }
        XOR_STEPS(WS_STEP)
#undef WS_STEP
#pragma unroll
        for (int u = 0; u < NR; ++u) ss[u] = xsum32(ss[u]);
        float rstd[NR];
#pragma unroll
        for (int u = 0; u < NR; ++u) rstd[u] = rsqrtf(ss[u] * (1.f / D) + EPS);
#pragma unroll
        for (int j = 0; j < 8; ++j) { const int c = (lane + 64 * j) * 4;
            const f32x4 g4 = *(const f32x4*)(g + c);
            f32x4 sc4[NR], sh4[NR];
#pragma unroll
            for (int u = 0; u < NR; ++u) { const float* mb = modl + (size_t)(rows[u] >> 11) * MODW; sc4[u] = *(const f32x4*)(mb + scale_off + c); sh4[u] = *(const f32x4*)(mb + shift_off + c); }
#pragma unroll
            for (int u = 0; u < NR; ++u) { if (!has[u]) continue;
                const f32x4 y = (v[u][j] * rstd[u]) * g4 * (sc4[u] + 1.f) + sh4[u];
                u32x2 w; w.x = cvt_pk_bf16(y[0], y[1]); w.y = cvt_pk_bf16(y[2], y[3]);
                *(u32x2*)(outp + (size_t)rows[u] * D + c) = w; } }
    }
}

__device__ __forceinline__ void prep_phase(const Params& p, int layer, int gw, int NGW, int) {
    const int lane = opaque_tid() & 63; gw = opaque_s(gw);
    bf16_t* proj = (bf16_t*)(p.ws + WS_PROJ);
    bf16_t* KB = (bf16_t*)(p.ws + WS_KB); bf16_t* XBC = (bf16_t*)(p.ws + WS_XBC); float* DT = (float*)(p.ws + WS_DT);
    const float* tab = (const float*)(p.ws + WS_TAB);
    const float* tAc = tab, *tAs = tab + 2048, *tBc = tab + 4096, *tBs = tab + 4096 + 1024;
    const float* qg = p.in[7] + layer * 128; const float* kg = p.in[8] + layer * 128;
    const float* cqg = p.in[9] + layer * 512; const float* ckvg = p.in[11] + layer * 256;
    const float* convw = p.in[13] + (size_t)layer * 5 * 1280; const float* convb = p.in[14] + layer * 1280;
    const float* dtbias = p.in[15] + layer * 24;
    for (int row = gw; row < T; row += NGW) {
        const int s = row & (S - 1), ri = s >> 6, ci = s & 63;
        bf16_t* pr = proj + (size_t)row * INP;
        const int e = lane + (lane & 32), axis = lane >> 5, fi = lane & 31, idx = axis ? ci : ri;
        float x1[8], x2[8], red[10];
#pragma unroll
        for (int hh = 0; hh < 8; ++hh) { x1[hh] = bf2f(pr[128 * hh + e]); x2[hh] = bf2f(pr[128 * hh + e + 32]); }
        bf16_t* cqb = pr + C_CQ + lane * 8; bf16_t* ckb = pr + C_CKV + lane * 4;
        const bf16x8 vq = *(const bf16x8*)cqb; const s16x4 vk4 = *(const s16x4*)ckb;
        const int paxis = (lane >> 4) & 1, pfi = lane & 15, pe = pfi + 32 * paxis, pidx = paxis ? ci : ri;
        const float kx1 = bf2f(pr[C_KPE + pe]), kx2 = bf2f(pr[C_KPE + pe + 16]);
        const float dtraw = bf2f(pr[C_DT + (lane < 24 ? lane : 0)]);
        float vk[5]; int rk[5];
#pragma unroll
        for (int k = 0; k < 5; ++k) { const int s2 = s + k - 2; const bool ok = (s2 >= 0) && (s2 < S); vk[k] = ok ? 1.f : 0.f; rk[k] = ok ? (row + k - 2) : row; }
        s16x4 xv[5][5];
#pragma unroll
        for (int j = 0; j < 5; ++j)
#pragma unroll
            for (int k = 0; k < 5; ++k) xv[j][k] = *(const s16x4*)(proj + (size_t)rk[k] * INP + C_XBC + (j * 64 + lane) * 4);
        const float cs = tAc[idx * 32 + fi], sn = tAs[idx * 32 + fi];
        float fq8[8], fk4[4];
#pragma unroll
        for (int hh = 0; hh < 8; ++hh) red[hh] = x1[hh] * x1[hh] + x2[hh] * x2[hh];
        red[8] = 0.f; red[9] = 0.f;
#pragma unroll
        for (int q = 0; q < 8; ++q) { fq8[q] = bfs2f(vq[q]); red[8] += fq8[q] * fq8[q]; }
#pragma unroll
        for (int q = 0; q < 4; ++q) { fk4[q] = bfs2f(vk4[q]); red[9] += fk4[q] * fk4[q]; }
#define WS_STEP(O) { _Pragma("unroll") for (int q = 0; q < 10; ++q) red[q] += shx<O>(red[q]); }
        XOR_STEPS(WS_STEP)
#undef WS_STEP
#pragma unroll
        for (int q = 0; q < 10; ++q) red[q] = xsum32(red[q]);
        bf16_t qo1[8], qo2[8];
#pragma unroll
        for (int hh = 0; hh < 8; ++hh) {
            const float r = rsqrtf(red[hh] * (1.f / 128.f) + EPS);
            const float* gg = hh < 6 ? qg : kg;
            const float a1 = x1[hh] * r * gg[e], a2 = x2[hh] * r * gg[e + 32];
            qo1[hh] = f2bf(a1 * cs - a2 * sn); qo2[hh] = f2bf(a1 * sn + a2 * cs);
        }
        u32x4 wq; u32x2 wk;
        { const float r = rsqrtf(red[8] * (1.f / 512.f) + EPS);
          const f32x4 g0 = *(const f32x4*)(cqg + lane * 8), g1 = *(const f32x4*)(cqg + lane * 8 + 4);
          wq.x = cvt_pk_bf16(fq8[0] * r * g0[0], fq8[1] * r * g0[1]); wq.y = cvt_pk_bf16(fq8[2] * r * g0[2], fq8[3] * r * g0[3]);
          wq.z = cvt_pk_bf16(fq8[4] * r * g1[0], fq8[5] * r * g1[1]); wq.w = cvt_pk_bf16(fq8[6] * r * g1[2], fq8[7] * r * g1[3]); }
        { const float r = rsqrtf(red[9] * (1.f / 256.f) + EPS);
          const f32x4 g0 = *(const f32x4*)(ckvg + lane * 4);
          wk.x = cvt_pk_bf16(fk4[0] * r * g0[0], fk4[1] * r * g0[1]); wk.y = cvt_pk_bf16(fk4[2] * r * g0[2], fk4[3] * r * g0[3]); }
        const float pcs = tBc[pidx * 16 + pfi], psn = tBs[pidx * 16 + pfi];
        const bf16_t ko1 = f2bf(kx1 * pcs - kx2 * psn), ko2 = f2bf(kx1 * psn + kx2 * pcs);
        u32x2 co[5];
#pragma unroll
        for (int j = 0; j < 5; ++j) {
            const int c = (j * 64 + lane) * 4;
            f32x4 a = *(const f32x4*)(convb + c);
#pragma unroll
            for (int k = 0; k < 5; ++k) {
                const f32x4 w = *(const f32x4*)(convw + k * 1280 + c) * vk[k];
#pragma unroll
                for (int q = 0; q < 4; ++q) a[q] = fmaf(w[q], bfs2f(xv[j][k][q]), a[q]);
            }
            co[j].x = cvt_pk_bf16(silu_f(a[0]), silu_f(a[1])); co[j].y = cvt_pk_bf16(silu_f(a[2]), silu_f(a[3]));
        }
        const float dtv = dtraw + dtbias[lane < 24 ? lane : 0];
        const float dto = dtv > 20.f ? dtv : log1pf(expf(dtv));
#pragma unroll
        for (int hh = 0; hh < 8; ++hh) { pr[128 * hh + e] = qo1[hh]; pr[128 * hh + e + 32] = qo2[hh]; }
        *(u32x4*)cqb = wq; *(u32x2*)ckb = wk;
        if (lane < 32) { bf16_t* kb = KB + (size_t)row * 768 + 128 + pe;
#pragma unroll
            for (int hd = 0; hd < 4; ++hd) { kb[hd * 192] = ko1; kb[hd * 192 + 16] = ko2; } }
#pragma unroll
        for (int j = 0; j < 5; ++j) *(u32x2*)(XBC + (size_t)row * 1280 + (j * 64 + lane) * 4) = co[j];
        if (lane < 24) DT[(size_t)row * 24 + lane] = dto;
    }
}

__device__ __forceinline__ void ssd_item(const bf16_t* XBC, const float* DT, float* Y, float a_neg, int b, int dir, int h, LAS unsigned char* lds, int) {
    const int tid = opaque_tid();
    LAS float* Bs = (LAS float*)lds;
    LAS float* Cs = Bs + 4096;
    LAS float* Xs = Cs + 4096;
    LAS float* Ys = Xs + 2048;
    LAS float* dAs = Ys + 2048;
    LAS float* dts = dAs + 32;
    const int g = h / 6, pp = tid >> 3, nq = tid & 7, srow = tid >> 4, sc = tid & 15;
    const size_t rowbase = (size_t)b * S;
    float hst[16];
#pragma unroll
    for (int j = 0; j < 16; ++j) hst[j] = 0.f;
    bf16x8 rB, rC; s16x4 rX; float rdt = 0.f;
#define SSD_LOAD(blk) do { const int i_ = (blk) * 32 + srow, t_ = dir ? (S - 1 - i_) : i_; const bf16_t* rp_ = XBC + (rowbase + t_) * 1280; \
        rB = *(const bf16x8*)(rp_ + 768 + g * 128 + sc * 8); rC = *(const bf16x8*)(rp_ + 1024 + g * 128 + sc * 8); rX = *(const s16x4*)(rp_ + h * 64 + sc * 4); \
        if (tid < 32) { const int i2_ = (blk) * 32 + tid, t2_ = dir ? (S - 1 - i2_) : i2_; rdt = DT[(rowbase + t2_) * 24 + dir * 12 + h]; } } while (0)
#define SSD_STORE() do { f32x4 b0_, b1_, c0_, c1_, x_; \
        _Pragma("unroll") for (int k_ = 0; k_ < 4; ++k_) { b0_[k_] = bfs2f(rB[k_]); b1_[k_] = bfs2f(rB[4 + k_]); c0_[k_] = bfs2f(rC[k_]); c1_[k_] = bfs2f(rC[4 + k_]); x_[k_] = bfs2f(rX[k_]); } \
        *(LAS f32x4*)(Bs + srow * 128 + sc * 8) = b0_; *(LAS f32x4*)(Bs + srow * 128 + sc * 8 + 4) = b1_; \
        *(LAS f32x4*)(Cs + srow * 128 + sc * 8) = c0_; *(LAS f32x4*)(Cs + srow * 128 + sc * 8 + 4) = c1_; \
        *(LAS f32x4*)(Xs + srow * 64 + sc * 4) = x_; \
        if (tid < 32) { dts[tid] = rdt; dAs[tid] = expf(rdt * a_neg); } } while (0)
    SSD_LOAD(0); SSD_STORE(); __syncthreads();
    for (int blk = 0; blk < S / 32; ++blk) {
        if (blk + 1 < S / 32) SSD_LOAD(blk + 1);
        for (int i = 0; i < 32; ++i) {
            const float dAt = dAs[i], xdt = Xs[i * 64 + pp] * dts[i];
            float acc = 0.f;
#pragma unroll
            for (int j = 0; j < 4; ++j) {
                const f32x4 bv = *(const LAS f32x4*)(Bs + i * 128 + 32 * j + 4 * nq), cv = *(const LAS f32x4*)(Cs + i * 128 + 32 * j + 4 * nq);
#pragma unroll
                for (int k = 0; k < 4; ++k) { hst[4 * j + k] = fmaf(hst[4 * j + k], dAt, xdt * bv[k]); acc = fmaf(cv[k], hst[4 * j + k], acc); }
            }
            acc += __shfl_xor(acc, 1); acc += __shfl_xor(acc, 2); acc += __shfl_xor(acc, 4);
            if (nq == 0) Ys[i * 64 + pp] = acc;
        }
        __syncthreads();
        { const int i_ = blk * 32 + srow, t_ = dir ? (S - 1 - i_) : i_;
          *(f32x4*)(Y + (rowbase + t_) * 768 + h * 64 + sc * 4) = *(const LAS f32x4*)(Ys + srow * 64 + sc * 4); }
        if (blk + 1 < S / 32) SSD_STORE();
        __syncthreads();
    }
#undef SSD_LOAD
#undef SSD_STORE
}


namespace ssdm {
using namespace att;
__device__ __forceinline__ int v_st_e(int k, int c) { const int kk = (k & ~0xC) | ((k & 4) << 1) | ((k & 8) >> 1); return ((kk >> 3) * 4 + (c >> 5)) * 512 + ((kk & 7) * 32 + (c & 31)) * 2; }
__device__ __forceinline__ void upd_one(f32x16& acc, int vbA, int vbB) {
    const s16x4 al0 = tr_read<v_rd_off(0, 0, 0)>(vbA), ah0 = tr_read<v_rd_off(0, 0, 1)>(vbA), al1 = tr_read<v_rd_off(0, 1, 0)>(vbA), ah1 = tr_read<v_rd_off(0, 1, 1)>(vbA);
    const s16x4 al2 = tr_read<v_rd_off(0, 2, 0)>(vbA), ah2 = tr_read<v_rd_off(0, 2, 1)>(vbA), al3 = tr_read<v_rd_off(0, 3, 0)>(vbA), ah3 = tr_read<v_rd_off(0, 3, 1)>(vbA);
    const s16x4 bl0 = tr_read<v_rd_off(0, 0, 0)>(vbB), bh0 = tr_read<v_rd_off(0, 0, 1)>(vbB), bl1 = tr_read<v_rd_off(0, 1, 0)>(vbB), bh1 = tr_read<v_rd_off(0, 1, 1)>(vbB);
    const s16x4 bl2 = tr_read<v_rd_off(0, 2, 0)>(vbB), bh2 = tr_read<v_rd_off(0, 2, 1)>(vbB), bl3 = tr_read<v_rd_off(0, 3, 0)>(vbB), bh3 = tr_read<v_rd_off(0, 3, 1)>(vbB);
    asm volatile("s_waitcnt lgkmcnt(0)" ::: "memory"); SBAR();
#define PK(L, H) (bf16x8){L[0], L[1], L[2], L[3], H[0], H[1], H[2], H[3]}
    acc = __builtin_amdgcn_mfma_f32_32x32x16_bf16(PK(al0, ah0), PK(bl0, bh0), acc, 0, 0, 0);
    acc = __builtin_amdgcn_mfma_f32_32x32x16_bf16(PK(al1, ah1), PK(bl1, bh1), acc, 0, 0, 0);
    acc = __builtin_amdgcn_mfma_f32_32x32x16_bf16(PK(al2, ah2), PK(bl2, bh2), acc, 0, 0, 0);
    acc = __builtin_amdgcn_mfma_f32_32x32x16_bf16(PK(al3, ah3), PK(bl3, bh3), acc, 0, 0, 0);
#undef PK
}
__device__ __forceinline__ void ssd_item(const bf16_t* XBC, const float* DT, float* Y, float a_neg, int b, int dir, int h, char* shm) {
    const int tid = opaque_tid(), wid = tid >> 6, lane = tid & 63, r32 = lane & 31, hi = lane >> 5;
    const int rb = wid & 3, ph = wid >> 2, g = h / 6;
    char* Kimg = shm; char* BV = shm + 32768; char* XI = shm + 65536; char* SI = shm + 98304;
    float* acs_l = (float*)(shm + MISC_OFF + 256); float* dts_l = acs_l + 128;
    const int vbB = (int)(uintptr_t)BV + v_rd_base(lane), vbX = (int)(uintptr_t)XI + v_rd_base(lane), vbS = (int)(uintptr_t)SI + v_rd_base(lane);
    const size_t rowbase = (size_t)b * S;
#define TOK(i) (dir ? (S - 1 - (i)) : (i))
#pragma unroll
    for (int i = 0; i < 4; ++i) *(u32x4*)(SI + (tid + 512 * i) * 16) = (u32x4){0u, 0u, 0u, 0u};
    f32x16 Sacc = {};
    bf16x8 rB[4], rX[2]; float rdt = 0.f;
    const int srow = tid >> 2, scq = tid & 3;
#define SSDM_LOAD(c) do { \
        _Pragma("unroll") for (int i_ = 0; i_ < 4; ++i_) { const int id_ = tid + 512 * i_, row_ = id_ >> 4, c8_ = id_ & 15; \
            rB[i_] = *(const bf16x8*)(XBC + (rowbase + TOK((c) * 128 + row_)) * 1280 + 768 + g * 128 + c8_ * 8); } \
        { const bf16_t* xp_ = XBC + (rowbase + TOK((c) * 128 + srow)) * 1280 + h * 64 + scq * 16; rX[0] = *(const bf16x8*)xp_; rX[1] = *(const bf16x8*)(xp_ + 8); } \
        if (tid < 128) rdt = DT[(rowbase + TOK((c) * 128 + tid)) * 24 + dir * 12 + h]; } while (0)
    SSDM_LOAD(0);
    for (int c = 0; c < S / 128; ++c) {
        bf16x8 qr[8];
        { const bf16_t* cp = XBC + (rowbase + TOK(c * 128 + 32 * rb + r32)) * 1280 + 1024 + g * 128 + hi * 8;
#pragma unroll
          for (int d0 = 0; d0 < 8; ++d0) qr[d0] = *(const bf16x8*)(cp + d0 * 16); }
#pragma unroll
        for (int i = 0; i < 4; ++i) { const int id = tid + 512 * i, row = id >> 4, c8 = id & 15, tt = row >> 6, k = row & 63;
            *(bf16x8*)(Kimg + tt * 16384 + kswz<128>(k, c8 * 16)) = rB[i]; *(bf16x8*)(BV + tt * 16384 + v_st(k, c8 * 8)) = rB[i]; }
        if (tid < 128) dts_l[tid] = rdt;
        __syncthreads();
        int ln = lane; asm volatile("" : "+v"(ln));
        float x_lo = dts_l[ln] * a_neg, x_hi = dts_l[64 + ln] * a_neg;
#pragma unroll
        for (int o = 1; o < 64; o <<= 1) { const int ad = (ln - o) << 2;
            const float v0 = __int_as_float(__builtin_amdgcn_ds_bpermute(ad, __float_as_int(x_lo))), v1 = __int_as_float(__builtin_amdgcn_ds_bpermute(ad, __float_as_int(x_hi)));
            if (ln >= o) { x_lo += v0; x_hi += v1; } }
        x_hi += __int_as_float(__builtin_amdgcn_readlane(__float_as_int(x_lo), 63));
        const float acs_last = __int_as_float(__builtin_amdgcn_readlane(__float_as_int(x_hi), 63));
        if (wid == 0) { acs_l[ln] = x_lo; acs_l[64 + ln] = x_hi; }
        { const int sl = ((ln >> 2) + 16 * wid) & 63;
          const float as_lo = __int_as_float(__builtin_amdgcn_ds_bpermute(sl << 2, __float_as_int(x_lo))), as_hi = __int_as_float(__builtin_amdgcn_ds_bpermute(sl << 2, __float_as_int(x_hi)));
          const float acs_s = (srow < 64) ? as_lo : as_hi;
          const float dt_s = dts_l[srow], e_s = dt_s * __expf(acs_last - acs_s);
          const int tt = srow >> 6, k = srow & 63;
#pragma unroll
          for (int hf = 0; hf < 2; ++hf) { float f[8];
#pragma unroll
              for (int j = 0; j < 8; ++j) f[j] = bfs2f(rX[hf][j]);
              u32x4 wd, we;
              wd.x = cvt_pk_bf16(f[0] * dt_s, f[1] * dt_s); wd.y = cvt_pk_bf16(f[2] * dt_s, f[3] * dt_s); wd.z = cvt_pk_bf16(f[4] * dt_s, f[5] * dt_s); wd.w = cvt_pk_bf16(f[6] * dt_s, f[7] * dt_s);
              we.x = cvt_pk_bf16(f[0] * e_s, f[1] * e_s); we.y = cvt_pk_bf16(f[2] * e_s, f[3] * e_s); we.z = cvt_pk_bf16(f[4] * e_s, f[5] * e_s); we.w = cvt_pk_bf16(f[6] * e_s, f[7] * e_s);
              const int cc = scq * 16 + hf * 8;
              *(u32x4*)(XI + tt * 16384 + v_st(k, cc)) = wd; *(u32x4*)(XI + tt * 16384 + v_st(k, cc + 64)) = we; } }
        if (c + 1 < S / 128) SSDM_LOAD(c + 1);
        __syncthreads();
        f32x16 o_off = {}, o_diag = {};
        pv_one<0>(o_off, vbS + ph * 512, qr[0], qr[1], qr[2], qr[3]);
        pv_one<0>(o_off, vbS + ph * 512 + 16384, qr[4], qr[5], qr[6], qr[7]);
        const float acs_row = acs_l[32 * rb + r32];
        for (int jt = 0; jt <= (rb >> 1); ++jt) {
            f32x16 p0, p1;
            qkt<128>(p0, p1, Kimg + jt * 16384, qr, r32, hi);
            const int lrow = 32 * rb + r32;
#pragma unroll
            for (int r = 0; r < 16; ++r) {
                const int s0 = 64 * jt + crow(r, hi), s1 = s0 + 32;
                const float m0 = __expf(acs_row - acs_l[s0]), m1 = __expf(acs_row - acs_l[s1]);
                p0[r] = (s0 <= lrow) ? p0[r] * m0 : 0.f; p1[r] = (s1 <= lrow) ? p1[r] * m1 : 0.f;
            }
            bf16x8 pa0, pa1, pa2, pa3;
#define PK4(P, BASE, OUT) do { unsigned a0 = cvtpk(P[BASE + 0], P[BASE + 1]), a1 = cvtpk(P[BASE + 2], P[BASE + 3]);   \
    unsigned b0 = cvtpk(P[BASE + 4], P[BASE + 5]), b1 = cvtpk(P[BASE + 6], P[BASE + 7]);                              \
    auto r0 = __builtin_amdgcn_permlane32_swap(a0, b0, false, false); auto r1 = __builtin_amdgcn_permlane32_swap(a1, b1, false, false); \
    u32x4 w = {r0[0], r1[0], r0[1], r1[1]}; OUT = *reinterpret_cast<bf16x8*>(&w); } while (0)
            PK4(p0, 0, pa0); PK4(p0, 8, pa1); PK4(p1, 0, pa2); PK4(p1, 8, pa3);
#undef PK4
            pv_one<0>(o_diag, vbX + ph * 512 + jt * 16384, pa0, pa1, pa2, pa3);
        }
        float ea[16];
#pragma unroll
        for (int r = 0; r < 16; ++r) ea[r] = __expf(acs_l[32 * rb + crow(r, hi)]);
#pragma unroll
        for (int r = 0; r < 16; ++r) { const int row = 32 * rb + crow(r, hi);
            Y[(rowbase + TOK(c * 128 + row)) * 768 + h * 64 + 32 * ph + r32] = o_diag[r] + o_off[r] * ea[r]; }
        { const float eA = __expf(acs_last);
#pragma unroll
          for (int r = 0; r < 16; ++r) Sacc[r] *= eA;
          upd_one(Sacc, vbB + rb * 512, vbX + (2 + ph) * 512);
          upd_one(Sacc, vbB + rb * 512 + 16384, vbX + (2 + ph) * 512 + 16384); }
        __syncthreads();
        if (c + 1 < S / 128) {
#pragma unroll
            for (int r = 0; r < 16; ++r) { const int n = 32 * rb + crow(r, hi);
                *(bf16_t*)(SI + (n >> 6) * 16384 + v_st_e(n & 63, 32 * ph + r32)) = f2bf_c(Sacc[r]); }
        }
    }
#undef SSDM_LOAD
#undef TOK
}
}

__device__ __forceinline__ void combine_phase(const Params& p, int layer, int gw, int NGW, int) {
    const int lane = opaque_tid() & 63; gw = opaque_s(gw);
    const bf16_t* proj = (const bf16_t*)(p.ws + WS_PROJ); const bf16_t* XBC = (const bf16_t*)(p.ws + WS_XBC);
    const float* YF = (const float*)(p.ws + WS_YF); const float* YB = (const float*)(p.ws + WS_YB);
    bf16_t* ACT = (bf16_t*)(p.ws + WS_ACT);
    const float* dskip = p.in[17] + layer * 12; const float* ng = p.in[18] + layer * 768;
    for (int rowa = gw; rowa < T; rowa += 2 * NGW) {
        const bool has1 = rowa + NGW < T; const int rows[2] = {rowa, has1 ? rowa + NGW : rowa};
        f32x4 a[2][3], bq[2][3]; s16x4 xv[2][3], zv[2][3];
#pragma unroll
        for (int u = 0; u < 2; ++u)
#pragma unroll
            for (int j = 0; j < 3; ++j) { const int c = j * 256 + lane * 4; const size_t row = (size_t)rows[u];
                a[u][j] = *(const f32x4*)(YF + row * 768 + c); bq[u][j] = *(const f32x4*)(YB + row * 768 + c);
                xv[u][j] = *(const s16x4*)(XBC + row * 1280 + c); zv[u][j] = *(const s16x4*)(proj + row * INP + C_Z + c); }
        f32x4 y[2][3]; float ss[4] = {0.f, 0.f, 0.f, 0.f};
#pragma unroll
        for (int u = 0; u < 2; ++u)
#pragma unroll
            for (int j = 0; j < 3; ++j) { const int c = j * 256 + lane * 4; const float dsk = dskip[c >> 6]; float q = 0.f;
#pragma unroll
                for (int k = 0; k < 4; ++k) { const float v = (a[u][j][k] + bq[u][j][k] + bfs2f(xv[u][j][k]) * dsk) * silu_f(bfs2f(zv[u][j][k])); y[u][j][k] = v; q += v * v; }
                if (c < 384) ss[2 * u] += q; else ss[2 * u + 1] += q; }
#define WS_STEP(O) { _Pragma("unroll") for (int q = 0; q < 4; ++q) ss[q] += shx<O>(ss[q]); }
        XOR_STEPS(WS_STEP)
#undef WS_STEP
#pragma unroll
        for (int q = 0; q < 4; ++q) ss[q] = xsum32(ss[q]);
        f32x4 gn4[3];
#pragma unroll
        for (int j = 0; j < 3; ++j) gn4[j] = *(const f32x4*)(ng + j * 256 + lane * 4);
#pragma unroll
        for (int u = 0; u < 2; ++u) { if (u == 1 && !has1) break;
            const float r0 = rsqrtf(ss[2 * u] * (1.f / 384.f) + EPS), r1 = rsqrtf(ss[2 * u + 1] * (1.f / 384.f) + EPS);
#pragma unroll
            for (int j = 0; j < 3; ++j) { const int c = j * 256 + lane * 4; const float r = c < 384 ? r0 : r1;
                const f32x4 g4 = gn4[j];
                u32x2 w; w.x = cvt_pk_bf16(y[u][j][0] * r * g4[0], y[u][j][1] * r * g4[1]); w.y = cvt_pk_bf16(y[u][j][2] * r * g4[2], y[u][j][3] * r * g4[3]);
                *(u32x2*)(ACT + (size_t)rows[u] * D + 1280 + c) = w; } }
    }
}

__device__ __forceinline__ void gsync(cg::grid_group& grid) {
    asm volatile("s_waitcnt vmcnt(0) lgkmcnt(0)" ::: "memory");
    grid.sync();
    if (__builtin_amdgcn_readfirstlane(threadIdx.x >> 6) == 0) { __builtin_amdgcn_fence(__ATOMIC_ACQUIRE, "agent"); asm volatile("s_waitcnt vmcnt(0)" ::: "memory"); }
    __syncthreads();
}
#define XB_TMO      128
#define XB_XCNT(j)  (256  + 64 * (j))
#define XB_XSUB(j)  (1280 + 64 * (j))
#define XB_XGEN(j)  (2304 + 64 * (j))
#define XB_TOP      3328
#define XB_TOPGEN   3392
#define XCD_BAR_WORDS 3456
#define XB_SPIN_CAP (1u << 18)
__device__ __forceinline__ unsigned xb_ld(unsigned* p)              { return __hip_atomic_load(p, __ATOMIC_RELAXED, __HIP_MEMORY_SCOPE_AGENT); }
__device__ __forceinline__ unsigned xb_add(unsigned* p, unsigned v) { return __hip_atomic_fetch_add(p, v, __ATOMIC_RELAXED, __HIP_MEMORY_SCOPE_AGENT); }
__device__ __forceinline__ unsigned xb_xcc_id() { return (unsigned)__builtin_amdgcn_s_getreg((3 << 11) | 20) & 0xFu; }
#define XB_SPIN(cond, bar) do { unsigned _sp = 0; while (cond) { __builtin_amdgcn_s_sleep(1); \
    if ((++_sp & 255u) == 0u) { if (xb_ld(&(bar)[XB_TMO])) break; if (_sp > XB_SPIN_CAP) { atomicAdd(&(bar)[XB_TMO], 1u); break; } } } } while (0)
struct XcdBarrier { unsigned* bar; unsigned x; volatile LAS unsigned* st; };
__device__ __forceinline__ XcdBarrier xcd_barrier_post(unsigned* bar, volatile LAS unsigned* st) {
    XcdBarrier b; b.bar = bar; b.x = xb_xcc_id(); b.st = st;
    if (opaque_tid() == 0) (void)xb_add(&bar[XB_XCNT(b.x)], 1u);
    return b;
}
__device__ __forceinline__ void xcd_barrier_complete(unsigned* bar, unsigned x, unsigned& nloc, unsigned& nx) {
    const unsigned G = gridDim.x * gridDim.y * gridDim.z;
    unsigned sum, cnt, mine, sp = 0u;
    for (;;) {
        sum = 0u; cnt = 0u; mine = 0u;
#pragma unroll
        for (unsigned j = 0; j < 16; ++j) { const unsigned c = xb_ld(&bar[XB_XCNT(j)]); sum += c; cnt += (c > 0u) ? 1u : 0u; mine = (j == x) ? c : mine; }
        if (sum == G) break;
        __builtin_amdgcn_s_sleep(1);
        if ((++sp & 255u) == 0u) { if (xb_ld(&bar[XB_TMO])) break; if (sp > XB_SPIN_CAP) { atomicAdd(&bar[XB_TMO], 1u); break; } }
    }
    nloc = mine > 0u ? mine : 1u; nx = cnt > 0u ? cnt : 1u;
}
__device__ __forceinline__ void xcd_barrier(const XcdBarrier& b) {
    asm volatile("s_waitcnt vmcnt(0)" ::: "memory");
    __syncthreads();
    if (opaque_tid() == 0) {
        unsigned* bar = b.bar;
        __builtin_amdgcn_s_waitcnt(0);
        unsigned nloc = b.st[0], nx = b.st[1];
        if (nloc == 0u) { xcd_barrier_complete(bar, b.x, nloc, nx); b.st[0] = nloc; b.st[1] = nx; }
        const unsigned old = xb_add(&bar[XB_XSUB(b.x)], 1u);
        const unsigned gen = old / nloc;
        if (old + 1u == (gen + 1u) * nloc) {
            __builtin_amdgcn_fence(__ATOMIC_RELEASE, "agent");
            asm volatile("s_waitcnt vmcnt(0)" ::: "memory");
            const unsigned og = xb_add(&bar[XB_TOP], 1u);
            const unsigned tg = og / nx;
            if (og + 1u == (tg + 1u) * nx) xb_add(&bar[XB_TOPGEN], 1u);
            else XB_SPIN(xb_ld(&bar[XB_TOPGEN]) == tg, bar);
            __builtin_amdgcn_fence(__ATOMIC_ACQUIRE, "agent");
            xb_add(&bar[XB_XGEN(b.x)], 1u);
            asm volatile("s_waitcnt vmcnt(0)" ::: "memory");
        } else {
            XB_SPIN(xb_ld(&bar[XB_XGEN(b.x)]) == gen, bar);
            __builtin_amdgcn_fence(__ATOMIC_ACQUIRE, "agent");
            asm volatile("s_waitcnt vmcnt(0)" ::: "memory");
        }
    }
    __syncthreads();
}
#ifndef EXP_SSD2
#define EXP_SSD2 0
#endif
#ifndef EXP_ELT2
#define EXP_ELT2 0
#endif
#ifndef EXP_GU2
#define EXP_GU2 0
#endif
#ifndef PROBE_PHASE
#define PROBE_PHASE 99
#endif
#define PROBE_T0(k) unsigned long long _t0 = 0; if (PROBE_PHASE == (k)) _t0 = __builtin_amdgcn_s_memrealtime();
#define PROBE_T1(k) if (PROBE_PHASE == (k)) { if (blockIdx.x == 0 && opaque_tid() == 0) { const unsigned long long _t1 = __builtin_amdgcn_s_memrealtime(); while (__builtin_amdgcn_s_memrealtime() - _t1 < _t1 - _t0) __builtin_amdgcn_s_sleep(8); } gsync(grid); }
#ifndef PH_MASK
#define PH_MASK 0xffff
#endif
#ifndef MLA_SD
#define MLA_SD 1
#endif
constexpr int N_SSD = NB * 2 * 12, N_MLA = NB * 4 * 8, N_GQA = NB * 6 * 8, N_MIX = N_SSD + N_MLA + N_GQA;

__global__ void __launch_bounds__(512, 2) fwd_megakernel(Params p) {
    extern __shared__ __attribute__((aligned(16))) unsigned char smem[];
    cg::grid_group grid = cg::this_grid();
    LAS unsigned char* lds = (LAS unsigned char*)smem;
    volatile LAS unsigned* MISC = (volatile LAS unsigned*)(lds + MISC_OFF);
    const int wave = __builtin_amdgcn_readfirstlane(threadIdx.x >> 6);
    const int G = gridDim.x, bx = blockIdx.x;
    if (threadIdx.x < 2) MISC[8 + threadIdx.x] = 0u;
    __syncthreads();
    (void)xcd_barrier_post((unsigned*)(p.ws + WS_BAR), MISC + 8);
#define XBAR() do { XcdBarrier xb_; xb_.bar = (unsigned*)(p.ws + WS_BAR); xb_.x = xb_xcc_id(); xb_.st = MISC + 8; xcd_barrier(xb_); } while (0)
    const int gw = bx * 8 + wave, NGW = G * 8;
    unsigned char* ws = p.ws;
    unsigned* ctl = (unsigned*)(ws + WS_CTL);
    float* modall = (float*)(ws + WS_MOD);
    float* tab = (float*)(ws + WS_TAB);
    bf16_t* ACT = (bf16_t*)(ws + WS_ACT); bf16_t* PROJ = (bf16_t*)(ws + WS_PROJ);
    bf16_t* QB = (bf16_t*)(ws + WS_QB); bf16_t* KB = (bf16_t*)(ws + WS_KB); bf16_t* VB = (bf16_t*)(ws + WS_VB);
    bf16_t* XBC = (bf16_t*)(ws + WS_XBC); float* DT = (float*)(ws + WS_DT); float* YF = (float*)(ws + WS_YF); float* YB = (float*)(ws + WS_YB);
    bf16_t* HID = (bf16_t*)(ws + WS_HID);

    {
        if (bx == 0 && opaque_tid() < DEPTH) ctl[16 + opaque_tid()] = 0u;
        for (int it = bx; it < DEPTH * 192; it += G) mod_item(p, it, (LAS float*)lds, 0);
        __syncthreads();
        { const int gt = bx * 512 + opaque_tid();
          if (gt < 2048) { const int idx = gt >> 5, i = gt & 31; const float inv = powf(10000.f, -(float)(2 * i) / 64.f); const float ang = (float)idx * inv; tab[gt] = cosf(ang); tab[2048 + gt] = sinf(ang); }
          else if (gt < 3072) { const int q = gt - 2048, idx = q >> 4, i = q & 15; const float inv = powf(10000.f, -(float)(2 * i) / 32.f); const float ang = (float)idx * inv; tab[4096 + q] = cosf(ang); tab[4096 + 1024 + q] = sinf(ang); } }
        LAS float* scr = (LAS float*)(lds + wave * 16384);
        constexpr int I_IN = (D / 64) * (INP / 32), I_UQ = (512 / 64) * (768 / 32), I_UKV = (256 / 64) * (1024 / 32), I_OUT = (D / 64) * (D / 32), I_GU = (D / 64) * (2 * FF / 32), I_DN = (FF / 64) * (D / 32);
        constexpr int I_LAYER = I_IN + I_UQ + I_UKV + I_OUT + I_GU + I_DN;
        for (int it = gw; it < DEPTH * I_LAYER; it += NGW) {
            const int l = it / I_LAYER; int r = it % I_LAYER;
            unsigned char* wl = ws + WS_W + (size_t)l * W_LAYER;
            if (r < I_IN) { transpose_item(p.in[6] + (size_t)l * D * INC, D, INC, INP, (bf16_t*)(wl + W_IN), 0, scr, r, 0); continue; } r -= I_IN;
            if (r < I_UQ) { transpose_item(p.in[10] + (size_t)l * 512 * 768, 512, 768, 768, (bf16_t*)(wl + W_UQ), 0, scr, r, 0); continue; } r -= I_UQ;
            if (r < I_UKV) { transpose_item(p.in[12] + (size_t)l * 256 * 1024, 256, 1024, 1024, (bf16_t*)(wl + W_UKV), 0, scr, r, 0); continue; } r -= I_UKV;
            if (r < I_OUT) { transpose_item(p.in[19] + (size_t)l * D * D, D, D, D, (bf16_t*)(wl + W_OUT), 0, scr, r, 0); continue; } r -= I_OUT;
            if (r < I_GU) { transpose_item(p.in[20] + (size_t)l * D * 2 * FF, D, 2 * FF, 2 * FF, (bf16_t*)(wl + W_GU), 1, scr, r, 0); continue; } r -= I_GU;
            transpose_item(p.in[21] + (size_t)l * FF * D, FF, D, D, (bf16_t*)(wl + W_DN), 0, scr, r, 0);
        }
    }
    XBAR();
    if (opaque_s(0) != 0) gsync(grid);

    for (int layer = 0; layer < DEPTH; ++layer) {
        const unsigned char* wl = ws + WS_W + (size_t)layer * W_LAYER;
        const float* modl = modall + (size_t)layer * NB * MODW;
        const float* xin = layer == 0 ? p.in[0] : p.out;
        norm_mod_phase(xin, p.in[4] + layer * D, modl, 0, D, ACT, gw, NGW, 0);
        if (EXP_ELT2) norm_mod_phase(xin, p.in[4] + layer * D, modl, 0, D, ACT, gw, NGW, 0);
        XBAR();
        #if PH_MASK & (1<<2)
        { pg8::Gemm g{ACT, (const bf16_t*)(wl + W_IN), T, INP, D, D}; pg8::StaticOrder so; so.init(T, INP, G, bx);
          pg8::EpiProj E{PROJ}; pg8::gemm_phase<pg8::EpiProj>(lds, g, so, E); }

#endif
        XBAR();
        prep_phase(p, layer, gw, NGW, 0);
        XBAR();
        #if PH_MASK & (1<<4)
        { pg8::Gemm g{PROJ + C_CQ, (const bf16_t*)(wl + W_UQ), T, 768, 512, INP}; pg8::StaticOrder so; so.init(T, 768, G, bx);
          pg8::EpiUq E{QB, tab + 4096, tab + 4096 + 1024}; pg8::gemm_phase<pg8::EpiUq>(lds, g, so, E); }

#endif
        #if PH_MASK & (1<<5)
        { pg8::Gemm g{PROJ + C_CKV, (const bf16_t*)(wl + W_UKV), T, 1024, 256, INP}; pg8::StaticOrder so; so.init(T, 1024, G, bx);
          pg8::EpiUkv E{KB, VB}; pg8::gemm_phase<pg8::EpiUkv>(lds, g, so, E); }

#endif
        XBAR();
        PROBE_T0(5)
        {
            const float* alog = p.in[16] + layer * 24;
            for (;;) {
                __syncthreads();
                if (opaque_tid() == 0) MISC[0] = atomicAdd(ctl + 16 + layer, 1u);
                __syncthreads();
                int it = (int)MISC[0];
                if (it >= N_MIX + (EXP_SSD2 ? N_SSD : 0)) break;
                if (EXP_SSD2 && it >= N_MIX) it -= N_MIX;
                if (it < N_SSD) {
                    const int h = it % 12, dir = (it / 12) & 1, b = it / 24;
#ifndef NO_SSD
                    ssdm::ssd_item(XBC, DT, dir ? YB : YF, -expf(alog[dir * 12 + h]), b, dir, h, (char*)smem);
#endif
                } else if (it < N_SSD + N_MLA) {
                    const int i = it - N_SSD, qb = i & 7, h = (i >> 3) & 3, b = i >> 5;
                    const size_t r0 = (size_t)b * S;
#ifndef NO_MLA
                    att::attn_simple_body<192, 768, 768, 512, D>(QB + (r0 + qb * 256) * 768 + h * 192, KB + r0 * 768 + h * 192, VB + r0 * 512 + h * 128,
                                                                ACT + (r0 + qb * 256) * D + 768 + h * 128, S, (char*)smem);
#endif
                } else {
                    const int i = it - N_SSD - N_MLA, qb = i & 7, h = (i >> 3) % 6, b = i / 48;
                    const size_t r0 = (size_t)b * S;
#ifndef NO_GQA
                    att::attn_dense_body<128, INP, INP, INP, D, 2>(PROJ + (r0 + qb * 256) * INP + C_QA + h * 128, PROJ + r0 * INP + C_KA + (h / 3) * 128, PROJ + r0 * INP + C_VA + (h / 3) * 128,
                                                                ACT + (r0 + qb * 256) * D + h * 128, S, (char*)smem);
#endif
                }
            }
        }
        XBAR();
        PROBE_T1(5)
        combine_phase(p, layer, gw, NGW, 0);
        if (EXP_ELT2) combine_phase(p, layer, gw, NGW, 0);
        XBAR();
        #if PH_MASK & (1<<7)
        { pg8::Gemm g{ACT, (const bf16_t*)(wl + W_OUT), T, D, D, D}; pg8::StaticOrder so; so.init(T, D, G, bx);
          pg8::EpiResid E{xin, p.out, modl + 2 * D}; pg8::gemm_phase<pg8::EpiResid>(lds, g, so, E); }

#endif
        XBAR();
        norm_mod_phase(p.out, p.in[5] + layer * D, modl, 3 * D, 4 * D, ACT, gw, NGW, 0);
        if (EXP_ELT2) norm_mod_phase(p.out, p.in[5] + layer * D, modl, 3 * D, 4 * D, ACT, gw, NGW, 0);
        XBAR();
        #if PH_MASK & (1<<9)
        { pg8::Gemm g{ACT, (const bf16_t*)(wl + W_GU), T, 2 * FF, D, D}; pg8::StaticOrder so; so.init(T, 2 * FF, G, bx);
          pg8::EpiSwiglu E{HID}; pg8::gemm_phase<pg8::EpiSwiglu>(lds, g, so, E);
          if (EXP_GU2) pg8::gemm_phase<pg8::EpiSwiglu>(lds, g, so, E); }

#endif
        XBAR();
        #if PH_MASK & (1<<10)
        { pg8::Gemm g{HID, (const bf16_t*)(wl + W_DN), T, D, FF, FF}; pg8::StaticOrder so; so.init(T, D, G, bx);
          pg8::EpiResid E{p.out, p.out, modl + 5 * D}; pg8::gemm_phase<pg8::EpiResid>(lds, g, so, E); }

#endif
        XBAR();
    }
    {
        const float* fg = p.in[22]; const int lane = opaque_tid() & 63; const int gw2 = opaque_s(gw);
        for (int row0 = gw2; row0 < T; row0 += 2 * NGW) {
            const int row1 = row0 + NGW; const bool has1 = row1 < T;
            f32x4* xr0 = (f32x4*)(p.out + (size_t)row0 * D) + lane; f32x4* xr1 = (f32x4*)(p.out + (size_t)(has1 ? row1 : row0) * D) + lane;
            f32x4 v0[8], v1[8]; float ss0 = 0.f, ss1 = 0.f;
#pragma unroll
            for (int j = 0; j < 8; ++j) { v0[j] = xr0[64 * j]; v1[j] = xr1[64 * j]; }
#pragma unroll
            for (int j = 0; j < 8; ++j) { ss0 += (v0[j][0] * v0[j][0] + v0[j][1] * v0[j][1]) + (v0[j][2] * v0[j][2] + v0[j][3] * v0[j][3]);
                                          ss1 += (v1[j][0] * v1[j][0] + v1[j][1] * v1[j][1]) + (v1[j][2] * v1[j][2] + v1[j][3] * v1[j][3]); }
            wave_sum2(ss0, ss1);
            const float rstd0 = rsqrtf(ss0 * (1.f / D) + EPS), rstd1 = rsqrtf(ss1 * (1.f / D) + EPS);
            f32x4 g4[8];
#pragma unroll
            for (int j = 0; j < 8; ++j) g4[j] = *(const f32x4*)(fg + (lane + 64 * j) * 4);
#pragma unroll
            for (int j = 0; j < 8; ++j) { xr0[64 * j] = (v0[j] * rstd0) * g4[j]; if (has1) xr1[64 * j] = (v1[j] * rstd1) * g4[j]; }
        }
    }
}

#undef XBAR
extern "C" void kernel_launch(void* const* d_in, const int* in_sizes, int n_in, void* d_out, int out_size, void* d_ws, size_t ws_size, hipStream_t stream) {
    static int grid_blocks = 0;
    if (grid_blocks == 0) {
        if (n_in != 23 || in_sizes[0] != T * D || out_size != T * D || ws_size < WS_END) {
            fprintf(stderr, "kernel_launch: shape/workspace mismatch: n_in %d in0 %d out %d ws %zu (need %zu); nothing launched\n", n_in, n_in > 0 ? in_sizes[0] : -1, out_size, ws_size, (size_t)WS_END);
            grid_blocks = -1; return; }
        int dev = 0, cus = 0, per_cu = 0;
        hipGetDevice(&dev);
        hipDeviceGetAttribute(&cus, hipDeviceAttributeMultiprocessorCount, dev);
        if (hipFuncSetAttribute((const void*)fwd_megakernel, hipFuncAttributeMaxDynamicSharedMemorySize, LDS_BYTES) != hipSuccess) { fprintf(stderr, "kernel_launch: hipFuncSetAttribute failed\n"); grid_blocks = -1; return; }
        if (hipOccupancyMaxActiveBlocksPerMultiprocessor(&per_cu, (const void*)fwd_megakernel, 512, LDS_BYTES) != hipSuccess || per_cu < 1) { fprintf(stderr, "kernel_launch: occupancy query failed (%d)\n", per_cu); (void)hipGetLastError(); per_cu = 1; }
        grid_blocks = cus * per_cu;
        fprintf(stderr, "kernel_launch: grid %d (cus %d x %d), ws need %zu of %zu\n", grid_blocks, cus, per_cu, (size_t)WS_END, ws_size);
    }
    if (grid_blocks < 0) return;
    if (hipMemsetAsync((char*)d_ws + WS_BAR, 0, 16384, stream) != hipSuccess) { fprintf(stderr, "kernel_launch: memset of the barrier words failed\n"); return; }
    Params p{};
    for (int i = 0; i < 23; ++i) p.in[i] = (const float*)d_in[i];
    p.out = (float*)d_out; p.ws = (unsigned char*)d_ws;
    void* args[] = {&p};
    hipError_t e = hipLaunchCooperativeKernel((const void*)fwd_megakernel, dim3(grid_blocks), dim3(512), args, LDS_BYTES, stream);
    if (e != hipSuccess) fprintf(stderr, "kernel_launch: cooperative launch failed: %s (grid %d)\n", hipGetErrorString(e), grid_blocks);
}
```

```cpp
#include <hip/hip_runtime.h>
#include <hip/hip_cooperative_groups.h>
#include <cstdio>
#include <cstdint>
namespace cg = cooperative_groups;

#define LAS __attribute__((address_space(3)))
typedef unsigned short bf16_t;
typedef short bf16x8 __attribute__((ext_vector_type(8)));
typedef short s16x4 __attribute__((ext_vector_type(4)));
typedef float f32x2 __attribute__((ext_vector_type(2)));
typedef float f32x4 __attribute__((ext_vector_type(4)));
typedef float f32x16 __attribute__((ext_vector_type(16)));
typedef unsigned u32x2 __attribute__((ext_vector_type(2)));
typedef unsigned u32x4 __attribute__((ext_vector_type(4)));

constexpr int NB = 16, S = 2048, D = 2048, T = NB * S, DEPTH = 2;
constexpr int INC = 4184, INP = 4352;
constexpr int FF = 5632;
constexpr int C_QA = 0, C_KA = 768, C_VA = 1024, C_CQ = 1280, C_CKV = 1792, C_KPE = 2048, C_Z = 2112, C_XBC = 2880, C_DT = 4160;
constexpr float EPS = 1e-6f;
constexpr int MODW = 6 * D;

constexpr size_t al256(size_t x) { return (x + 255) / 256 * 256; }
constexpr size_t WS_CTL = 0;
constexpr size_t WS_MOD = 4096;
constexpr size_t WS_TAB = WS_MOD + (size_t)DEPTH * NB * MODW * 4;
constexpr size_t WS_BAR = al256(WS_TAB + (64 * 32 * 2 + 64 * 16 * 2) * 4);
constexpr size_t WS_W   = al256(WS_BAR + 16384);
constexpr size_t W_IN = 0, W_UQ = W_IN + (size_t)INP * D * 2, W_UKV = W_UQ + (size_t)768 * 512 * 2, W_OUT = W_UKV + (size_t)1024 * 256 * 2,
                 W_GU = W_OUT + (size_t)D * D * 2, W_DN = W_GU + (size_t)2 * FF * D * 2, W_LAYER = W_DN + (size_t)D * FF * 2;
constexpr size_t WS_ACT = al256(WS_W + DEPTH * W_LAYER);
constexpr size_t WS_BIG = WS_ACT + (size_t)T * D * 2;
constexpr size_t WS_PROJ = WS_BIG;
constexpr size_t WS_QB = WS_PROJ + (size_t)T * INP * 2;
constexpr size_t WS_KB = WS_QB + (size_t)T * 768 * 2;
constexpr size_t WS_VB = WS_KB + (size_t)T * 768 * 2;
constexpr size_t WS_XBC = WS_VB + (size_t)T * 512 * 2;
constexpr size_t WS_DT = WS_XBC + (size_t)T * 1280 * 2;
constexpr size_t WS_YF = WS_DT + (size_t)T * 24 * 4;
constexpr size_t WS_YB = WS_YF + (size_t)T * 768 * 4;
constexpr size_t WS_END1 = WS_YB + (size_t)T * 768 * 4;
constexpr size_t WS_HID = WS_BIG;
constexpr size_t WS_END2 = WS_HID + (size_t)T * FF * 2;
constexpr size_t WS_END = WS_END1 > WS_END2 ? WS_END1 : WS_END2;

constexpr int RING_BYTES = 131072, MISC_OFF = RING_BYTES, LDS_BYTES = 147456;

struct Params { const float* in[23]; float* out; unsigned char* ws; };

__device__ __forceinline__ float bf2f(bf16_t b) { return __uint_as_float(((unsigned)b) << 16); }
__device__ __forceinline__ float bfs2f(short b) { return __uint_as_float(((unsigned)(unsigned short)b) << 16); }
__device__ __forceinline__ unsigned cvt_pk_bf16(float lo, float hi) { unsigned r; asm volatile("v_cvt_pk_bf16_f32 %0, %1, %2" : "=v"(r) : "v"(lo), "v"(hi)); return r; }
__device__ __forceinline__ bf16_t f2bf_c(float f) { unsigned u = __float_as_uint(f); u += 0x7fffu + ((u >> 16) & 1u); return (bf16_t)(u >> 16); }
__device__ __forceinline__ unsigned pk2c(float lo, float hi) { return (unsigned)f2bf_c(lo) | ((unsigned)f2bf_c(hi) << 16); }
__device__ __forceinline__ bf16_t f2bf(float f) { return (bf16_t)(cvt_pk_bf16(f, 0.f) & 0xffffu); }
template <int O> __device__ __forceinline__ float shx(float x) {
    static_assert(O < 32, "within a 32-lane half");
    return __int_as_float(__builtin_amdgcn_ds_swizzle(__float_as_int(x), 0x1f | (O << 10)));
}
__device__ __forceinline__ float xsum32(float x) { auto rr = __builtin_amdgcn_permlane32_swap(__float_as_uint(x), __float_as_uint(x), false, false); return __uint_as_float(rr[0]) + __uint_as_float(rr[1]); }
#define XOR_STEPS(BODY) { BODY(1) BODY(2) BODY(4) BODY(8) BODY(16) }
__device__ __forceinline__ float wave_sum(float v) {
#define WS_STEP(O) v += shx<O>(v);
    XOR_STEPS(WS_STEP)
#undef WS_STEP
    return xsum32(v);
}
__device__ __forceinline__ void wave_sum2(float& a, float& b) {
#define WS_STEP(O) { const float ta = shx<O>(a), tb = shx<O>(b); a += ta; b += tb; }
    XOR_STEPS(WS_STEP)
#undef WS_STEP
    a = xsum32(a); b = xsum32(b);
}
__device__ __forceinline__ float silu_f(float x) { return x * __builtin_amdgcn_rcpf(1.f + __expf(-x)); }
__device__ __forceinline__ int opaque_tid() { int t = threadIdx.x; asm volatile("" : "+v"(t)); return t; }
__device__ __forceinline__ int opaque_s(int x) { asm volatile("" : "+s"(x)); return x; }
#define LDS_WAIT() asm volatile("s_waitcnt lgkmcnt(0)" ::: "memory")

namespace pg8 {
constexpr int BM = 256, BK = 64, HALF = 128, HTB = HALF * BK * 2, STAGE_BYTES = 8 * HTB, NXCD = 8, WGM = 8;
__host__ __device__ __forceinline__ int lds_byte(int r, int c) { const int st = (r >> 4) * 2 + (c >> 5), rr = r & 15, cc = c & 31, ob = rr * 64 + cc * 2; return st * 1024 + (ob ^ (((ob >> 9) & 1) << 5)); }
__host__ __device__ __forceinline__ void stage_rc(int b, int& R, int& C) { const int st = b / 1024, sb = b % 1024, swz = sb ^ (((sb >> 9) & 1) << 5); R = (st >> 1) * 16 + swz / 64; C = (st & 1) * 32 + (swz % 64) / 2; }
__host__ __device__ __forceinline__ int perm32(int rho) { const int n = rho >> 4, i = rho & 15; return 8 * (i >> 2) + 4 * n + (i & 3); }

struct Unit { int pm, pn; };
struct Gemm { const bf16_t* A; const bf16_t* Bt; int M, N, K, lda; };

struct StaticOrder {
    int nM, nN, nwg, G, c;
    __device__ void init(int M, int N, int G_, int c_) { nM = M / BM; nN = N / BM; nwg = nM * nN; G = G_; c = c_; }
    __device__ bool next(int i, Unit& u) const {
        const long L = (long)i * G + c; if (L >= nwg) return false;
        int wgid = (int)L; { const int q = nwg / NXCD, r = nwg % NXCD, xcd = wgid % NXCD, off = wgid / NXCD; wgid = (xcd < r ? xcd * (q + 1) : r * (q + 1) + (xcd - r) * q) + off; }
        const int nig = WGM * nN, gid = wgid / nig, fm = gid * WGM, gsz = (nM - fm) < WGM ? (nM - fm) : WGM;
        u.pm = fm + ((wgid % nig) % gsz); u.pn = (wgid % nig) / gsz; return true;
    }
};

template <class Epi>
__device__ __forceinline__ void gemm_phase(LAS unsigned char* lds, const Gemm g, const StaticOrder& S, const Epi& E) {
    const int tid = opaque_tid(), wid = __builtin_amdgcn_readfirstlane(tid >> 6), lane = tid & 63, wr = wid >> 2, wc = wid & 3, fr = lane & 15, fq = lane >> 4;
    const int K = g.K, nt = K / BK;
    unsigned voffA[2], voffB[2];
#pragma unroll
    for (int i = 0; i < 2; ++i) { int R, C; stage_rc(tid * 16 + i * 8192, R, C); const int Rb = Epi::PERM ? ((R & ~31) + perm32(R & 31)) : R;
        voffA[i] = (unsigned)(R * g.lda + C) * 2u; voffB[i] = (unsigned)(Rb * K + C) * 2u; }
    const size_t kstep = (size_t)(BK * 2);
    const size_t hstepA = (size_t)HALF * g.lda * 2, hstepB = (size_t)HALF * K * 2;
    const size_t tstepA = 2 * hstepA, tstepB = 2 * hstepB;
    const unsigned ldsw = (unsigned)wid * 1024u;
    const int aoff = lds_byte(wr * 64 + fr, fq * 8), boff = lds_byte(wc * 32 + fr, fq * 8);
#define PG8_SA(b, h) (((b) * 2 + (h)) * HTB)
#define PG8_SB(b, h) ((4 + (b) * 2 + (h)) * HTB)
#define PG8_STAGE(bufoff, gbase, voff) do { _Pragma("unroll") for (int _i = 0; _i < 2; ++_i) \
        __builtin_amdgcn_global_load_lds((const unsigned*)((const char*)(gbase) + (voff)[_i]), (LAS unsigned*)(lds + (bufoff) + ldsw + _i * 8192), 16, 0, 0); } while (0)
#define PG8_LDA(dst, b, h) do { _Pragma("unroll") for (int m = 0; m < 4; ++m) _Pragma("unroll") for (int k = 0; k < 2; ++k) dst[m][k] = *(const LAS bf16x8*)(lds + PG8_SA(b, h) + aoff + m * 2048 + k * 1024); } while (0)
#define PG8_LDB(dst, b, h) do { _Pragma("unroll") for (int n = 0; n < 2; ++n) _Pragma("unroll") for (int k = 0; k < 2; ++k) dst[n][k] = *(const LAS bf16x8*)(lds + PG8_SB(b, h) + boff + n * 2048 + k * 1024); } while (0)
#define PG8_MMA(ai, bj, At, Bt) do { __builtin_amdgcn_s_setprio(1); _Pragma("unroll") for (int m = 0; m < 4; ++m) _Pragma("unroll") for (int n = 0; n < 2; ++n) _Pragma("unroll") for (int k = 0; k < 2; ++k) \
        acc[ai][bj][m][n] = __builtin_amdgcn_mfma_f32_16x16x32_bf16(Bt[n][k], At[m][k], acc[ai][bj][m][n], 0, 0, 0); __builtin_amdgcn_s_setprio(0); } while (0)
#define PG8_WAIT_V(n) asm volatile("s_waitcnt vmcnt(" #n ")" ::: "memory")
#define PG8_WAIT_L(n) asm volatile("s_waitcnt lgkmcnt(" #n ")" ::: "memory")
#define PG8_BAR __builtin_amdgcn_s_barrier()
#define PG8_SCHED __builtin_amdgcn_sched_barrier(0)
    Unit cur, nxt; int ui = 0;
    if (!S.next(0, cur)) return;
    f32x4 acc[2][2][4][2];
#pragma unroll
    for (int a = 0; a < 2; ++a)
#pragma unroll
        for (int b = 0; b < 2; ++b)
#pragma unroll
            for (int m = 0; m < 4; ++m)
#pragma unroll
                for (int n = 0; n < 2; ++n) acc[a][b][m][n] = (f32x4){0.f, 0.f, 0.f, 0.f};
    bf16x8 At[4][2], B0[2][2], B1[2][2];
    const char* cA = (const char*)g.A + (size_t)cur.pm * tstepA; const char* cB = (const char*)g.Bt + (size_t)cur.pn * tstepB;
    PG8_STAGE(PG8_SB(0, 0), cB, voffB); PG8_STAGE(PG8_SB(0, 1), cB + hstepB, voffB); PG8_STAGE(PG8_SA(0, 0), cA, voffA); PG8_STAGE(PG8_SA(0, 1), cA + hstepA, voffA);
    if (wr == 1) PG8_BAR;
    PG8_WAIT_V(2); PG8_BAR;
    PG8_STAGE(PG8_SB(1, 0), cB + kstep, voffB); PG8_STAGE(PG8_SA(1, 0), cA + kstep, voffA); PG8_STAGE(PG8_SB(1, 1), cB + hstepB + kstep, voffB);
    PG8_WAIT_V(6); PG8_BAR;
    for (;;) {
        const bool has_next = S.next(ui + 1, nxt);
        const char* nA = has_next ? (const char*)g.A + (size_t)nxt.pm * tstepA : cA; const char* nB = has_next ? (const char*)g.Bt + (size_t)nxt.pn * tstepB : cB;
#pragma nounroll
        for (int t = 0; t < nt; t += 2) {
            const bool last = (t == nt - 2);
            const char* a1 = cA + (size_t)(t + 1) * kstep;
            const char* a2 = last ? nA : cA + (size_t)(t + 2) * kstep; const char* b2 = last ? nB : cB + (size_t)(t + 2) * kstep;
            const char* a3 = a2 + kstep; const char* b3 = b2 + kstep;
            PG8_LDB(B0, 0, 0); PG8_LDB(B1, 0, 1); PG8_SCHED; PG8_LDA(At, 0, 0); PG8_STAGE(PG8_SA(1, 1), a1 + hstepA, voffA);
            PG8_WAIT_V(8); PG8_WAIT_L(0); PG8_BAR; PG8_MMA(0, 0, At, B0); PG8_MMA(0, 1, At, B1); PG8_BAR; PG8_SCHED;
            PG8_LDA(At, 0, 1); PG8_STAGE(PG8_SB(0, 0), b2, voffB); PG8_STAGE(PG8_SB(0, 1), b2 + hstepB, voffB); PG8_STAGE(PG8_SA(0, 0), a2, voffA);
            PG8_WAIT_V(8); PG8_WAIT_L(0); PG8_BAR; PG8_MMA(1, 0, At, B0); PG8_MMA(1, 1, At, B1); PG8_BAR; PG8_SCHED;
            PG8_LDB(B0, 1, 0); PG8_LDB(B1, 1, 1); PG8_SCHED; PG8_LDA(At, 1, 0); PG8_STAGE(PG8_SA(0, 1), a2 + hstepA, voffA);
            PG8_WAIT_V(8); PG8_WAIT_L(0); PG8_BAR; PG8_MMA(0, 0, At, B0); PG8_MMA(0, 1, At, B1); PG8_BAR; PG8_SCHED;
            PG8_LDA(At, 1, 1); PG8_STAGE(PG8_SB(1, 0), b3, voffB); PG8_STAGE(PG8_SB(1, 1), b3 + hstepB, voffB); PG8_STAGE(PG8_SA(1, 0), a3, voffA);
            PG8_WAIT_V(8); PG8_WAIT_L(0); PG8_BAR; PG8_MMA(1, 0, At, B0); PG8_MMA(1, 1, At, B1); PG8_BAR; PG8_SCHED;
        }
        if (wr == 0) PG8_BAR;
        E(acc, cur, wr, wc, fr, fq);
        if (!has_next) break;
#pragma unroll
        for (int a = 0; a < 2; ++a)
#pragma unroll
            for (int b = 0; b < 2; ++b)
#pragma unroll
                for (int m = 0; m < 4; ++m)
#pragma unroll
                    for (int n = 0; n < 2; ++n) acc[a][b][m][n] = (f32x4){0.f, 0.f, 0.f, 0.f};
        cur = nxt; cA = nA; cB = nB; ++ui;
        if (wr == 1) PG8_BAR;
    }
    PG8_WAIT_V(0);
    PG8_BAR;
#undef PG8_SA
#undef PG8_SB
#undef PG8_STAGE
#undef PG8_LDA
#undef PG8_LDB
#undef PG8_MMA
#undef PG8_WAIT_V
#undef PG8_WAIT_L
#undef PG8_BAR
#undef PG8_SCHED
}

struct EpiProj {
    static constexpr bool PERM = true;
    bf16_t* O;
    __device__ __forceinline__ void operator()(const f32x4 (&acc)[2][2][4][2], const Unit& u, int wr, int wc, int fr, int fq) const {
        const int row0 = u.pm * BM + wr * 64 + fr, col0 = u.pn * BM + wc * 32 + 8 * fq;
#pragma unroll
        for (int ai = 0; ai < 2; ++ai)
#pragma unroll
            for (int m = 0; m < 4; ++m) { bf16_t* rowp = O + (size_t)(row0 + ai * HALF + m * 16) * INP + col0;
#pragma unroll
                for (int bj = 0; bj < 2; ++bj) { const f32x4 v0 = acc[ai][bj][m][0], v1 = acc[ai][bj][m][1];
                    u32x4 w; w.x = cvt_pk_bf16(v0[0], v0[1]); w.y = cvt_pk_bf16(v0[2], v0[3]); w.z = cvt_pk_bf16(v1[0], v1[1]); w.w = cvt_pk_bf16(v1[2], v1[3]);
                    *(u32x4*)(rowp + bj * HALF) = w; } }
    }
};
struct EpiUq {
    static constexpr bool PERM = false;
    bf16_t* O; const float* tcos; const float* tsin;
    __device__ __forceinline__ void operator()(const f32x4 (&acc)[2][2][4][2], const Unit& u, int wr, int wc, int fr, int fq) const {
        const int row0 = u.pm * BM + wr * 64 + fr;
#pragma unroll
        for (int bj = 0; bj < 2; ++bj) {
            const int cg = u.pn * BM + bj * HALF + wc * 32, w = cg % 192;
            const int axis = (w == 128) ? 0 : ((w == 160) ? 1 : -1);
#pragma unroll
            for (int ai = 0; ai < 2; ++ai)
#pragma unroll
                for (int m = 0; m < 4; ++m) {
                    const int r = row0 + ai * HALF + m * 16, s = r & (S - 1);
                    f32x4 x1 = acc[ai][bj][m][0], x2 = acc[ai][bj][m][1];
                    if (axis >= 0) {
                        const int idx = axis ? (s & 63) : (s >> 6);
                        const f32x4 c = *(const f32x4*)(tcos + idx * 16 + 4 * fq), sn = *(const f32x4*)(tsin + idx * 16 + 4 * fq);
                        const f32x4 o1 = x1 * c - x2 * sn, o2 = x1 * sn + x2 * c; x1 = o1; x2 = o2;
                    }
                    bf16_t* rowp = O + (size_t)r * 768 + cg + 4 * fq;
                    u32x2 w0, w1; w0.x = pk2c(x1[0], x1[1]); w0.y = pk2c(x1[2], x1[3]); w1.x = pk2c(x2[0], x2[1]); w1.y = pk2c(x2[2], x2[3]);
                    *(u32x2*)(rowp) = w0; *(u32x2*)(rowp + 16) = w1;
                }
        }
    }
};
struct EpiUkv {
    static constexpr bool PERM = true;
    bf16_t* KB; bf16_t* VB;
    __device__ __forceinline__ void operator()(const f32x4 (&acc)[2][2][4][2], const Unit& u, int wr, int wc, int fr, int fq) const {
        const int row0 = u.pm * BM + wr * 64 + fr, cin = wc * 32 + 8 * fq;
#pragma unroll
        for (int ai = 0; ai < 2; ++ai)
#pragma unroll
            for (int m = 0; m < 4; ++m) { const size_t r = (size_t)(row0 + ai * HALF + m * 16);
#pragma unroll
                for (int bj = 0; bj < 2; ++bj) { const f32x4 v0 = acc[ai][bj][m][0], v1 = acc[ai][bj][m][1];
                    u32x4 w; w.x = pk2c(v0[0], v0[1]); w.y = pk2c(v0[2], v0[3]); w.z = pk2c(v1[0], v1[1]); w.w = pk2c(v1[2], v1[3]);
                    bf16_t* dst = bj == 0 ? (KB + r * 768 + u.pn * 192 + cin) : (VB + r * 512 + u.pn * 128 + cin);
                    *(u32x4*)dst = w; } }
    }
};
struct EpiResid {
    static constexpr bool PERM = false;
    const float* in; float* out; const float* gate;
    __device__ __forceinline__ void operator()(const f32x4 (&acc)[2][2][4][2], const Unit& u, int wr, int wc, int fr, int fq) const {
        const int row0 = u.pm * BM + wr * 64 + fr, col0 = u.pn * BM + wc * 32 + 4 * fq;
        const float* gb = gate + (size_t)(u.pm >> 3) * MODW + col0;
        f32x4 gv[2][2];
#pragma unroll
        for (int bj = 0; bj < 2; ++bj)
#pragma unroll
            for (int n = 0; n < 2; ++n) gv[bj][n] = *(const f32x4*)(gb + bj * HALF + n * 16);
#pragma unroll
        for (int ai = 0; ai < 2; ++ai)
#pragma unroll
            for (int mp = 0; mp < 2; ++mp) {
                f32x4 bs[2][2][2];
#pragma unroll
                for (int mm = 0; mm < 2; ++mm) { const size_t off = (size_t)(row0 + ai * HALF + (2 * mp + mm) * 16) * D + col0;
#pragma unroll
                    for (int bj = 0; bj < 2; ++bj)
#pragma unroll
                        for (int n = 0; n < 2; ++n) bs[mm][bj][n] = *(const f32x4*)(in + off + bj * HALF + n * 16); }
#pragma unroll
                for (int mm = 0; mm < 2; ++mm) { const size_t off = (size_t)(row0 + ai * HALF + (2 * mp + mm) * 16) * D + col0;
#pragma unroll
                    for (int bj = 0; bj < 2; ++bj)
#pragma unroll
                        for (int n = 0; n < 2; ++n) *(f32x4*)(out + off + bj * HALF + n * 16) = bs[mm][bj][n] + gv[bj][n] * acc[ai][bj][2 * mp + mm][n]; }
                asm volatile("" ::: "memory"); }
    }
};
struct EpiSwiglu {
    static constexpr bool PERM = true;
    bf16_t* O;
    __device__ __forceinline__ void operator()(const f32x4 (&acc)[2][2][4][2], const Unit& u, int wr, int wc, int fr, int fq) const {
        const int row0 = u.pm * BM + wr * 64 + fr, col0 = u.pn * HALF + wc * 32 + 8 * fq;
#pragma unroll
        for (int ai = 0; ai < 2; ++ai)
#pragma unroll
            for (int m = 0; m < 4; ++m) { bf16_t* rowp = O + (size_t)(row0 + ai * HALF + m * 16) * FF + col0;
                f32x4 h0, h1;
#pragma unroll
                for (int j = 0; j < 4; ++j) { h0[j] = silu_f(acc[ai][0][m][0][j]) * acc[ai][1][m][0][j]; h1[j] = silu_f(acc[ai][0][m][1][j]) * acc[ai][1][m][1][j]; }
                u32x4 w; w.x = cvt_pk_bf16(h0[0], h0[1]); w.y = cvt_pk_bf16(h0[2], h0[3]); w.z = cvt_pk_bf16(h1[0], h1[1]); w.w = cvt_pk_bf16(h1[2], h1[3]);
                *(u32x4*)rowp = w; }
    }
};
}

namespace att {
constexpr int NW = 8, QBLK = 32, KVBLK = 64, DV = 128;
constexpr float THR = 8.f;
#define SBAR() __builtin_amdgcn_sched_barrier(0)
__device__ __forceinline__ int crow(int r, int hi) { return (r & 3) + 8 * (r >> 2) + 4 * hi; }
__device__ __forceinline__ unsigned cvtpk(float lo, float hi) { unsigned r; asm volatile("v_cvt_pk_bf16_f32 %0, %1, %2" : "=v"(r) : "v"(lo), "v"(hi)); return r; }

template <int DK> struct Cfg {
    static constexpr float SCALE = (DK == 128) ? 0.088388347648318440f : 0.072168783648703220f;
    static constexpr int KROWB = DK * 2;
    static constexpr int SHM_V = KVBLK * DV * 2, SHM_K = KVBLK * DK * 2;
    static constexpr int SHM = 2 * SHM_V + 2 * SHM_K + NW * 64 * 4;
    static constexpr int NKC = DK / 64;
    static constexpr int ND0 = DK / 16;
};
template <int DK> __device__ __forceinline__ int kswz(int row, int colB) { return row * (DK * 2) + (colB ^ ((row & 7) << 4)); }

template <int DK>
__device__ __forceinline__ void partialSM(f32x16& p0, f32x16& p1, float& m_reg, float& mn, float& alpha) {
    constexpr float SCALE = Cfg<DK>::SCALE;
    constexpr float C = SCALE * 1.4426950408889634f;
    float pmax = p0[0];
#pragma unroll
    for (int r = 1; r < 16; ++r) pmax = fmaxf(pmax, p0[r]);
#pragma unroll
    for (int r = 0; r < 16; ++r) pmax = fmaxf(pmax, p1[r]);
    { auto rr = __builtin_amdgcn_permlane32_swap(__float_as_uint(pmax), __float_as_uint(pmax), false, false);
      pmax = fmaxf(__uint_as_float(rr[0]), __uint_as_float(rr[1])); }
    if (__builtin_expect(__all(pmax - m_reg <= THR / SCALE), 1)) { mn = m_reg; alpha = 1.f; }
    else { mn = fmaxf(m_reg, pmax); alpha = __builtin_amdgcn_exp2f((m_reg - mn) * C); m_reg = mn; }
    float mnC = -mn * C;
#pragma unroll
    for (int r = 0; r < 16; ++r) p0[r] = fmaf(p0[r], C, mnC);
#pragma unroll
    for (int r = 0; r < 16; ++r) p1[r] = fmaf(p1[r], C, mnC);
#pragma unroll
    for (int r = 0; r < 16; ++r) p0[r] = __builtin_amdgcn_exp2f(p0[r]);
}
__device__ __forceinline__ void finishSM(f32x16& p0, f32x16& p1, float alpha, float& l_reg, bf16x8& pa0, bf16x8& pa1, bf16x8& pa2, bf16x8& pa3) {
#pragma unroll
    for (int r = 0; r < 16; ++r) p1[r] = __builtin_amdgcn_exp2f(p1[r]);
    float ps = 0;
#pragma unroll
    for (int r = 0; r < 16; ++r) ps += p0[r];
#pragma unroll
    for (int r = 0; r < 16; ++r) ps += p1[r];
    { auto rr = __builtin_amdgcn_permlane32_swap(__float_as_uint(ps), __float_as_uint(ps), false, false);
      ps = __uint_as_float(rr[0]) + __uint_as_float(rr[1]); }
    l_reg = l_reg * alpha + ps;
#define PK4(P, BASE, OUT) do { unsigned a0 = cvtpk(P[BASE + 0], P[BASE + 1]), a1 = cvtpk(P[BASE + 2], P[BASE + 3]);   \
    unsigned b0 = cvtpk(P[BASE + 4], P[BASE + 5]), b1 = cvtpk(P[BASE + 6], P[BASE + 7]);                              \
    auto r0 = __builtin_amdgcn_permlane32_swap(a0, b0, false, false); auto r1 = __builtin_amdgcn_permlane32_swap(a1, b1, false, false); \
    u32x4 w = {r0[0], r1[0], r0[1], r1[1]}; OUT = *reinterpret_cast<bf16x8*>(&w); } while (0)
    PK4(p0, 0, pa0); PK4(p0, 8, pa1); PK4(p1, 0, pa2); PK4(p1, 8, pa3);
#undef PK4
}
template <int DK>
__device__ __forceinline__ void qkt(f32x16& p0, f32x16& p1, const char* Ks, const bf16x8* qr, int r32, int hi) {
    p0 = f32x16{}; p1 = f32x16{};
#pragma unroll
    for (int d0 = 0; d0 < Cfg<DK>::ND0; ++d0) { int cb = (d0 * 16 + hi * 8) * 2;
        bf16x8 b0 = *reinterpret_cast<const bf16x8*>(Ks + kswz<DK>(r32, cb));
        bf16x8 b1 = *reinterpret_cast<const bf16x8*>(Ks + kswz<DK>(32 + r32, cb));
        p0 = __builtin_amdgcn_mfma_f32_32x32x16_bf16(b0, qr[d0], p0, 0, 0, 0);
        p1 = __builtin_amdgcn_mfma_f32_32x32x16_bf16(b1, qr[d0], p1, 0, 0, 0); }
}
__device__ __forceinline__ int v_st(int k, int c) { const int kk = (k & ~0xC) | ((k & 4) << 1) | ((k & 8) >> 1); return ((kk >> 3) * 4 + (c >> 5)) * 512 + ((kk & 7) * 32 + (c & 31)) * 2; }
__device__ __forceinline__ int v_rd_base(int lane) { return ((lane & 3) << 3) | (((lane >> 2) & 3) << 6) | (((lane >> 4) & 1) << 5) | (((lane >> 5) & 1) << 8); }
constexpr int v_rd_off(int d0, int ks, int half) { return d0 * 512 + ks * 4096 + half * 2048; }
template <int OFF> __device__ __forceinline__ s16x4 tr_read(int vb) {
    s16x4 r; asm volatile("ds_read_b64_tr_b16 %0, %1 offset:%2" : "=&v"(r) : "v"(vb), "i"(OFF) : "memory"); return r;
}
template <int D0> __device__ __forceinline__ void pv_one(f32x16& od, int vb, bf16x8 pa0, bf16x8 pa1, bf16x8 pa2, bf16x8 pa3) {
    const s16x4 l0 = tr_read<v_rd_off(D0, 0, 0)>(vb), h0 = tr_read<v_rd_off(D0, 0, 1)>(vb), l1 = tr_read<v_rd_off(D0, 1, 0)>(vb), h1 = tr_read<v_rd_off(D0, 1, 1)>(vb);
    const s16x4 l2 = tr_read<v_rd_off(D0, 2, 0)>(vb), h2 = tr_read<v_rd_off(D0, 2, 1)>(vb), l3 = tr_read<v_rd_off(D0, 3, 0)>(vb), h3 = tr_read<v_rd_off(D0, 3, 1)>(vb);
    asm volatile("s_waitcnt lgkmcnt(0)" ::: "memory"); SBAR();
#define PK(L, H) (bf16x8){L[0], L[1], L[2], L[3], H[0], H[1], H[2], H[3]}
    od = __builtin_amdgcn_mfma_f32_32x32x16_bf16(pa0, PK(l0, h0), od, 0, 0, 0);
    od = __builtin_amdgcn_mfma_f32_32x32x16_bf16(pa1, PK(l1, h1), od, 0, 0, 0);
    od = __builtin_amdgcn_mfma_f32_32x32x16_bf16(pa2, PK(l2, h2), od, 0, 0, 0);
    od = __builtin_amdgcn_mfma_f32_32x32x16_bf16(pa3, PK(l3, h3), od, 0, 0, 0);
#undef PK
}
__device__ __forceinline__ void pv_d0(f32x16* o, int vb, bf16x8 pa0, bf16x8 pa1, bf16x8 pa2, bf16x8 pa3) {
    pv_one<0>(o[0], vb, pa0, pa1, pa2, pa3); pv_one<1>(o[1], vb, pa0, pa1, pa2, pa3); pv_one<2>(o[2], vb, pa0, pa1, pa2, pa3); pv_one<3>(o[3], vb, pa0, pa1, pa2, pa3);
}

template <int DK, int LDQ, int LDK, int LDV, int LDO, int SDEPTH>
__device__ __forceinline__ void attn_dense_body(const bf16_t* __restrict__ Qb, const bf16_t* __restrict__ Kh, const bf16_t* __restrict__ Vh,
                                                bf16_t* __restrict__ Ob, int seq, char* lds) {
    using C = Cfg<DK>;
    constexpr int SHM_V = C::SHM_V, SHM_K = C::SHM_K, NKC = C::NKC, ND0 = C::ND0;
    const int tid = opaque_tid(), wid = tid >> 6, lane = tid & 63, r32 = lane & 31, hi = lane >> 5;
    char* V_lds = lds; char* K_lds = lds + 2 * SHM_V;
    float* ws = (float*)(lds + 2 * SHM_V + 2 * SHM_K) + wid * 64; float* li_l = ws; float* al_l = ws + 32;
    float m_reg = -1e30f, l_reg = 0; f32x16 o[4] = {}; bf16x8 qr[ND0];
    const bf16_t* Qw = Qb + (long)(wid * QBLK + r32) * LDQ + hi * 8;
#pragma unroll
    for (int d0 = 0; d0 < ND0; ++d0) qr[d0] = *reinterpret_cast<const bf16x8*>(Qw + d0 * 16);
    const int sr = tid >> 4, sc = (tid & 15) * 8, vst0 = v_st(sr, sc), vst1 = v_st(32 + sr, sc);
    int kgo[NKC], klo[NKC];
#pragma unroll
    for (int c = 0; c < NKC; ++c) { const int id = tid + 512 * c, kr = id / (DK / 8), kc = id % (DK / 8); kgo[c] = kr * LDK + kc * 8; klo[c] = kswz<DK>(kr, kc * 16); }
    const int vb0 = (int)(uintptr_t)V_lds + v_rd_base(lane);
    struct { bf16x8 vs0, vs1, ks[NKC]; } sr_[SDEPTH];
#define SLOAD(i, k0) do { sr_[i].vs0 = *reinterpret_cast<const bf16x8*>(&Vh[(long)((k0) + sr) * LDV + sc]); sr_[i].vs1 = *reinterpret_cast<const bf16x8*>(&Vh[(long)((k0) + 32 + sr) * LDV + sc]); \
    _Pragma("unroll") for (int c_ = 0; c_ < NKC; ++c_) sr_[i].ks[c_] = *reinterpret_cast<const bf16x8*>(&Kh[(long)(k0) * LDK + kgo[c_]]); } while (0)
#define SWRITE(b, i) do { *(bf16x8*)(V_lds + (b) * SHM_V + vst0) = sr_[i].vs0; *(bf16x8*)(V_lds + (b) * SHM_V + vst1) = sr_[i].vs1; \
    _Pragma("unroll") for (int c_ = 0; c_ < NKC; ++c_) *(bf16x8*)(K_lds + (b) * SHM_K + klo[c_]) = sr_[i].ks[c_]; } while (0)
#define SWAIT() do { if constexpr (SDEPTH == 2) { if constexpr (NKC == 2) asm volatile("s_waitcnt vmcnt(4)" ::: "memory"); else asm volatile("s_waitcnt vmcnt(5)" ::: "memory"); } \
    else asm volatile("s_waitcnt vmcnt(0)" ::: "memory"); } while (0)
#define RESC(a) do { if (__any((a) < 1.f)) { if (hi == 0) al_l[r32] = (a); asm volatile("s_waitcnt lgkmcnt(0)" ::: "memory"); \
    _Pragma("unroll") for (int d = 0; d < 4; ++d) _Pragma("unroll") for (int r = 0; r < 16; ++r) o[d][r] *= al_l[crow(r, hi)]; } } while (0)
    f32x16 pA0, pA1, pB0, pB1; float mnA, mnB, alA, alB; bf16x8 pa0, pa1, pa2, pa3; const int NT = seq / KVBLK;
    constexpr int SE = 0, SO = SDEPTH - 1;
    SLOAD(SE, 0); asm volatile("s_waitcnt vmcnt(0)" ::: "memory"); SWRITE(0, SE); __syncthreads();
    qkt<DK>(pA0, pA1, K_lds, qr, r32, hi); partialSM<DK>(pA0, pA1, m_reg, mnA, alA);
    SLOAD(SO, KVBLK); if constexpr (SDEPTH == 2) { if (2 < NT) SLOAD(SE, 2 * KVBLK); }
    SWAIT(); SWRITE(1, SO); __syncthreads();
    for (int j = 1; j + 1 < NT; j += 2) {
        SBAR(); qkt<DK>(pB0, pB1, K_lds + SHM_K, qr, r32, hi);
        finishSM(pA0, pA1, alA, l_reg, pa0, pa1, pa2, pa3); SBAR();
        SLOAD(SO, (j + SDEPTH) * KVBLK); SBAR();
        pv_d0(o, vb0, pa0, pa1, pa2, pa3); partialSM<DK>(pB0, pB1, m_reg, mnB, alB);
        __syncthreads(); SWAIT(); SWRITE(0, SE);
        RESC(alB); __syncthreads();
        SBAR(); qkt<DK>(pA0, pA1, K_lds, qr, r32, hi);
        finishSM(pB0, pB1, alB, l_reg, pa0, pa1, pa2, pa3); SBAR();
        if (SDEPTH == 1 || j + 3 < NT) SLOAD(SE, (j + 1 + SDEPTH) * KVBLK); SBAR();
        pv_d0(o, vb0 + (int)SHM_V, pa0, pa1, pa2, pa3); partialSM<DK>(pA0, pA1, m_reg, mnA, alA);
        __syncthreads(); SWAIT(); SWRITE(1, SO);
        RESC(alA); __syncthreads();
    }
    SBAR(); qkt<DK>(pB0, pB1, K_lds + SHM_K, qr, r32, hi);
    finishSM(pA0, pA1, alA, l_reg, pa0, pa1, pa2, pa3); SBAR();
    pv_d0(o, vb0, pa0, pa1, pa2, pa3); partialSM<DK>(pB0, pB1, m_reg, mnB, alB);
    __syncthreads(); RESC(alB);
    finishSM(pB0, pB1, alB, l_reg, pa0, pa1, pa2, pa3); SBAR();
    pv_d0(o, vb0 + (int)SHM_V, pa0, pa1, pa2, pa3);
    if (hi == 0) li_l[r32] = l_reg; asm volatile("s_waitcnt lgkmcnt(0)" ::: "memory");
    float rli[16];
#pragma unroll
    for (int r = 0; r < 16; ++r) rli[r] = __builtin_amdgcn_rcpf(li_l[crow(r, hi)]);
    bf16_t* Ow = Ob + (long)(wid * QBLK) * LDO;
#pragma unroll
    for (int r = 0; r < 16; ++r) { int orow = crow(r, hi);
#pragma unroll
        for (int d0 = 0; d0 < 4; ++d0) Ow[(long)orow * LDO + d0 * 32 + r32] = f2bf(o[d0][r] * rli[r]); }
#undef SLOAD
#undef SWRITE
#undef SWAIT
#undef RESC
}

template <int DK, int LDQ, int LDK, int LDV, int LDO>
__device__ __forceinline__ void attn_simple_body(const bf16_t* __restrict__ Qb, const bf16_t* __restrict__ Kh, const bf16_t* __restrict__ Vh,
                                                 bf16_t* __restrict__ Ob, int seq, char* lds) {
    using C = Cfg<DK>;
    constexpr int SHM_V = C::SHM_V, SHM_K = C::SHM_K, NKC = C::NKC, ND0 = C::ND0;
    const int tid = opaque_tid(), wid = tid >> 6, lane = tid & 63, r32 = lane & 31, hi = lane >> 5;
    char* V_lds = lds; char* K_lds = lds + 2 * SHM_V;
    float* ws = (float*)(lds + 2 * SHM_V + 2 * SHM_K) + wid * 64; float* li_l = ws; float* al_l = ws + 32;
    float m_reg = -1e30f, l_reg = 0; f32x16 o[4] = {}; bf16x8 qr[ND0];
    const bf16_t* Qw = Qb + (long)(wid * QBLK + r32) * LDQ + hi * 8;
#pragma unroll
    for (int d0 = 0; d0 < ND0; ++d0) qr[d0] = *reinterpret_cast<const bf16x8*>(Qw + d0 * 16);
    const int sr = tid >> 4, sc = (tid & 15) * 8, vst0 = v_st(sr, sc), vst1 = v_st(32 + sr, sc);
    const int vb0 = (int)(uintptr_t)V_lds + v_rd_base(lane);
    bf16x8 vs0, vs1, ks[NKC];
#define SLOAD1(k0) do { vs0 = *reinterpret_cast<const bf16x8*>(&Vh[(long)((k0) + sr) * LDV + sc]); vs1 = *reinterpret_cast<const bf16x8*>(&Vh[(long)((k0) + 32 + sr) * LDV + sc]); \
    _Pragma("unroll") for (int c_ = 0; c_ < NKC; ++c_) { const int id_ = tid + 512 * c_, kr_ = id_ / (DK / 8), kc_ = id_ % (DK / 8); ks[c_] = *reinterpret_cast<const bf16x8*>(&Kh[(long)((k0) + kr_) * LDK + kc_ * 8]); } } while (0)
#define SWRITE1(b) do { *(bf16x8*)(V_lds + (b) * SHM_V + vst0) = vs0; *(bf16x8*)(V_lds + (b) * SHM_V + vst1) = vs1; \
    _Pragma("unroll") for (int c_ = 0; c_ < NKC; ++c_) { const int id_ = tid + 512 * c_, kr_ = id_ / (DK / 8), kc_ = id_ % (DK / 8); *(bf16x8*)(K_lds + (b) * SHM_K + kswz<DK>(kr_, kc_ * 16)) = ks[c_]; } } while (0)
    f32x16 pA0, pA1; float mnA, alA; bf16x8 pa0, pa1, pa2, pa3; const int NT = seq / KVBLK;
    SLOAD1(0); asm volatile("s_waitcnt vmcnt(0)" ::: "memory"); SWRITE1(0); __syncthreads();
    for (int j = 0; j < NT; ++j) {
        const int cb = j & 1;
        if (j + 1 < NT) SLOAD1((j + 1) * KVBLK);
        SBAR(); qkt<DK>(pA0, pA1, K_lds + cb * SHM_K, qr, r32, hi);
        partialSM<DK>(pA0, pA1, m_reg, mnA, alA);
        if (__any(alA < 1.f)) { if (hi == 0) al_l[r32] = alA; asm volatile("s_waitcnt lgkmcnt(0)" ::: "memory");
#pragma unroll
            for (int d = 0; d < 4; ++d)
#pragma unroll
                for (int r = 0; r < 16; ++r) o[d][r] *= al_l[crow(r, hi)]; }
        finishSM(pA0, pA1, alA, l_reg, pa0, pa1, pa2, pa3); SBAR();
        pv_d0(o, vb0 + cb * SHM_V, pa0, pa1, pa2, pa3);
        if (j + 1 < NT) { SWRITE1(cb ^ 1); }
        __syncthreads();
    }
    if (hi == 0) li_l[r32] = l_reg; asm volatile("s_waitcnt lgkmcnt(0)" ::: "memory");
    float rli[16];
#pragma unroll
    for (int r = 0; r < 16; ++r) rli[r] = __builtin_amdgcn_rcpf(li_l[crow(r, hi)]);
    bf16_t* Ow = Ob + (long)(wid * QBLK) * LDO;
#pragma unroll
    for (int r = 0; r < 16; ++r) { int orow = crow(r, hi);
#pragma unroll
        for (int d0 = 0; d0 < 4; ++d0) Ow[(long)orow * LDO + d0 * 32 + r32] = f2bf(o[d0][r] * rli[r]); }
#undef SLOAD1
#undef SWRITE1
}
}

__device__ __forceinline__ void transpose_item(const float* W, int K, int N, int NPAD, bf16_t* WT, int mode, LAS float* scr, int item, int) {
    const int lane = opaque_tid() & 63;
    const int nblk = NPAD / 32, kb = item / nblk, nb = item % nblk, k0 = 64 * kb, n0 = 32 * nb;
    const int ncol = n0 + (lane & 31); const bool okc = ncol < N;
    float v[32];
#pragma unroll
    for (int i = 0; i < 32; ++i) { const int kk = 2 * i + (lane >> 5); v[i] = okc ? W[(size_t)(k0 + kk) * N + ncol] : 0.f; }
#pragma unroll
    for (int i = 0; i < 32; ++i) { const int kk = 2 * i + (lane >> 5); scr[kk * 33 + (lane & 31)] = v[i]; }
    LDS_WAIT(); asm volatile("" ::: "memory");
    const int c = lane & 7;
#pragma unroll
    for (int j = 0; j < 4; ++j) { const int n = (lane >> 3) + 8 * j; const LAS float* s = scr + (8 * c) * 33 + n;
        u32x4 o; o.x = cvt_pk_bf16(s[0 * 33], s[1 * 33]); o.y = cvt_pk_bf16(s[2 * 33], s[3 * 33]); o.z = cvt_pk_bf16(s[4 * 33], s[5 * 33]); o.w = cvt_pk_bf16(s[6 * 33], s[7 * 33]);
        int nn = n0 + n, drow = nn;
        if (mode == 1) { drow = (nn < FF) ? ((nn >> 7) * 256 + (nn & 127)) : (((nn - FF) >> 7) * 256 + 128 + ((nn - FF) & 127)); }
        *(u32x4*)(WT + (size_t)drow * K + k0 + 8 * c) = o; }
    LDS_WAIT(); asm volatile("" ::: "memory");
}

__device__ __forceinline__ void mod_item(const Params& p, int item, LAS float* ldsf, int) {
    const int tid = opaque_tid();
    const int l = item / 192, col0 = (item % 192) * 64, wave = tid >> 6, lane = tid & 63;
    const float* cin = p.in[1]; const float* wada = p.in[2] + (size_t)l * D * MODW; const float* bada = p.in[3] + (size_t)l * MODW;
    float* mod = (float*)(p.ws + WS_MOD) + (size_t)l * NB * MODW;
    __syncthreads();
    for (int i0 = 0; i0 < 64; i0 += 16) {
        float cv[16];
#pragma unroll
        for (int u = 0; u < 16; ++u) cv[u] = cin[tid + 512 * (i0 + u)];
#pragma unroll
        for (int u = 0; u < 16; ++u) { const int idx = tid + 512 * (i0 + u), b = idx >> 11, k = idx & 2047; ldsf[k * 16 + b] = silu_f(cv[u]); }
    }
    __syncthreads();
    float acc[16];
#pragma unroll
    for (int b = 0; b < 16; ++b) acc[b] = 0.f;
    const float* wp = wada + (size_t)(wave * 256) * MODW + col0 + lane;
    for (int k0 = 0; k0 < 256; k0 += 16) {
        float wv[16];
#pragma unroll
        for (int u = 0; u < 16; ++u) wv[u] = __builtin_nontemporal_load(wp + (size_t)(k0 + u) * MODW);
#pragma unroll
        for (int u = 0; u < 16; ++u) {
            const LAS f32x4* sp = (const LAS f32x4*)(ldsf + (wave * 256 + k0 + u) * 16);
#pragma unroll
            for (int q = 0; q < 4; ++q) { const f32x4 s4 = sp[q];
#pragma unroll
                for (int j = 0; j < 4; ++j) acc[q * 4 + j] = fmaf(s4[j], wv[u], acc[q * 4 + j]); }
        }
    }
    __syncthreads();
#pragma unroll
    for (int b = 0; b < 16; ++b) ldsf[(wave * 16 + b) * 64 + lane] = acc[b];
    __syncthreads();
#pragma unroll
    for (int q = 0; q < 2; ++q) { const int o = tid + 512 * q, b = o >> 6, cl = o & 63; float s = 0.f;
#pragma unroll
        for (int w = 0; w < 8; ++w) s += ldsf[(w * 16 + b) * 64 + cl];
        mod[(size_t)b * MODW + col0 + cl] = s + bada[col0 + cl]; }
    __syncthreads();
}

__device__ __forceinline__ void norm_mod_phase(const float* __restrict__ x, const float* __restrict__ g, const float* __restrict__ modl, int shift_off, int scale_off, bf16_t* __restrict__ outp, int gw, int NGW, int) {
    constexpr int NR = 4;
    const int lane = opaque_tid() & 63; gw = opaque_s(gw);
    for (int rowa = gw; rowa < T; rowa += NR * NGW) {
        int rows[NR]; bool has[NR];
#pragma unroll
        for (int u = 0; u < NR; ++u) { has[u] = rowa + u * NGW < T; rows[u] = has[u] ? rowa + u * NGW : rowa; }
        f32x4 v[NR][8]; float ss[NR];
#pragma unroll
        for (int u = 0; u < NR; ++u) { const f32x4* xr = (const f32x4*)(x + (size_t)rows[u] * D) + lane;
#pragma unroll
            for (int j = 0; j < 8; ++j) v[u][j] = xr[64 * j]; }
#pragma unroll
        for (int u = 0; u < NR; ++u) { float q = 0.f;
#pragma unroll
            for (int j = 0; j < 8; ++j) q += (v[u][j][0] * v[u][j][0] + v[u][j][1] * v[u][j][1]) + (v[u][j][2] * v[u][j][2] + v[u][j][3] * v[u][j][3]);
            ss[u] = q; }
#define WS_STEP(O) { _Pragma("unroll") for (int u = 0; u < NR; ++u) ss[u] += shx<O>(ss[u]); }
        XOR_STEPS(WS_STEP)
#undef WS_STEP
#pragma unroll
        for (int u = 0; u < NR; ++u) ss[u] = xsum32(ss[u]);
        float rstd[NR];
#pragma unroll
        for (int u = 0; u < NR; ++u) rstd[u] = rsqrtf(ss[u] * (1.f / D) + EPS);
#pragma unroll
        for (int j = 0; j < 8; ++j) { const int c = (lane + 64 * j) * 4;
            const f32x4 g4 = *(const f32x4*)(g + c);
            f32x4 sc4[NR], sh4[NR];
#pragma unroll
            for (int u = 0; u < NR; ++u) { const float* mb = modl + (size_t)(rows[u] >> 11) * MODW; sc4[u] = *(const f32x4*)(mb + scale_off + c); sh4[u] = *(const f32x4*)(mb + shift_off + c); }
#pragma unroll
            for (int u = 0; u < NR; ++u) { if (!has[u]) continue;
                const f32x4 y = (v[u][j] * rstd[u]) * g4 * (sc4[u] + 1.f) + sh4[u];
                u32x2 w; w.x = cvt_pk_bf16(y[0], y[1]); w.y = cvt_pk_bf16(y[2], y[3]);
                *(u32x2*)(outp + (size_t)rows[u] * D + c) = w; } }
    }
}

__device__ __forceinline__ void prep_phase(const Params& p, int layer, int gw, int NGW, int) {
    const int lane = opaque_tid() & 63; gw = opaque_s(gw);
    bf16_t* proj = (bf16_t*)(p.ws + WS_PROJ);
    bf16_t* KB = (bf16_t*)(p.ws + WS_KB); bf16_t* XBC = (bf16_t*)(p.ws + WS_XBC); float* DT = (float*)(p.ws + WS_DT);
    const float* tab = (const float*)(p.ws + WS_TAB);
    const float* tAc = tab, *tAs = tab + 2048, *tBc = tab + 4096, *tBs = tab + 4096 + 1024;
    const float* qg = p.in[7] + layer * 128; const float* kg = p.in[8] + layer * 128;
    const float* cqg = p.in[9] + layer * 512; const float* ckvg = p.in[11] + layer * 256;
    const float* convw = p.in[13] + (size_t)layer * 5 * 1280; const float* convb = p.in[14] + layer * 1280;
    const float* dtbias = p.in[15] + layer * 24;
    for (int row = gw; row < T; row += NGW) {
        const int s = row & (S - 1), ri = s >> 6, ci = s & 63;
        bf16_t* pr = proj + (size_t)row * INP;
        const int e = lane + (lane & 32), axis = lane >> 5, fi = lane & 31, idx = axis ? ci : ri;
        float x1[8], x2[8], red[10];
#pragma unroll
        for (int hh = 0; hh < 8; ++hh) { x1[hh] = bf2f(pr[128 * hh + e]); x2[hh] = bf2f(pr[128 * hh + e + 32]); }
        bf16_t* cqb = pr + C_CQ + lane * 8; bf16_t* ckb = pr + C_CKV + lane * 4;
        const bf16x8 vq = *(const bf16x8*)cqb; const s16x4 vk4 = *(const s16x4*)ckb;
        const int paxis = (lane >> 4) & 1, pfi = lane & 15, pe = pfi + 32 * paxis, pidx = paxis ? ci : ri;
        const float kx1 = bf2f(pr[C_KPE + pe]), kx2 = bf2f(pr[C_KPE + pe + 16]);
        const float dtraw = bf2f(pr[C_DT + (lane < 24 ? lane : 0)]);
        float vk[5]; int rk[5];
#pragma unroll
        for (int k = 0; k < 5; ++k) { const int s2 = s + k - 2; const bool ok = (s2 >= 0) && (s2 < S); vk[k] = ok ? 1.f : 0.f; rk[k] = ok ? (row + k - 2) : row; }
        s16x4 xv[5][5];
#pragma unroll
        for (int j = 0; j < 5; ++j)
#pragma unroll
            for (int k = 0; k < 5; ++k) xv[j][k] = *(const s16x4*)(proj + (size_t)rk[k] * INP + C_XBC + (j * 64 + lane) * 4);
        const float cs = tAc[idx * 32 + fi], sn = tAs[idx * 32 + fi];
        float fq8[8], fk4[4];
#pragma unroll
        for (int hh = 0; hh < 8; ++hh) red[hh] = x1[hh] * x1[hh] + x2[hh] * x2[hh];
        red[8] = 0.f; red[9] = 0.f;
#pragma unroll
        for (int q = 0; q < 8; ++q) { fq8[q] = bfs2f(vq[q]); red[8] += fq8[q] * fq8[q]; }
#pragma unroll
        for (int q = 0; q < 4; ++q) { fk4[q] = bfs2f(vk4[q]); red[9] += fk4[q] * fk4[q]; }
#define WS_STEP(O) { _Pragma("unroll") for (int q = 0; q < 10; ++q) red[q] += shx<O>(red[q]); }
        XOR_STEPS(WS_STEP)
#undef WS_STEP
#pragma unroll
        for (int q = 0; q < 10; ++q) red[q] = xsum32(red[q]);
        bf16_t qo1[8], qo2[8];
#pragma unroll
        for (int hh = 0; hh < 8; ++hh) {
            const float r = rsqrtf(red[hh] * (1.f / 128.f) + EPS);
            const float* gg = hh < 6 ? qg : kg;
            const float a1 = x1[hh] * r * gg[e], a2 = x2[hh] * r * gg[e + 32];
            qo1[hh] = f2bf(a1 * cs - a2 * sn); qo2[hh] = f2bf(a1 * sn + a2 * cs);
        }
        u32x4 wq; u32x2 wk;
        { const float r = rsqrtf(red[8] * (1.f / 512.f) + EPS);
          const f32x4 g0 = *(const f32x4*)(cqg + lane * 8), g1 = *(const f32x4*)(cqg + lane * 8 + 4);
          wq.x = cvt_pk_bf16(fq8[0] * r * g0[0], fq8[1] * r * g0[1]); wq.y = cvt_pk_bf16(fq8[2] * r * g0[2], fq8[3] * r * g0[3]);
          wq.z = cvt_pk_bf16(fq8[4] * r * g1[0], fq8[5] * r * g1[1]); wq.w = cvt_pk_bf16(fq8[6] * r * g1[2], fq8[7] * r * g1[3]); }
        { const float r = rsqrtf(red[9] * (1.f / 256.f) + EPS);
          const f32x4 g0 = *(const f32x4*)(ckvg + lane * 4);
          wk.x = cvt_pk_bf16(fk4[0] * r * g0[0], fk4[1] * r * g0[1]); wk.y = cvt_pk_bf16(fk4[2] * r * g0[2], fk4[3] * r * g0[3]); }
        const float pcs = tBc[pidx * 16 + pfi], psn = tBs[pidx * 16 + pfi];
        const bf16_t ko1 = f2bf(kx1 * pcs - kx2 * psn), ko2 = f2bf(kx1 * psn + kx2 * pcs);
        u32x2 co[5];
#pragma unroll
        for (int j = 0; j < 5; ++j) {
            const int c = (j * 64 + lane) * 4;
            f32x4 a = *(const f32x4*)(convb + c);
#pragma unroll
            for (int k = 0; k < 5; ++k) {
                const f32x4 w = *(const f32x4*)(convw + k * 1280 + c) * vk[k];
#pragma unroll
                for (int q = 0; q < 4; ++q) a[q] = fmaf(w[q], bfs2f(xv[j][k][q]), a[q]);
            }
            co[j].x = cvt_pk_bf16(silu_f(a[0]), silu_f(a[1])); co[j].y = cvt_pk_bf16(silu_f(a[2]), silu_f(a[3]));
        }
        const float dtv = dtraw + dtbias[lane < 24 ? lane : 0];
        const float dto = dtv > 20.f ? dtv : log1pf(expf(dtv));
#pragma unroll
        for (int hh = 0; hh < 8; ++hh) { pr[128 * hh + e] = qo1[hh]; pr[128 * hh + e + 32] = qo2[hh]; }
        *(u32x4*)cqb = wq; *(u32x2*)ckb = wk;
        if (lane < 32) { bf16_t* kb = KB + (size_t)row * 768 + 128 + pe;
#pragma unroll
            for (int hd = 0; hd < 4; ++hd) { kb[hd * 192] = ko1; kb[hd * 192 + 16] = ko2; } }
#pragma unroll
        for (int j = 0; j < 5; ++j) *(u32x2*)(XBC + (size_t)row * 1280 + (j * 64 + lane) * 4) = co[j];
        if (lane < 24) DT[(size_t)row * 24 + lane] = dto;
    }
}

__device__ __forceinline__ void ssd_item(const bf16_t* XBC, const float* DT, float* Y, float a_neg, int b, int dir, int h, LAS unsigned char* lds, int) {
    const int tid = opaque_tid();
    LAS float* Bs = (LAS float*)lds;
    LAS float* Cs = Bs + 4096;
    LAS float* Xs = Cs + 4096;
    LAS float* Ys = Xs + 2048;
    LAS float* dAs = Ys + 2048;
    LAS float* dts = dAs + 32;
    const int g = h / 6, pp = tid >> 3, nq = tid & 7, srow = tid >> 4, sc = tid & 15;
    const size_t rowbase = (size_t)b * S;
    float hst[16];
#pragma unroll
    for (int j = 0; j < 16; ++j) hst[j] = 0.f;
    bf16x8 rB, rC; s16x4 rX; float rdt = 0.f;
#define SSD_LOAD(blk) do { const int i_ = (blk) * 32 + srow, t_ = dir ? (S - 1 - i_) : i_; const bf16_t* rp_ = XBC + (rowbase + t_) * 1280; \
        rB = *(const bf16x8*)(rp_ + 768 + g * 128 + sc * 8); rC = *(const bf16x8*)(rp_ + 1024 + g * 128 + sc * 8); rX = *(const s16x4*)(rp_ + h * 64 + sc * 4); \
        if (tid < 32) { const int i2_ = (blk) * 32 + tid, t2_ = dir ? (S - 1 - i2_) : i2_; rdt = DT[(rowbase + t2_) * 24 + dir * 12 + h]; } } while (0)
#define SSD_STORE() do { f32x4 b0_, b1_, c0_, c1_, x_; \
        _Pragma("unroll") for (int k_ = 0; k_ < 4; ++k_) { b0_[k_] = bfs2f(rB[k_]); b1_[k_] = bfs2f(rB[4 + k_]); c0_[k_] = bfs2f(rC[k_]); c1_[k_] = bfs2f(rC[4 + k_]); x_[k_] = bfs2f(rX[k_]); } \
        *(LAS f32x4*)(Bs + srow * 128 + sc * 8) = b0_; *(LAS f32x4*)(Bs + srow * 128 + sc * 8 + 4) = b1_; \
        *(LAS f32x4*)(Cs + srow * 128 + sc * 8) = c0_; *(LAS f32x4*)(Cs + srow * 128 + sc * 8 + 4) = c1_; \
        *(LAS f32x4*)(Xs + srow * 64 + sc * 4) = x_; \
        if (tid < 32) { dts[tid] = rdt; dAs[tid] = expf(rdt * a_neg); } } while (0)
    SSD_LOAD(0); SSD_STORE(); __syncthreads();
    for (int blk = 0; blk < S / 32; ++blk) {
        if (blk + 1 < S / 32) SSD_LOAD(blk + 1);
        for (int i = 0; i < 32; ++i) {
            const float dAt = dAs[i], xdt = Xs[i * 64 + pp] * dts[i];
            float acc = 0.f;
#pragma unroll
            for (int j = 0; j < 4; ++j) {
                const f32x4 bv = *(const LAS f32x4*)(Bs + i * 128 + 32 * j + 4 * nq), cv = *(const LAS f32x4*)(Cs + i * 128 + 32 * j + 4 * nq);
#pragma unroll
                for (int k = 0; k < 4; ++k) { hst[4 * j + k] = fmaf(hst[4 * j + k], dAt, xdt * bv[k]); acc = fmaf(cv[k], hst[4 * j + k], acc); }
            }
            acc += __shfl_xor(acc, 1); acc += __shfl_xor(acc, 2); acc += __shfl_xor(acc, 4);
            if (nq == 0) Ys[i * 64 + pp] = acc;
        }
        __syncthreads();
        { const int i_ = blk * 32 + srow, t_ = dir ? (S - 1 - i_) : i_;
          *(f32x4*)(Y + (rowbase + t_) * 768 + h * 64 + sc * 4) = *(const LAS f32x4*)(Ys + srow * 64 + sc * 4); }
        if (blk + 1 < S / 32) SSD_STORE();
        __syncthreads();
    }
#undef SSD_LOAD
#undef SSD_STORE
}


namespace ssdm {
using namespace att;
__device__ __forceinline__ int v_st_e(int k, int c) { const int kk = (k & ~0xC) | ((k & 4) << 1) | ((k & 8) >> 1); return ((kk >> 3) * 4 + (c >> 5)) * 512 + ((kk & 7) * 32 + (c & 31)) * 2; }
__device__ __forceinline__ void upd_one(f32x16& acc, int vbA, int vbB) {
    const s16x4 al0 = tr_read<v_rd_off(0, 0, 0)>(vbA), ah0 = tr_read<v_rd_off(0, 0, 1)>(vbA), al1 = tr_read<v_rd_off(0, 1, 0)>(vbA), ah1 = tr_read<v_rd_off(0, 1, 1)>(vbA);
    const s16x4 al2 = tr_read<v_rd_off(0, 2, 0)>(vbA), ah2 = tr_read<v_rd_off(0, 2, 1)>(vbA), al3 = tr_read<v_rd_off(0, 3, 0)>(vbA), ah3 = tr_read<v_rd_off(0, 3, 1)>(vbA);
    const s16x4 bl0 = tr_read<v_rd_off(0, 0, 0)>(vbB), bh0 = tr_read<v_rd_off(0, 0, 1)>(vbB), bl1 = tr_read<v_rd_off(0, 1, 0)>(vbB), bh1 = tr_read<v_rd_off(0, 1, 1)>(vbB);
    const s16x4 bl2 = tr_read<v_rd_off(0, 2, 0)>(vbB), bh2 = tr_read<v_rd_off(0, 2, 1)>(vbB), bl3 = tr_read<v_rd_off(0, 3, 0)>(vbB), bh3 = tr_read<v_rd_off(0, 3, 1)>(vbB);
    asm volatile("s_waitcnt lgkmcnt(0)" ::: "memory"); SBAR();
#define PK(L, H) (bf16x8){L[0], L[1], L[2], L[3], H[0], H[1], H[2], H[3]}
    acc = __builtin_amdgcn_mfma_f32_32x32x16_bf16(PK(al0, ah0), PK(bl0, bh0), acc, 0, 0, 0);
    acc = __builtin_amdgcn_mfma_f32_32x32x16_bf16(PK(al1, ah1), PK(bl1, bh1), acc, 0, 0, 0);
    acc = __builtin_amdgcn_mfma_f32_32x32x16_bf16(PK(al2, ah2), PK(bl2, bh2), acc, 0, 0, 0);
    acc = __builtin_amdgcn_mfma_f32_32x32x16_bf16(PK(al3, ah3), PK(bl3, bh3), acc, 0, 0, 0);
#undef PK
}
__device__ __forceinline__ void ssd_item(const bf16_t* XBC, const float* DT, float* Y, float a_neg, int b, int dir, int h, char* shm) {
    const int tid = opaque_tid(), wid = tid >> 6, lane = tid & 63, r32 = lane & 31, hi = lane >> 5;
    const int rb = wid & 3, ph = wid >> 2, g = h / 6;
    char* Kimg = shm; char* BV = shm + 32768; char* XI = shm + 65536; char* SI = shm + 98304;
    float* acs_l = (float*)(shm + MISC_OFF + 256); float* dts_l = acs_l + 128;
    const int vbB = (int)(uintptr_t)BV + v_rd_base(lane), vbX = (int)(uintptr_t)XI + v_rd_base(lane), vbS = (int)(uintptr_t)SI + v_rd_base(lane);
    const size_t rowbase = (size_t)b * S;
#define TOK(i) (dir ? (S - 1 - (i)) : (i))
#pragma unroll
    for (int i = 0; i < 4; ++i) *(u32x4*)(SI + (tid + 512 * i) * 16) = (u32x4){0u, 0u, 0u, 0u};
    f32x16 Sacc = {};
    bf16x8 rB[4], rX[2]; float rdt = 0.f;
    const int srow = tid >> 2, scq = tid & 3;
#define SSDM_LOAD(c) do { \
        _Pragma("unroll") for (int i_ = 0; i_ < 4; ++i_) { const int id_ = tid + 512 * i_, row_ = id_ >> 4, c8_ = id_ & 15; \
            rB[i_] = *(const bf16x8*)(XBC + (rowbase + TOK((c) * 128 + row_)) * 1280 + 768 + g * 128 + c8_ * 8); } \
        { const bf16_t* xp_ = XBC + (rowbase + TOK((c) * 128 + srow)) * 1280 + h * 64 + scq * 16; rX[0] = *(const bf16x8*)xp_; rX[1] = *(const bf16x8*)(xp_ + 8); } \
        if (tid < 128) rdt = DT[(rowbase + TOK((c) * 128 + tid)) * 24 + dir * 12 + h]; } while (0)
    SSDM_LOAD(0);
    for (int c = 0; c < S / 128; ++c) {
        bf16x8 qr[8];
        { const bf16_t* cp = XBC + (rowbase + TOK(c * 128 + 32 * rb + r32)) * 1280 + 1024 + g * 128 + hi * 8;
#pragma unroll
          for (int d0 = 0; d0 < 8; ++d0) qr[d0] = *(const bf16x8*)(cp + d0 * 16); }
#pragma unroll
        for (int i = 0; i < 4; ++i) { const int id = tid + 512 * i, row = id >> 4, c8 = id & 15, tt = row >> 6, k = row & 63;
            *(bf16x8*)(Kimg + tt * 16384 + kswz<128>(k, c8 * 16)) = rB[i]; *(bf16x8*)(BV + tt * 16384 + v_st(k, c8 * 8)) = rB[i]; }
        if (tid < 128) dts_l[tid] = rdt;
        __syncthreads();
        int ln = lane; asm volatile("" : "+v"(ln));
        float x_lo = dts_l[ln] * a_neg, x_hi = dts_l[64 + ln] * a_neg;
#pragma unroll
        for (int o = 1; o < 64; o <<= 1) { const int ad = (ln - o) << 2;
            const float v0 = __int_as_float(__builtin_amdgcn_ds_bpermute(ad, __float_as_int(x_lo))), v1 = __int_as_float(__builtin_amdgcn_ds_bpermute(ad, __float_as_int(x_hi)));
            if (ln >= o) { x_lo += v0; x_hi += v1; } }
        x_hi += __int_as_float(__builtin_amdgcn_readlane(__float_as_int(x_lo), 63));
        const float acs_last = __int_as_float(__builtin_amdgcn_readlane(__float_as_int(x_hi), 63));
        if (wid == 0) { acs_l[ln] = x_lo; acs_l[64 + ln] = x_hi; }
        { const int sl = ((ln >> 2) + 16 * wid) & 63;
          const float as_lo = __int_as_float(__builtin_amdgcn_ds_bpermute(sl << 2, __float_as_int(x_lo))), as_hi = __int_as_float(__builtin_amdgcn_ds_bpermute(sl << 2, __float_as_int(x_hi)));
          const float acs_s = (srow < 64) ? as_lo : as_hi;
          const float dt_s = dts_l[srow], e_s = dt_s * __expf(acs_last - acs_s);
          const int tt = srow >> 6, k = srow & 63;
#pragma unroll
          for (int hf = 0; hf < 2; ++hf) { float f[8];
#pragma unroll
              for (int j = 0; j < 8; ++j) f[j] = bfs2f(rX[hf][j]);
              u32x4 wd, we;
              wd.x = cvt_pk_bf16(f[0] * dt_s, f[1] * dt_s); wd.y = cvt_pk_bf16(f[2] * dt_s, f[3] * dt_s); wd.z = cvt_pk_bf16(f[4] * dt_s, f[5] * dt_s); wd.w = cvt_pk_bf16(f[6] * dt_s, f[7] * dt_s);
              we.x = cvt_pk_bf16(f[0] * e_s, f[1] * e_s); we.y = cvt_pk_bf16(f[2] * e_s, f[3] * e_s); we.z = cvt_pk_bf16(f[4] * e_s, f[5] * e_s); we.w = cvt_pk_bf16(f[6] * e_s, f[7] * e_s);
              const int cc = scq * 16 + hf * 8;
              *(u32x4*)(XI + tt * 16384 + v_st(k, cc)) = wd; *(u32x4*)(XI + tt * 16384 + v_st(k, cc + 64)) = we; } }
        if (c + 1 < S / 128) SSDM_LOAD(c + 1);
        __syncthreads();
        f32x16 o_off = {}, o_diag = {};
        pv_one<0>(o_off, vbS + ph * 512, qr[0], qr[1], qr[2], qr[3]);
        pv_one<0>(o_off, vbS + ph * 512 + 16384, qr[4], qr[5], qr[6], qr[7]);
        const float acs_row = acs_l[32 * rb + r32];
        for (int jt = 0; jt <= (rb >> 1); ++jt) {
            f32x16 p0, p1;
            qkt<128>(p0, p1, Kimg + jt * 16384, qr, r32, hi);
            const int lrow = 32 * rb + r32;
#pragma unroll
            for (int r = 0; r < 16; ++r) {
                const int s0 = 64 * jt + crow(r, hi), s1 = s0 + 32;
                const float m0 = __expf(acs_row - acs_l[s0]), m1 = __expf(acs_row - acs_l[s1]);
                p0[r] = (s0 <= lrow) ? p0[r] * m0 : 0.f; p1[r] = (s1 <= lrow) ? p1[r] * m1 : 0.f;
            }
            bf16x8 pa0, pa1, pa2, pa3;
#define PK4(P, BASE, OUT) do { unsigned a0 = cvtpk(P[BASE + 0], P[BASE + 1]), a1 = cvtpk(P[BASE + 2], P[BASE + 3]);   \
    unsigned b0 = cvtpk(P[BASE + 4], P[BASE + 5]), b1 = cvtpk(P[BASE + 6], P[BASE + 7]);                              \
    auto r0 = __builtin_amdgcn_permlane32_swap(a0, b0, false, false); auto r1 = __builtin_amdgcn_permlane32_swap(a1, b1, false, false); \
    u32x4 w = {r0[0], r1[0], r0[1], r1[1]}; OUT = *reinterpret_cast<bf16x8*>(&w); } while (0)
            PK4(p0, 0, pa0); PK4(p0, 8, pa1); PK4(p1, 0, pa2); PK4(p1, 8, pa3);
#undef PK4
            pv_one<0>(o_diag, vbX + ph * 512 + jt * 16384, pa0, pa1, pa2, pa3);
        }
        float ea[16];
#pragma unroll
        for (int r = 0; r < 16; ++r) ea[r] = __expf(acs_l[32 * rb + crow(r, hi)]);
#pragma unroll
        for (int r = 0; r < 16; ++r) { const int row = 32 * rb + crow(r, hi);
            Y[(rowbase + TOK(c * 128 + row)) * 768 + h * 64 + 32 * ph + r32] = o_diag[r] + o_off[r] * ea[r]; }
        { const float eA = __expf(acs_last);
#pragma unroll
          for (int r = 0; r < 16; ++r) Sacc[r] *= eA;
          upd_one(Sacc, vbB + rb * 512, vbX + (2 + ph) * 512);
          upd_one(Sacc, vbB + rb * 512 + 16384, vbX + (2 + ph) * 512 + 16384); }
        __syncthreads();
        if (c + 1 < S / 128) {
#pragma unroll
            for (int r = 0; r < 16; ++r) { const int n = 32 * rb + crow(r, hi);
                *(bf16_t*)(SI + (n >> 6) * 16384 + v_st_e(n & 63, 32 * ph + r32)) = f2bf_c(Sacc[r]); }
        }
    }
#undef SSDM_LOAD
#undef TOK
}
}

__device__ __forceinline__ void combine_phase(const Params& p, int layer, int gw, int NGW, int) {
    const int lane = opaque_tid() & 63; gw = opaque_s(gw);
    const bf16_t* proj = (const bf16_t*)(p.ws + WS_PROJ); const bf16_t* XBC = (const bf16_t*)(p.ws + WS_XBC);
    const float* YF = (const float*)(p.ws + WS_YF); const float* YB = (const float*)(p.ws + WS_YB);
    bf16_t* ACT = (bf16_t*)(p.ws + WS_ACT);
    const float* dskip = p.in[17] + layer * 12; const float* ng = p.in[18] + layer * 768;
    for (int rowa = gw; rowa < T; rowa += 2 * NGW) {
        const bool has1 = rowa + NGW < T; const int rows[2] = {rowa, has1 ? rowa + NGW : rowa};
        f32x4 a[2][3], bq[2][3]; s16x4 xv[2][3], zv[2][3];
#pragma unroll
        for (int u = 0; u < 2; ++u)
#pragma unroll
            for (int j = 0; j < 3; ++j) { const int c = j * 256 + lane * 4; const size_t row = (size_t)rows[u];
                a[u][j] = *(const f32x4*)(YF + row * 768 + c); bq[u][j] = *(const f32x4*)(YB + row * 768 + c);
                xv[u][j] = *(const s16x4*)(XBC + row * 1280 + c); zv[u][j] = *(const s16x4*)(proj + row * INP + C_Z + c); }
        f32x4 y[2][3]; float ss[4] = {0.f, 0.f, 0.f, 0.f};
#pragma unroll
        for (int u = 0; u < 2; ++u)
#pragma unroll
            for (int j = 0; j < 3; ++j) { const int c = j * 256 + lane * 4; const float dsk = dskip[c >> 6]; float q = 0.f;
#pragma unroll
                for (int k = 0; k < 4; ++k) { const float v = (a[u][j][k] + bq[u][j][k] + bfs2f(xv[u][j][k]) * dsk) * silu_f(bfs2f(zv[u][j][k])); y[u][j][k] = v; q += v * v; }
                if (c < 384) ss[2 * u] += q; else ss[2 * u + 1] += q; }
#define WS_STEP(O) { _Pragma("unroll") for (int q = 0; q < 4; ++q) ss[q] += shx<O>(ss[q]); }
        XOR_STEPS(WS_STEP)
#undef WS_STEP
#pragma unroll
        for (int q = 0; q < 4; ++q) ss[q] = xsum32(ss[q]);
        f32x4 gn4[3];
#pragma unroll
        for (int j = 0; j < 3; ++j) gn4[j] = *(const f32x4*)(ng + j * 256 + lane * 4);
#pragma unroll
        for (int u = 0; u < 2; ++u) { if (u == 1 && !has1) break;
            const float r0 = rsqrtf(ss[2 * u] * (1.f / 384.f) + EPS), r1 = rsqrtf(ss[2 * u + 1] * (1.f / 384.f) + EPS);
#pragma unroll
            for (int j = 0; j < 3; ++j) { const int c = j * 256 + lane * 4; const float r = c < 384 ? r0 : r1;
                const f32x4 g4 = gn4[j];
                u32x2 w; w.x = cvt_pk_bf16(y[u][j][0] * r * g4[0], y[u][j][1] * r * g4[1]); w.y = cvt_pk_bf16(y[u][j][2] * r * g4[2], y[u][j][3] * r * g4[3]);
                *(u32x2*)(ACT + (size_t)rows[u] * D + 1280 + c) = w; } }
    }
}

__device__ __forceinline__ void gsync(cg::grid_group& grid) {
    asm volatile("s_waitcnt vmcnt(0) lgkmcnt(0)" ::: "memory");
    grid.sync();
    if (__builtin_amdgcn_readfirstlane(threadIdx.x >> 6) == 0) { __builtin_amdgcn_fence(__ATOMIC_ACQUIRE, "agent"); asm volatile("s_waitcnt vmcnt(0)" ::: "memory"); }
    __syncthreads();
}
#define XB_TMO      128
#define XB_XCNT(j)  (256  + 64 * (j))
#define XB_XSUB(j)  (1280 + 64 * (j))
#define XB_XGEN(j)  (2304 + 64 * (j))
#define XB_TOP      3328
#define XB_TOPGEN   3392
#define XCD_BAR_WORDS 3456
#define XB_SPIN_CAP (1u << 18)
__device__ __forceinline__ unsigned xb_ld(unsigned* p)              { return __hip_atomic_load(p, __ATOMIC_RELAXED, __HIP_MEMORY_SCOPE_AGENT); }
__device__ __forceinline__ unsigned xb_add(unsigned* p, unsigned v) { return __hip_atomic_fetch_add(p, v, __ATOMIC_RELAXED, __HIP_MEMORY_SCOPE_AGENT); }
__device__ __forceinline__ unsigned xb_xcc_id() { return (unsigned)__builtin_amdgcn_s_getreg((3 << 11) | 20) & 0xFu; }
#define XB_SPIN(cond, bar) do { unsigned _sp = 0; while (cond) { \
    if ((++_sp & 255u) == 0u) { if (xb_ld(&(bar)[XB_TMO])) break; if (_sp > XB_SPIN_CAP) { atomicAdd(&(bar)[XB_TMO], 1u); break; } } } } while (0)
struct XcdBarrier { unsigned* bar; unsigned x; volatile LAS unsigned* st; };
__device__ __forceinline__ XcdBarrier xcd_barrier_post(unsigned* bar, volatile LAS unsigned* st) {
    XcdBarrier b; b.bar = bar; b.x = xb_xcc_id(); b.st = st;
    if (opaque_tid() == 0) (void)xb_add(&bar[XB_XCNT(b.x)], 1u);
    return b;
}
__device__ __forceinline__ void xcd_barrier_complete(unsigned* bar, unsigned x, unsigned& nloc, unsigned& nx) {
    const unsigned G = gridDim.x * gridDim.y * gridDim.z;
    unsigned sum, cnt, mine, sp = 0u;
    for (;;) {
        sum = 0u; cnt = 0u; mine = 0u;
#pragma unroll
        for (unsigned j = 0; j < 16; ++j) { const unsigned c = xb_ld(&bar[XB_XCNT(j)]); sum += c; cnt += (c > 0u) ? 1u : 0u; mine = (j == x) ? c : mine; }
        if (sum == G) break;
        __builtin_amdgcn_s_sleep(1);
        if ((++sp & 255u) == 0u) { if (xb_ld(&bar[XB_TMO])) break; if (sp > XB_SPIN_CAP) { atomicAdd(&bar[XB_TMO], 1u); break; } }
    }
    nloc = mine > 0u ? mine : 1u; nx = cnt > 0u ? cnt : 1u;
}
__device__ __forceinline__ void xcd_barrier(const XcdBarrier& b) {
    asm volatile("s_waitcnt vmcnt(0)" ::: "memory");
    __syncthreads();
    if (opaque_tid() == 0) {
        unsigned* bar = b.bar;
        __builtin_amdgcn_s_waitcnt(0);
        unsigned nloc = b.st[0], nx = b.st[1];
        if (nloc == 0u) { xcd_barrier_complete(bar, b.x, nloc, nx); b.st[0] = nloc; b.st[1] = nx; }
        const unsigned old = xb_add(&bar[XB_XSUB(b.x)], 1u);
        const unsigned gen = old / nloc;
        if (old + 1u == (gen + 1u) * nloc) {
            __builtin_amdgcn_fence(__ATOMIC_RELEASE, "agent");
            asm volatile("s_waitcnt vmcnt(0)" ::: "memory");
            const unsigned og = xb_add(&bar[XB_TOP], 1u);
            const unsigned tg = og / nx;
            if (og + 1u == (tg + 1u) * nx) xb_add(&bar[XB_TOPGEN], 1u);
            else XB_SPIN(xb_ld(&bar[XB_TOPGEN]) == tg, bar);
            __builtin_amdgcn_fence(__ATOMIC_ACQUIRE, "agent");
            xb_add(&bar[XB_XGEN(b.x)], 1u);
            asm volatile("s_waitcnt vmcnt(0)" ::: "memory");
        } else {
            XB_SPIN(xb_ld(&bar[XB_XGEN(b.x)]) == gen, bar);
            __builtin_amdgcn_fence(__ATOMIC_ACQUIRE, "agent");
            asm volatile("s_waitcnt vmcnt(0)" ::: "memory");
        }
    }
    __syncthreads();
}
#ifndef EXP_SSD2
#define EXP_SSD2 0
#endif
#ifndef EXP_ELT2
#define EXP_ELT2 0
#endif
#ifndef EXP_GU2
#define EXP_GU2 0
#endif
#ifndef PROBE_PHASE
#define PROBE_PHASE 99
#endif
#define PROBE_T0(k) unsigned long long _t0 = 0; if (PROBE_PHASE == (k)) _t0 = __builtin_amdgcn_s_memrealtime();
#define PROBE_T1(k) if (PROBE_PHASE == (k)) { if (blockIdx.x == 0 && opaque_tid() == 0) { const unsigned long long _t1 = __builtin_amdgcn_s_memrealtime(); while (__builtin_amdgcn_s_memrealtime() - _t1 < _t1 - _t0) __builtin_amdgcn_s_sleep(8); } gsync(grid); }
#ifndef PH_MASK
#define PH_MASK 0xffff
#endif
#ifndef MLA_SD
#define MLA_SD 1
#endif
constexpr int N_SSD = NB * 2 * 12, N_MLA = NB * 4 * 8, N_GQA = NB * 6 * 8, N_MIX = N_SSD + N_MLA + N_GQA;

__global__ void __launch_bounds__(512, 2) fwd_megakernel(Params p) {
    extern __shared__ __attribute__((aligned(16))) unsigned char smem[];
    cg::grid_group grid = cg::this_grid();
    LAS unsigned char* lds = (LAS unsigned char*)smem;
    volatile LAS unsigned* MISC = (volatile LAS unsigned*)(lds + MISC_OFF);
    const int wave = __builtin_amdgcn_readfirstlane(threadIdx.x >> 6);
    const int G = gridDim.x, bx = blockIdx.x;
    if (threadIdx.x < 2) MISC[8 + threadIdx.x] = 0u;
    __syncthreads();
    (void)xcd_barrier_post((unsigned*)(p.ws + WS_BAR), MISC + 8);
#define XBAR() do { XcdBarrier xb_; xb_.bar = (unsigned*)(p.ws + WS_BAR); xb_.x = xb_xcc_id(); xb_.st = MISC + 8; xcd_barrier(xb_); } while (0)
    const int gw = bx * 8 + wave, NGW = G * 8;
    unsigned char* ws = p.ws;
    unsigned* ctl = (unsigned*)(ws + WS_CTL);
    float* modall = (float*)(ws + WS_MOD);
    float* tab = (float*)(ws + WS_TAB);
    bf16_t* ACT = (bf16_t*)(ws + WS_ACT); bf16_t* PROJ = (bf16_t*)(ws + WS_PROJ);
    bf16_t* QB = (bf16_t*)(ws + WS_QB); bf16_t* KB = (bf16_t*)(ws + WS_KB); bf16_t* VB = (bf16_t*)(ws + WS_VB);
    bf16_t* XBC = (bf16_t*)(ws + WS_XBC); float* DT = (float*)(ws + WS_DT); float* YF = (float*)(ws + WS_YF); float* YB = (float*)(ws + WS_YB);
    bf16_t* HID = (bf16_t*)(ws + WS_HID);

    {
        if (bx == 0 && opaque_tid() < DEPTH) ctl[16 + opaque_tid()] = 0u;
        for (int it = bx; it < DEPTH * 192; it += G) mod_item(p, it, (LAS float*)lds, 0);
        __syncthreads();
        { const int gt = bx * 512 + opaque_tid();
          if (gt < 2048) { const int idx = gt >> 5, i = gt & 31; const float inv = powf(10000.f, -(float)(2 * i) / 64.f); const float ang = (float)idx * inv; tab[gt] = cosf(ang); tab[2048 + gt] = sinf(ang); }
          else if (gt < 3072) { const int q = gt - 2048, idx = q >> 4, i = q & 15; const float inv = powf(10000.f, -(float)(2 * i) / 32.f); const float ang = (float)idx * inv; tab[4096 + q] = cosf(ang); tab[4096 + 1024 + q] = sinf(ang); } }
        LAS float* scr = (LAS float*)(lds + wave * 16384);
        constexpr int I_IN = (D / 64) * (INP / 32), I_UQ = (512 / 64) * (768 / 32), I_UKV = (256 / 64) * (1024 / 32), I_OUT = (D / 64) * (D / 32), I_GU = (D / 64) * (2 * FF / 32), I_DN = (FF / 64) * (D / 32);
        constexpr int I_LAYER = I_IN + I_UQ + I_UKV + I_OUT + I_GU + I_DN;
        for (int it = gw; it < DEPTH * I_LAYER; it += NGW) {
            const int l = it / I_LAYER; int r = it % I_LAYER;
            unsigned char* wl = ws + WS_W + (size_t)l * W_LAYER;
            if (r < I_IN) { transpose_item(p.in[6] + (size_t)l * D * INC, D, INC, INP, (bf16_t*)(wl + W_IN), 0, scr, r, 0); continue; } r -= I_IN;
            if (r < I_UQ) { transpose_item(p.in[10] + (size_t)l * 512 * 768, 512, 768, 768, (bf16_t*)(wl + W_UQ), 0, scr, r, 0); continue; } r -= I_UQ;
            if (r < I_UKV) { transpose_item(p.in[12] + (size_t)l * 256 * 1024, 256, 1024, 1024, (bf16_t*)(wl + W_UKV), 0, scr, r, 0); continue; } r -= I_UKV;
            if (r < I_OUT) { transpose_item(p.in[19] + (size_t)l * D * D, D, D, D, (bf16_t*)(wl + W_OUT), 0, scr, r, 0); continue; } r -= I_OUT;
            if (r < I_GU) { transpose_item(p.in[20] + (size_t)l * D * 2 * FF, D, 2 * FF, 2 * FF, (bf16_t*)(wl + W_GU), 1, scr, r, 0); continue; } r -= I_GU;
            transpose_item(p.in[21] + (size_t)l * FF * D, FF, D, D, (bf16_t*)(wl + W_DN), 0, scr, r, 0);
        }
    }
    XBAR();
    if (opaque_s(0) != 0) gsync(grid);

    for (int layer = 0; layer < DEPTH; ++layer) {
        const unsigned char* wl = ws + WS_W + (size_t)layer * W_LAYER;
        const float* modl = modall + (size_t)layer * NB * MODW;
        const float* xin = layer == 0 ? p.in[0] : p.out;
        norm_mod_phase(xin, p.in[4] + layer * D, modl, 0, D, ACT, gw, NGW, 0);
        if (EXP_ELT2) norm_mod_phase(xin, p.in[4] + layer * D, modl, 0, D, ACT, gw, NGW, 0);
        XBAR();
        #if PH_MASK & (1<<2)
        { pg8::Gemm g{ACT, (const bf16_t*)(wl + W_IN), T, INP, D, D}; pg8::StaticOrder so; so.init(T, INP, G, bx);
          pg8::EpiProj E{PROJ}; pg8::gemm_phase<pg8::EpiProj>(lds, g, so, E); }

#endif
        XBAR();
        prep_phase(p, layer, gw, NGW, 0);
        XBAR();
        #if PH_MASK & (1<<4)
        { pg8::Gemm g{PROJ + C_CQ, (const bf16_t*)(wl + W_UQ), T, 768, 512, INP}; pg8::StaticOrder so; so.init(T, 768, G, bx);
          pg8::EpiUq E{QB, tab + 4096, tab + 4096 + 1024}; pg8::gemm_phase<pg8::EpiUq>(lds, g, so, E); }

#endif
        #if PH_MASK & (1<<5)
        { pg8::Gemm g{PROJ + C_CKV, (const bf16_t*)(wl + W_UKV), T, 1024, 256, INP}; pg8::StaticOrder so; so.init(T, 1024, G, bx);
          pg8::EpiUkv E{KB, VB}; pg8::gemm_phase<pg8::EpiUkv>(lds, g, so, E); }

#endif
        XBAR();
        PROBE_T0(5)
        {
            const float* alog = p.in[16] + layer * 24;
            for (;;) {
                __syncthreads();
                if (opaque_tid() == 0) MISC[0] = atomicAdd(ctl + 16 + layer, 1u);
                __syncthreads();
                int it = (int)MISC[0];
                if (it >= N_MIX + (EXP_SSD2 ? N_SSD : 0)) break;
                if (EXP_SSD2 && it >= N_MIX) it -= N_MIX;
                if (it < N_SSD) {
                    const int h = it % 12, dir = (it / 12) & 1, b = it / 24;
#ifndef NO_SSD
                    ssdm::ssd_item(XBC, DT, dir ? YB : YF, -expf(alog[dir * 12 + h]), b, dir, h, (char*)smem);
#endif
                } else if (it < N_SSD + N_MLA) {
                    const int i = it - N_SSD, qb = i & 7, h = (i >> 3) & 3, b = i >> 5;
                    const size_t r0 = (size_t)b * S;
#ifndef NO_MLA
                    att::attn_simple_body<192, 768, 768, 512, D>(QB + (r0 + qb * 256) * 768 + h * 192, KB + r0 * 768 + h * 192, VB + r0 * 512 + h * 128,
                                                                ACT + (r0 + qb * 256) * D + 768 + h * 128, S, (char*)smem);
#endif
                } else {
                    const int i = it - N_SSD - N_MLA, qb = i & 7, h = (i >> 3) % 6, b = i / 48;
                    const size_t r0 = (size_t)b * S;
#ifndef NO_GQA
                    att::attn_dense_body<128, INP, INP, INP, D, 2>(PROJ + (r0 + qb * 256) * INP + C_QA + h * 128, PROJ + r0 * INP + C_KA + (h / 3) * 128, PROJ + r0 * INP + C_VA + (h / 3) * 128,
                                                                ACT + (r0 + qb * 256) * D + h * 128, S, (char*)smem);
#endif
                }
            }
        }
        XBAR();
        PROBE_T1(5)
        combine_phase(p, layer, gw, NGW, 0);
        if (EXP_ELT2) combine_phase(p, layer, gw, NGW, 0);
        XBAR();
        #if PH_MASK & (1<<7)
        { pg8::Gemm g{ACT, (const bf16_t*)(wl + W_OUT), T, D, D, D}; pg8::StaticOrder so; so.init(T, D, G, bx);
          pg8::EpiResid E{xin, p.out, modl + 2 * D}; pg8::gemm_phase<pg8::EpiResid>(lds, g, so, E); }

#endif
        XBAR();
        norm_mod_phase(p.out, p.in[5] + layer * D, modl, 3 * D, 4 * D, ACT, gw, NGW, 0);
        if (EXP_ELT2) norm_mod_phase(p.out, p.in[5] + layer * D, modl, 3 * D, 4 * D, ACT, gw, NGW, 0);
        XBAR();
        #if PH_MASK & (1<<9)
        { pg8::Gemm g{ACT, (const bf16_t*)(wl + W_GU), T, 2 * FF, D, D}; pg8::StaticOrder so; so.init(T, 2 * FF, G, bx);
          pg8::EpiSwiglu E{HID}; pg8::gemm_phase<pg8::EpiSwiglu>(lds, g, so, E);
          if (EXP_GU2) pg8::gemm_phase<pg8::EpiSwiglu>(lds, g, so, E); }

#endif
        XBAR();
        #if PH_MASK & (1<<10)
        { pg8::Gemm g{HID, (const bf16_t*)(wl + W_DN), T, D, FF, FF}; pg8::StaticOrder so; so.init(T, D, G, bx);
          pg8::EpiResid E{p.out, p.out, modl + 5 * D}; pg8::gemm_phase<pg8::EpiResid>(lds, g, so, E); }

#endif
        XBAR();
    }
    {
        const float* fg = p.in[22]; const int lane = opaque_tid() & 63; const int gw2 = opaque_s(gw);
        for (int row0 = gw2; row0 < T; row0 += 2 * NGW) {
            const int row1 = row0 + NGW; const bool has1 = row1 < T;
            f32x4* xr0 = (f32x4*)(p.out + (size_t)row0 * D) + lane; f32x4* xr1 = (f32x4*)(p.out + (size_t)(has1 ? row1 : row0) * D) + lane;
            f32x4 v0[8], v1[8]; float ss0 = 0.f, ss1 = 0.f;
#pragma unroll
            for (int j = 0; j < 8; ++j) { v0[j] = xr0[64 * j]; v1[j] = xr1[64 * j]; }
#pragma unroll
            for (int j = 0; j < 8; ++j) { ss0 += (v0[j][0] * v0[j][0] + v0[j][1] * v0[j][1]) + (v0[j][2] * v0[j][2] + v0[j][3] * v0[j][3]);
                                          ss1 += (v1[j][0] * v1[j][0] + v1[j][1] * v1[j][1]) + (v1[j][2] * v1[j][2] + v1[j][3] * v1[j][3]); }
            wave_sum2(ss0, ss1);
            const float rstd0 = rsqrtf(ss0 * (1.f / D) + EPS), rstd1 = rsqrtf(ss1 * (1.f / D) + EPS);
            f32x4 g4[8];
#pragma unroll
            for (int j = 0; j < 8; ++j) g4[j] = *(const f32x4*)(fg + (lane + 64 * j) * 4);
#pragma unroll
            for (int j = 0; j < 8; ++j) { xr0[64 * j] = (v0[j] * rstd0) * g4[j]; if (has1) xr1[64 * j] = (v1[j] * rstd1) * g4[j]; }
        }
    }
}

#undef XBAR
extern "C" void kernel_launch(void* const* d_in, const int* in_sizes, int n_in, void* d_out, int out_size, void* d_ws, size_t ws_size, hipStream_t stream) {
    static int grid_blocks = 0;
    if (grid_blocks == 0) {
        if (n_in != 23 || in_sizes[0] != T * D || out_size != T * D || ws_size < WS_END) {
            fprintf(stderr, "kernel_launch: shape/workspace mismatch: n_in %d in0 %d out %d ws %zu (need %zu); nothing launched\n", n_in, n_in > 0 ? in_sizes[0] : -1, out_size, ws_size, (size_t)WS_END);
            grid_blocks = -1; return; }
        int dev = 0, cus = 0, per_cu = 0;
        hipGetDevice(&dev);
        hipDeviceGetAttribute(&cus, hipDeviceAttributeMultiprocessorCount, dev);
        if (hipFuncSetAttribute((const void*)fwd_megakernel, hipFuncAttributeMaxDynamicSharedMemorySize, LDS_BYTES) != hipSuccess) { fprintf(stderr, "kernel_launch: hipFuncSetAttribute failed\n"); grid_blocks = -1; return; }
        if (hipOccupancyMaxActiveBlocksPerMultiprocessor(&per_cu, (const void*)fwd_megakernel, 512, LDS_BYTES) != hipSuccess || per_cu < 1) { fprintf(stderr, "kernel_launch: occupancy query failed (%d)\n", per_cu); (void)hipGetLastError(); per_cu = 1; }
        grid_blocks = cus * per_cu;
        fprintf(stderr, "kernel_launch: grid %d (cus %d x %d), ws need %zu of %zu\n", grid_blocks, cus, per_cu, (size_t)WS_END, ws_size);
    }
    if (grid_blocks < 0) return;
    if (hipMemsetAsync((char*)d_ws + WS_BAR, 0, 16384, stream) != hipSuccess) { fprintf(stderr, "kernel_launch: memset of the barrier words failed\n"); return; }
    Params p{};
    for (int i = 0; i < 23; ++i) p.in[i] = (const float*)d_in[i];
    p.out = (float*)d_out; p.ws = (unsigned char*)d_ws;
    void* args[] = {&p};
    hipError_t e = hipLaunchCooperativeKernel((const void*)fwd_megakernel, dim3(grid_blocks), dim3(512), args, LDS_BYTES, stream);
    if (e != hipSuccess) fprintf(stderr, "kernel_launch: cooperative launch failed: %s (grid %d)\n", hipGetErrorString(e), grid_blocks);
}
```
